# Optimizing an MI355X kernel written in HIP

```python
import math
import jax, jax.numpy as jnp
from jax import lax
import numpy as np

D_MODEL = 1024
BATCH = 16
SEQ = 256
DEPTH = 2
DEC_BATCH = 2
DEC_SEQ = 2048
PAST_LEN = 256

GRID_W = 64
Q_BLOCK = 128
ROPE_THETA = 10000.0
NORM_EPS = 1e-6

DIFF_HEADS = 4
DIFF_HEAD_DIM = 64
DIFF_V_DIM = 2 * DIFF_HEAD_DIM
DIFF_QK_WIDTH = DIFF_HEADS * 2 * DIFF_HEAD_DIM
DIFF_WIDTH = DIFF_HEADS * DIFF_V_DIM

GQA_HEADS = 8
GQA_KV_HEADS = 2
GQA_GROUP = GQA_HEADS // GQA_KV_HEADS
GQA_HEAD_DIM = 64
GQA_WIDTH = GQA_HEADS * GQA_HEAD_DIM
GQA_KV_WIDTH = GQA_KV_HEADS * GQA_HEAD_DIM

CONV_WIDTH = 512
CONV_KSIZE = 31

N_BRANCH = 3
MLP_HIDDEN = 4 * D_MODEL
N_MOD = 6

IN_SIZES = (DIFF_QK_WIDTH, DIFF_QK_WIDTH, DIFF_WIDTH,
            GQA_WIDTH, GQA_KV_WIDTH, GQA_KV_WIDTH,
            2 * CONV_WIDTH, N_BRANCH * D_MODEL)
IN_WIDTH = sum(IN_SIZES)

kernel_name = "hybrid_diff_gqa_conformer_dit_step"


def rms_norm(x, g):
    xf = x.astype(jnp.float32)
    y = xf * lax.rsqrt(jnp.mean(xf * xf, axis=-1, keepdims=True) + NORM_EPS)
    return (y * g.astype(jnp.float32)).astype(x.dtype)


def layer_norm(x, g, b):
    xf = x.astype(jnp.float32)
    mu = jnp.mean(xf, axis=-1, keepdims=True)
    xc = xf - mu
    y = xc * lax.rsqrt(jnp.mean(xc * xc, axis=-1, keepdims=True) + NORM_EPS)
    return (y * g.astype(jnp.float32) + b.astype(jnp.float32)).astype(x.dtype)


def axial_rope_tables(n_tokens, dim):
    n_rows = n_tokens // GRID_W
    row = jnp.repeat(jnp.arange(n_rows), GRID_W).astype(jnp.float32)
    col = jnp.tile(jnp.arange(GRID_W), n_rows).astype(jnp.float32)
    axis_dim = dim // 2
    freqs = ROPE_THETA ** (-jnp.arange(0, axis_dim, 2, dtype=jnp.float32) / axis_dim)
    ang_r = row[:, None] * freqs[None, :]
    ang_c = col[:, None] * freqs[None, :]
    ang = jnp.concatenate([ang_r, ang_r, ang_c, ang_c], axis=-1)
    return jnp.cos(ang), jnp.sin(ang)


def apply_axial_rope(x, rope):
    cos, sin = rope
    x1, x2, x3, x4 = jnp.split(x, 4, axis=-1)
    rot = jnp.concatenate([-x2, x1, -x4, x3], axis=-1)
    shape = (1, x.shape[1]) + (1,) * (x.ndim - 3) + (x.shape[-1],)
    return x * cos.reshape(shape).astype(x.dtype) + rot * sin.reshape(shape).astype(x.dtype)


def sweep_query_blocks(fn, q):
    b, s = q.shape[0], q.shape[1]
    nb = s // Q_BLOCK
    qb = jnp.moveaxis(q.reshape((b, nb, Q_BLOCK) + q.shape[2:]), 1, 0)
    out = lax.map(fn, qb)
    out = jnp.moveaxis(out, 0, 1)
    return out.reshape((b, s) + out.shape[3:])


def differential_attention(q, k, v, lam):
    scale = DIFF_HEAD_DIM ** -0.5
    kf = k.astype(jnp.float32)
    vf = v.astype(jnp.float32)

    def block(qb):
        s = jnp.einsum('bqhcd,bkhcd->bhcqk', qb.astype(jnp.float32), kf) * scale
        p = jax.nn.softmax(s, axis=-1)
        a = p[:, :, 0] - lam * p[:, :, 1]
        return jnp.einsum('bhqk,bkhe->bqhe', a, vf).astype(q.dtype)

    return sweep_query_blocks(block, q)


def grouped_query_attention(q, k, v):
    scale = GQA_HEAD_DIM ** -0.5
    kf = k.astype(jnp.float32)
    vf = v.astype(jnp.float32)

    def block(qb):
        s = jnp.einsum('bqngd,bknd->bngqk', qb.astype(jnp.float32), kf) * scale
        p = jax.nn.softmax(s, axis=-1)
        return jnp.einsum('bngqk,bknd->bqngd', p, vf).astype(q.dtype)

    return sweep_query_blocks(block, q)


def split_points():
    pts, acc = [], 0
    for s in IN_SIZES[:-1]:
        acc += s
        pts.append(acc)
    return pts


def parallel_mixer(h, l, P, ctx, rope_d, rope_g):
    b, s, _ = h.shape
    proj = h @ P['w_in'][l]
    dq, dk, dv, gq, gk, gv, cv, gl = jnp.split(proj, split_points(), axis=-1)

    dq = dq.reshape(b, s, DIFF_HEADS, 2, DIFF_HEAD_DIM)
    dk = dk.reshape(b, s, DIFF_HEADS, 2, DIFF_HEAD_DIM)
    dv = dv.reshape(b, s, DIFF_HEADS, DIFF_V_DIM)
    gq = rms_norm(gq.reshape(b, s, GQA_KV_HEADS, GQA_GROUP, GQA_HEAD_DIM), P['gqa_q_norm'][l])
    gk = rms_norm(gk.reshape(b, s, GQA_KV_HEADS, GQA_HEAD_DIM), P['gqa_k_norm'][l])
    gv = gv.reshape(b, s, GQA_KV_HEADS, GQA_HEAD_DIM)
    own_ctx = (dk, dv, gk, gv)

    if ctx is None:
        dk_all, dv_all, gk_all, gv_all = dk, dv, gk, gv
    else:
        dq = apply_axial_rope(dq, rope_d)
        gq = apply_axial_rope(gq, rope_g)
        dk_all = jnp.concatenate([apply_axial_rope(dk, rope_d), ctx[0].astype(dk.dtype)], axis=1)
        dv_all = jnp.concatenate([dv, ctx[1].astype(dv.dtype)], axis=1)
        gk_all = jnp.concatenate([apply_axial_rope(gk, rope_g), ctx[2].astype(gk.dtype)], axis=1)
        gv_all = jnp.concatenate([gv, ctx[3].astype(gv.dtype)], axis=1)

    lam_init = 0.8 - 0.6 * math.exp(-0.3 * l)
    f32 = jnp.float32
    lam = (jnp.exp(jnp.sum(P['diff_lq1'][l].astype(f32) * P['diff_lk1'][l].astype(f32)))
           - jnp.exp(jnp.sum(P['diff_lq2'][l].astype(f32) * P['diff_lk2'][l].astype(f32)))
           + lam_init)
    da = differential_attention(dq, dk_all, dv_all, lam)
    da = rms_norm(da, P['diff_subln'][l]) * (1.0 - lam_init)
    branch_a = da.reshape(b, s, DIFF_WIDTH) @ P['w_diff_o'][l]

    ga = grouped_query_attention(gq, gk_all, gv_all)
    branch_b = ga.reshape(b, s, GQA_WIDTH) @ P['w_gqa_o'][l]

    u = cv[..., :CONV_WIDTH] * jax.nn.sigmoid(cv[..., CONV_WIDTH:])
    kern = P['conv_dw'][l][:, None, :].astype(u.dtype)
    u = lax.conv_general_dilated(u, kern, window_strides=(1,),
                                 padding=[(CONV_KSIZE // 2, CONV_KSIZE // 2)],
                                 dimension_numbers=('NWC', 'WIO', 'NWC'),
                                 feature_group_count=CONV_WIDTH)
    u = u + P['conv_dw_b'][l]
    u = jax.nn.silu(layer_norm(u, P['conv_ln_g'][l], P['conv_ln_b'][l]))
    branch_c = u @ P['w_conv_o'][l]

    g = jax.nn.sigmoid(gl.reshape(b, s, N_BRANCH, D_MODEL))
    merged = g[:, :, 0] * branch_a + g[:, :, 1] * branch_b + g[:, :, 2] * branch_c
    return merged @ P['w_o'][l], own_ctx


def trunk_layer(x, mod, l, P, ctx, rope_d, rope_g):
    shift1, scale1, gate1, shift2, scale2, gate2 = jnp.split(mod, N_MOD, axis=-1)
    h = rms_norm(x, P['norm1'][l]) * (1.0 + scale1) + shift1
    m, own_ctx = parallel_mixer(h, l, P, ctx, rope_d, rope_g)
    x = x + gate1 * m
    h = rms_norm(x, P['norm2'][l]) * (1.0 + scale2) + shift2
    f = jnp.square(jax.nn.relu(h @ P['w_mlp1'][l])) @ P['w_mlp2'][l]
    x = x + gate2 * f
    return x, own_ctx


def setup_inputs(seed: int = 0) -> dict:
    key = jax.random.key(seed)
    ks = jax.random.split(key, 32)
    f32 = jnp.float32

    def nrm(k, shape, scale):
        return jax.random.normal(k, shape, f32) * scale

    return {
        'x_prompt': nrm(ks[0], (BATCH, SEQ, D_MODEL), 1.0),
        'x_sample': nrm(ks[1], (DEC_BATCH, DEC_SEQ, D_MODEL), 1.0),
        'cache_diff_k': nrm(ks[2], (DEC_BATCH, DEPTH, PAST_LEN, DIFF_HEADS, 2, DIFF_HEAD_DIM), 1.0),
        'cache_diff_v': nrm(ks[3], (DEC_BATCH, DEPTH, PAST_LEN, DIFF_HEADS, DIFF_V_DIM), 1.0),
        'cache_gqa_k': nrm(ks[4], (DEC_BATCH, DEPTH, PAST_LEN, GQA_KV_HEADS, GQA_HEAD_DIM), 1.0),
        'cache_gqa_v': nrm(ks[5], (DEC_BATCH, DEPTH, PAST_LEN, GQA_KV_HEADS, GQA_HEAD_DIM), 1.0),
        'c': nrm(ks[6], (DEC_BATCH, D_MODEL), 1.0),
        'c_ctx': nrm(ks[7], (D_MODEL,), 1.0),
        'w_ada': nrm(ks[8], (DEPTH, D_MODEL, N_MOD * D_MODEL), 0.5 * D_MODEL ** -0.5),
        'b_ada': nrm(ks[9], (DEPTH, N_MOD * D_MODEL), 0.02),
        'norm1': 1.0 + nrm(ks[10], (DEPTH, D_MODEL), 0.02),
        'norm2': 1.0 + nrm(ks[11], (DEPTH, D_MODEL), 0.02),
        'w_in': nrm(ks[12], (DEPTH, D_MODEL, IN_WIDTH), D_MODEL ** -0.5),
        'diff_lq1': nrm(ks[13], (DEPTH, DIFF_HEAD_DIM), 0.1),
        'diff_lk1': nrm(ks[14], (DEPTH, DIFF_HEAD_DIM), 0.1),
        'diff_lq2': nrm(ks[15], (DEPTH, DIFF_HEAD_DIM), 0.1),
        'diff_lk2': nrm(ks[16], (DEPTH, DIFF_HEAD_DIM), 0.1),
        'diff_subln': 1.0 + nrm(ks[17], (DEPTH, DIFF_V_DIM), 0.02),
        'w_diff_o': nrm(ks[18], (DEPTH, DIFF_WIDTH, D_MODEL), DIFF_WIDTH ** -0.5),
        'gqa_q_norm': 1.0 + nrm(ks[19], (DEPTH, GQA_HEAD_DIM), 0.02),
        'gqa_k_norm': 1.0 + nrm(ks[20], (DEPTH, GQA_HEAD_DIM), 0.02),
        'w_gqa_o': nrm(ks[21], (DEPTH, GQA_WIDTH, D_MODEL), GQA_WIDTH ** -0.5),
        'conv_dw': nrm(ks[22], (DEPTH, CONV_KSIZE, CONV_WIDTH), CONV_KSIZE ** -0.5),
        'conv_dw_b': nrm(ks[23], (DEPTH, CONV_WIDTH), 0.02),
        'conv_ln_g': 1.0 + nrm(ks[24], (DEPTH, CONV_WIDTH), 0.02),
        'conv_ln_b': nrm(ks[25], (DEPTH, CONV_WIDTH), 0.02),
        'w_conv_o': nrm(ks[26], (DEPTH, CONV_WIDTH, D_MODEL), CONV_WIDTH ** -0.5),
        'w_o': nrm(ks[27], (DEPTH, D_MODEL, D_MODEL), D_MODEL ** -0.5),
        'w_mlp1': nrm(ks[28], (DEPTH, D_MODEL, MLP_HIDDEN), D_MODEL ** -0.5),
        'w_mlp2': nrm(ks[29], (DEPTH, MLP_HIDDEN, D_MODEL), MLP_HIDDEN ** -0.5),
        'final_norm': 1.0 + nrm(ks[30], (D_MODEL,), 0.02),
    }


def reference(x_prompt, x_sample, cache_diff_k, cache_diff_v, cache_gqa_k, cache_gqa_v, c, c_ctx,
              w_ada, b_ada, norm1, norm2, w_in, diff_lq1, diff_lk1, diff_lq2, diff_lk2, diff_subln,
              w_diff_o, gqa_q_norm, gqa_k_norm, w_gqa_o, conv_dw, conv_dw_b, conv_ln_g, conv_ln_b,
              w_conv_o, w_o, w_mlp1, w_mlp2, final_norm):
    P = dict(norm1=norm1, norm2=norm2, w_in=w_in, diff_lq1=diff_lq1, diff_lk1=diff_lk1,
             diff_lq2=diff_lq2, diff_lk2=diff_lk2, diff_subln=diff_subln, w_diff_o=w_diff_o,
             gqa_q_norm=gqa_q_norm, gqa_k_norm=gqa_k_norm, w_gqa_o=w_gqa_o, conv_dw=conv_dw,
             conv_dw_b=conv_dw_b, conv_ln_g=conv_ln_g, conv_ln_b=conv_ln_b, w_conv_o=w_conv_o,
             w_o=w_o, w_mlp1=w_mlp1, w_mlp2=w_mlp2)

    x = x_prompt
    ctx_layers = []
    for l in range(DEPTH):
        mod = (jax.nn.silu(c_ctx) @ w_ada[l] + b_ada[l])[None, None, :]
        x, own_ctx = trunk_layer(x, mod, l, P, None, None, None)
        ctx_layers.append(own_ctx)
    y_prompt = rms_norm(x, final_norm)
    new_diff_k = jnp.stack([t[0] for t in ctx_layers], axis=1)
    new_diff_v = jnp.stack([t[1] for t in ctx_layers], axis=1)
    new_gqa_k = jnp.stack([t[2] for t in ctx_layers], axis=1)
    new_gqa_v = jnp.stack([t[3] for t in ctx_layers], axis=1)

    n_lat = x_sample.shape[1]
    rope_d = axial_rope_tables(n_lat, DIFF_HEAD_DIM)
    rope_g = axial_rope_tables(n_lat, GQA_HEAD_DIM)
    x = x_sample
    for l in range(DEPTH):
        mod = (jax.nn.silu(c) @ w_ada[l] + b_ada[l])[:, None, :]
        ctx = (cache_diff_k[:, l], cache_diff_v[:, l], cache_gqa_k[:, l], cache_gqa_v[:, l])
        x, _ = trunk_layer(x, mod, l, P, ctx, rope_d, rope_g)
    y_sample = rms_norm(x, final_norm)

    return (y_prompt, y_sample, new_diff_k, new_diff_v, new_gqa_k, new_gqa_v)
```

```cpp
#include <hip/hip_runtime.h>
#include <hip/hip_cooperative_groups.h>
#include <cstdio>
#include <cstdint>
namespace cg = cooperative_groups;

typedef float f32x4_t __attribute__((ext_vector_type(4)));
typedef float f32x2_t __attribute__((ext_vector_type(2)));
typedef float f32x16_t __attribute__((ext_vector_type(16)));
typedef unsigned u32x4_t __attribute__((ext_vector_type(4)));
typedef unsigned u32x2_t __attribute__((ext_vector_type(2)));
typedef short s16x8_t __attribute__((ext_vector_type(8)));
typedef __bf16 bf16x2_t __attribute__((ext_vector_type(2)));
typedef unsigned short bfraw;

__device__ __forceinline__ unsigned pk2(float lo, float hi) { f32x2_t v = {lo, hi}; bf16x2_t b = __builtin_convertvector(v, bf16x2_t); return __builtin_bit_cast(unsigned, b); }
__device__ __forceinline__ bfraw f2bf(float x) { return (bfraw)(pk2(x, 0.f) & 0xffffu); }
__device__ __forceinline__ float bf2f(bfraw x) { return __builtin_bit_cast(float, (unsigned)x << 16); }
__device__ __forceinline__ float sigmoidf_(float x) { return __builtin_amdgcn_rcpf(1.0f + __builtin_amdgcn_exp2f(-1.4426950408889634f * x)); }

constexpr int DM = 1024, NTOK = 8192, NCTX = 4096, CSEQ = 256, LSEQ = 2048, PAST = 256, INW = 6400, FF = 4096;
constexpr float NEPS = 1e-6f;
constexpr float QSCALE = 0.125f * 1.4426950408889634f;
constexpr size_t O_X = 0, O_NDK = 8388608, O_NDV = 12582912, O_NGK = 16777216, O_NGV = 17825792;
constexpr int M_SH1 = 0, M_SC1 = 1024, M_G1 = 2048, M_SH2 = 3072, M_SC2 = 4096, M_G2 = 5120;

struct EpiCtx { int l; float* out; unsigned char* ws; const float* qn; const float* kn; };
#define LAS __attribute__((address_space(3)))
constexpr size_t MiB = 1u << 20;
constexpr size_t WS_MOD = 0, WS_ROPEC = 160 * 1024, WS_ROPES = 164 * 1024, WS_BAR = 192 * 1024;
constexpr size_t WS_CDK = 1 * MiB, WS_CDVT = 2 * MiB, WS_CGK = 3 * MiB, WS_CGVT = 3 * MiB + 256 * 1024;
constexpr size_t WS_WIN = 4 * MiB, WIN_L = (size_t)INW * DM * 2;
constexpr size_t WS_WBR = 29 * MiB, WBR_L = 3 * MiB;
constexpr size_t WS_WO = 35 * MiB, WO_L = 2 * MiB;
constexpr size_t WS_W1 = 39 * MiB, W1_L = 8 * MiB;
constexpr size_t WS_W2 = 55 * MiB, W2_L = 8 * MiB;
constexpr size_t WS_HB = 72 * MiB;
constexpr size_t WS_ABR = 88 * MiB;
constexpr size_t WS_PROJ = 112 * MiB;
constexpr size_t P_DQ = 0, P_DK = 8 * MiB, P_DVTC = 16 * MiB, P_DVTL = 20 * MiB, P_GQ = 24 * MiB, P_GK = 32 * MiB, P_GVTC = 34 * MiB, P_GVTL = 35 * MiB, P_U = 36 * MiB, P_G = 44 * MiB;
constexpr size_t WS_END = 204 * MiB;
constexpr int LDS_BYTES = 147456;

__device__ __forceinline__ void st_bf4(bfraw* p, f32x4_t v) { u32x2_t w; w.x = pk2(v[0], v[1]); w.y = pk2(v[2], v[3]); *(u32x2_t*)p = w; }
__device__ __forceinline__ float dot4(f32x4_t v) { return (v[0] * v[0] + v[1] * v[1]) + (v[2] * v[2] + v[3] * v[3]); }
namespace pg8 {
#define PG8_LAS __attribute__((address_space(3)))
typedef unsigned short bf16_t;
typedef short bf16x8 __attribute__((ext_vector_type(8)));
typedef float f32x4 __attribute__((ext_vector_type(4)));
typedef unsigned u32x4 __attribute__((ext_vector_type(4)));
constexpr int BM = 256, BK = 64, HALF = 128, HTB = HALF * BK * 2  , STAGE_BYTES = 8 * HTB, NXCD = 8, WGM = 8;

__host__ __device__ __forceinline__ int lds_byte(int r, int c) { const int st = (r >> 4) * 2 + (c >> 5), rr = r & 15, cc = c & 31, ob = rr * 64 + cc * 2; return st * 1024 + (ob ^ (((ob >> 9) & 1) << 5)); }
__host__ __device__ __forceinline__ void stage_rc(int b, int& R, int& C) { const int st = b / 1024, sb = b % 1024, swz = sb ^ (((sb >> 9) & 1) << 5); R = (st >> 1) * 16 + swz / 64; C = (st & 1) * 32 + (swz % 64) / 2; }
__host__ __device__ __forceinline__ int perm32(int rho) { const int n = rho >> 4, i = rho & 15; return 8 * (i >> 2) + 4 * n + (i & 3); }

struct Unit { int pm, pn; };
struct Gemm { const bf16_t* A; const bf16_t* Bt; int M, N, K; };

struct StaticOrder {
    int nM, nN, nwg, G, c;
    __host__ __device__ void init(int M, int N, int G_, int c_) { nM = M / BM; nN = N / BM; nwg = nM * nN; G = G_; c = c_; }
    __host__ __device__ bool next(int i, Unit& u) const {
        const long L = (long)i * G + c; if (L >= nwg) return false;
        int wgid = (int)L; { const int q = nwg / NXCD, r = nwg % NXCD, xcd = wgid % NXCD, off = wgid / NXCD; wgid = (xcd < r ? xcd * (q + 1) : r * (q + 1) + (xcd - r) * q) + off; }
        const int nig = WGM * nN, gid = wgid / nig, fm = gid * WGM, gsz = (nM - fm) < WGM ? (nM - fm) : WGM;
        u.pm = fm + ((wgid % nig) % gsz); u.pn = (wgid % nig) / gsz; return true;
    }
    __device__ __forceinline__ void a_ready(const Unit&) const {}
    __device__ __forceinline__ void done(const Unit&) const {}
};

__device__ __forceinline__ unsigned cvt_pk_bf16(float lo, float hi) { unsigned r; asm volatile("v_cvt_pk_bf16_f32 %0, %1, %2" : "=v"(r) : "v"(lo), "v"(hi)); return r; }
typedef float f32x2 __attribute__((ext_vector_type(2)));
#define EC_DQ ((bfraw*)(c.ws + WS_PROJ + P_DQ))
#define EC_DK ((bfraw*)(c.ws + WS_PROJ + P_DK))
#define EC_DVtC ((bfraw*)(c.ws + WS_PROJ + P_DVTC))
#define EC_DVtL ((bfraw*)(c.ws + WS_PROJ + P_DVTL))
#define EC_GQ ((bfraw*)(c.ws + WS_PROJ + P_GQ))
#define EC_GK ((bfraw*)(c.ws + WS_PROJ + P_GK))
#define EC_GVtC ((bfraw*)(c.ws + WS_PROJ + P_GVTC))
#define EC_GVtL ((bfraw*)(c.ws + WS_PROJ + P_GVTL))
#define EC_U ((bfraw*)(c.ws + WS_PROJ + P_U))
#define EC_G ((bfraw*)(c.ws + WS_PROJ + P_G))
#define EC_TMP ((float*)(c.ws + WS_PROJ))
#define EC_HB ((bfraw*)(c.ws + WS_HB))
#define EC_HID ((bfraw*)(c.ws + WS_PROJ))
#define EC_mod ((const float*)(c.ws + WS_MOD))
#define EC_ropec ((const float*)(c.ws + WS_ROPEC))
#define EC_ropes ((const float*)(c.ws + WS_ROPES))

struct EpiIn {
    static constexpr bool PERM = false, AFTER_DRAIN = false;
    EpiCtx c;
    __device__ __forceinline__ void operator()(const f32x4 (&acc)[2][2][4][2], const Unit& u, int wr, int wc, int fr_, int fq_) const {
        int fr = fr_, fq = fq_; asm volatile("" : "+v"(fr), "+v"(fq));
        const int pn = u.pn, pm = u.pm, l = c.l;
        const bool ctx = pm < 16;
        const int rbase = pm * 256 + wr * 64 + fr;
        const int lb = (pm - 16) >> 3;
        if (pn < 2) {
#pragma unroll
            for (int ai = 0; ai < 2; ++ai)
#pragma unroll
                for (int m = 0; m < 4; ++m) {
                    const int row = rbase + ai * 128 + m * 16; const int t = (row - NCTX) & (LSEQ - 1);
                    f32x4 cs = {1.f, 1.f, 1.f, 1.f}, sn = {0.f, 0.f, 0.f, 0.f};
                    if (!ctx) { const int pos = (wc & 1) ? (t & 63) : (t >> 6); cs = *(const f32x4*)(EC_ropec + pos * 16 + 4 * fq); sn = *(const f32x4*)(EC_ropes + pos * 16 + 4 * fq); }
#pragma unroll
                    for (int bj = 0; bj < 2; ++bj) {
                        const f32x4 x1 = acc[ai][bj][m][0], x2 = acc[ai][bj][m][1];
                        const f32x4 o1 = (x1 * cs - x2 * sn) * QSCALE, o2 = (x2 * cs + x1 * sn) * QSCALE;
                        bfraw* p = EC_DQ + (size_t)row * 512 + pn * 256 + bj * 128 + wc * 32 + 4 * fq;
                        st_bf4(p, o1); st_bf4(p + 16, o2);
                    }
                }
        } else if (pn < 4) {
#pragma unroll
            for (int ai = 0; ai < 2; ++ai)
#pragma unroll
                for (int m = 0; m < 4; ++m) {
                    const int row = rbase + ai * 128 + m * 16; const int t = (row - NCTX) & (LSEQ - 1);
                    f32x4 cs = {1.f, 1.f, 1.f, 1.f}, sn = {0.f, 0.f, 0.f, 0.f};
                    if (!ctx) { const int pos = (wc & 1) ? (t & 63) : (t >> 6); cs = *(const f32x4*)(EC_ropec + pos * 16 + 4 * fq); sn = *(const f32x4*)(EC_ropes + pos * 16 + 4 * fq); }
#pragma unroll
                    for (int bj = 0; bj < 2; ++bj) {
                        const f32x4 x1 = acc[ai][bj][m][0], x2 = acc[ai][bj][m][1];
                        const f32x4 o1 = x1 * cs - x2 * sn, o2 = x2 * cs + x1 * sn;
                        const int colb = (pn - 2) * 256 + bj * 128 + wc * 32 + 4 * fq;
                        if (ctx) { float* op = c.out + O_NDK + ((size_t)(pm * 2 + l) * 256 + (row & 255)) * 512 + colb; *(f32x4*)op = x1; *(f32x4*)(op + 16) = x2; }
                        bfraw* p = EC_DK + (size_t)row * 512 + colb;
                        st_bf4(p, o1); st_bf4(p + 16, o2);
                    }
                }
        } else if (pn < 6) {
#pragma unroll
            for (int ai = 0; ai < 2; ++ai)
#pragma unroll
                for (int m = 0; m < 4; ++m) {
                    const int row = rbase + ai * 128 + m * 16; const int t = (row - NCTX) & (LSEQ - 1); const int s = row & 255;
#pragma unroll
                    for (int bj = 0; bj < 2; ++bj)
#pragma unroll
                        for (int n = 0; n < 2; ++n) {
                            const f32x4 x = acc[ai][bj][m][n];
                            const int colb = (pn - 4) * 256 + bj * 128 + wc * 32 + 16 * n + 4 * fq;
                            if (ctx) { *(f32x4*)(c.out + O_NDV + ((size_t)(pm * 2 + l) * 256 + s) * 512 + colb) = x;
#pragma unroll
                                for (int j = 0; j < 4; ++j) EC_DVtC[((size_t)pm * 512 + colb + j) * 256 + s] = f2bf(x[j]); }
                            else {
#pragma unroll
                                for (int j = 0; j < 4; ++j) EC_DVtL[((size_t)lb * 512 + colb + j) * 2048 + t] = f2bf(x[j]); }
                        }
                }
        } else if (pn < 8 || (pn == 8 && wc < 2)) {
            const bool isq = pn < 8;
            const float* nw = isq ? c.qn : c.kn;
            const int head = isq ? 4 * (pn - 6) + wc : wc;
            const float osc = isq ? QSCALE : 1.0f;
#pragma unroll
            for (int ai = 0; ai < 2; ++ai)
#pragma unroll
                for (int m = 0; m < 4; ++m) {
                    const int row = rbase + ai * 128 + m * 16; const int t = (row - NCTX) & (LSEQ - 1);
                    float ss = (dot4(acc[ai][0][m][0]) + dot4(acc[ai][0][m][1])) + (dot4(acc[ai][1][m][0]) + dot4(acc[ai][1][m][1]));
                    ss += __shfl_xor(ss, 16); ss += __shfl_xor(ss, 32);
                    const float r = __builtin_amdgcn_rsqf(ss * (1.0f / 64.0f) + NEPS);
#pragma unroll
                    for (int bj = 0; bj < 2; ++bj) {
                        const f32x4 wa = *(const f32x4*)(nw + 32 * bj + 4 * fq), wb = *(const f32x4*)(nw + 32 * bj + 16 + 4 * fq);
                        const f32x4 x1 = acc[ai][bj][m][0] * r * wa, x2 = acc[ai][bj][m][1] * r * wb;
                        f32x4 cs = {1.f, 1.f, 1.f, 1.f}, sn = {0.f, 0.f, 0.f, 0.f};
                        if (!ctx) { const int pos = bj ? (t & 63) : (t >> 6); cs = *(const f32x4*)(EC_ropec + pos * 16 + 4 * fq); sn = *(const f32x4*)(EC_ropes + pos * 16 + 4 * fq); }
                        const f32x4 o1 = (x1 * cs - x2 * sn) * osc, o2 = (x2 * cs + x1 * sn) * osc;
                        const int d0 = head * 64 + 32 * bj + 4 * fq;
                        if (isq) { bfraw* p = EC_GQ + (size_t)row * 512 + d0; st_bf4(p, o1); st_bf4(p + 16, o2); }
                        else {
                            if (ctx) { float* op = c.out + O_NGK + ((size_t)(pm * 2 + l) * 256 + (row & 255)) * 128 + d0; *(f32x4*)op = x1; *(f32x4*)(op + 16) = x2; }
                            bfraw* p = EC_GK + (size_t)row * 128 + d0; st_bf4(p, o1); st_bf4(p + 16, o2);
                        }
                    }
                    asm volatile("" ::: "memory");
                }
        } else if (pn == 8) {
            const int kvh = wc - 2;
#pragma unroll
            for (int ai = 0; ai < 2; ++ai)
#pragma unroll
                for (int m = 0; m < 4; ++m) {
                    const int row = rbase + ai * 128 + m * 16; const int t = (row - NCTX) & (LSEQ - 1); const int s = row & 255;
#pragma unroll
                    for (int bj = 0; bj < 2; ++bj)
#pragma unroll
                        for (int n = 0; n < 2; ++n) {
                            const f32x4 x = acc[ai][bj][m][n];
                            const int d0 = kvh * 64 + 32 * bj + 16 * n + 4 * fq;
                            if (ctx) { *(f32x4*)(c.out + O_NGV + ((size_t)(pm * 2 + l) * 256 + s) * 128 + d0) = x;
#pragma unroll
                                for (int j = 0; j < 4; ++j) EC_GVtC[((size_t)pm * 128 + d0 + j) * 256 + s] = f2bf(x[j]); }
                            else {
#pragma unroll
                                for (int j = 0; j < 4; ++j) EC_GVtL[((size_t)lb * 128 + d0 + j) * 2048 + t] = f2bf(x[j]); }
                        }
                }
        } else if (pn < 13) {
            const int q = pn - 9;
#pragma unroll
            for (int ai = 0; ai < 2; ++ai)
#pragma unroll
                for (int m = 0; m < 4; ++m) {
                    const int row = rbase + ai * 128 + m * 16;
#pragma unroll
                    for (int n = 0; n < 2; ++n) {
                        const f32x4 a = acc[ai][0][m][n], g = acc[ai][1][m][n];
                        f32x4 o; o[0] = a[0] * sigmoidf_(g[0]); o[1] = a[1] * sigmoidf_(g[1]); o[2] = a[2] * sigmoidf_(g[2]); o[3] = a[3] * sigmoidf_(g[3]);
                        st_bf4(EC_U + (size_t)row * 512 + q * 128 + wc * 32 + 16 * n + 4 * fq, o);
                    }
                }
        } else {
#pragma unroll
            for (int ai = 0; ai < 2; ++ai)
#pragma unroll
                for (int m = 0; m < 4; ++m) {
                    const int row = rbase + ai * 128 + m * 16;
#pragma unroll
                    for (int bj = 0; bj < 2; ++bj)
#pragma unroll
                        for (int n = 0; n < 2; ++n) {
                            const f32x4 g = acc[ai][bj][m][n];
                            f32x4 o; o[0] = sigmoidf_(g[0]); o[1] = sigmoidf_(g[1]); o[2] = sigmoidf_(g[2]); o[3] = sigmoidf_(g[3]);
                            st_bf4(EC_G + (size_t)row * 3072 + (pn - 13) * 256 + bj * 128 + wc * 32 + 16 * n + 4 * fq, o);
                        }
                }
        }
    }
};

struct EpiBranch {
    static constexpr bool PERM = true, AFTER_DRAIN = false;
    EpiCtx c;
    __device__ __forceinline__ void operator()(const f32x4 (&acc)[2][2][4][2], const Unit& u, int wr, int wc, int fr_, int fq_) const {
        int fr = fr_, fq = fq_; asm volatile("" : "+v"(fr), "+v"(fq));
        const int br = u.pm >> 5, pm = u.pm & 31, pn = u.pn & 3;
#pragma unroll
        for (int ai = 0; ai < 2; ++ai)
#pragma unroll
            for (int m = 0; m < 4; ++m) {
                const int row = pm * 256 + ai * 128 + wr * 64 + m * 16 + fr;
#pragma unroll
                for (int bj = 0; bj < 2; ++bj) {
                    const int col8 = pn * 256 + bj * 128 + wc * 32 + 8 * fq;
                    const u32x4 gw = *(const u32x4*)(EC_G + (size_t)row * 3072 + br * 1024 + col8);
                    f32x4 g0, g1;
                    g0[0] = __builtin_bit_cast(float, gw.x << 16); g0[1] = __builtin_bit_cast(float, gw.x & 0xffff0000u);
                    g0[2] = __builtin_bit_cast(float, gw.y << 16); g0[3] = __builtin_bit_cast(float, gw.y & 0xffff0000u);
                    g1[0] = __builtin_bit_cast(float, gw.z << 16); g1[1] = __builtin_bit_cast(float, gw.z & 0xffff0000u);
                    g1[2] = __builtin_bit_cast(float, gw.w << 16); g1[3] = __builtin_bit_cast(float, gw.w & 0xffff0000u);
                    f32x4 v0 = acc[ai][bj][m][0] * g0, v1 = acc[ai][bj][m][1] * g1;
                    float* tp = EC_TMP + (size_t)row * 1024 + col8;
                    if (br == 0) { *(f32x4*)tp = v0; *(f32x4*)(tp + 4) = v1; }
                    else {
                        v0 += *(const f32x4*)tp; v1 += *(const f32x4*)(tp + 4);
                        if (br == 1) { *(f32x4*)tp = v0; *(f32x4*)(tp + 4) = v1; }
                        else { u32x4 w; w.x = pk2(v0[0], v0[1]); w.y = pk2(v0[2], v0[3]); w.z = pk2(v1[0], v1[1]); w.w = pk2(v1[2], v1[3]); *(u32x4*)(EC_HB + (size_t)row * 1024 + col8) = w; }
                    }
                }
            }
    }
};
struct BranchOrder {
    int c;
    __device__ bool next(int i, Unit& u) const { if (c >= 128 || i >= 3) return false; u.pm = i * 32 + (c >> 2); u.pn = i * 4 + (c & 3); return true; }
    __device__ __forceinline__ void a_ready(const Unit&) const {}
    __device__ __forceinline__ void done(const Unit&) const {}
};

struct EpiRes {
    static constexpr bool PERM = false, AFTER_DRAIN = false;
    EpiCtx c; int goff; bfraw* dummy;
    __device__ __forceinline__ void operator()(const f32x4 (&acc)[2][2][4][2], const Unit& u, int wr, int wc, int fr_, int fq_) const {
        int fr = fr_, fq = fq_; asm volatile("" : "+v"(fr), "+v"(fq));
        const int pm = u.pm, pn = u.pn;
        const int cond = pm < 16 ? 0 : 1 + ((pm - 16) >> 3);
        const float* gp = EC_mod + (size_t)(c.l * 3 + cond) * 6144 + goff;
#pragma unroll
        for (int bj = 0; bj < 2; ++bj)
#pragma unroll
            for (int n = 0; n < 2; ++n) {
                const int colb = pn * 256 + bj * 128 + wc * 32 + 16 * n + 4 * fq;
                const f32x4 gv = *(const f32x4*)(gp + colb);
#pragma unroll
                for (int ai = 0; ai < 2; ++ai)
#pragma unroll
                    for (int m = 0; m < 4; ++m) {
                        const int row = pm * 256 + ai * 128 + wr * 64 + m * 16 + fr;
                        float* xp = c.out + O_X + (size_t)row * 1024 + colb;
                        const f32x4 nv = *(const f32x4*)xp + gv * acc[ai][bj][m][n];
                        if (dummy) st_bf4(dummy + (size_t)row * 1024 + colb, nv); else *(f32x4*)xp = nv;
                    }
            }
    }
};

struct EpiRelu2 {
    static constexpr bool PERM = true, AFTER_DRAIN = false;
    EpiCtx c;
    __device__ __forceinline__ void operator()(const f32x4 (&acc)[2][2][4][2], const Unit& u, int wr, int wc, int fr_, int fq_) const {
        int fr = fr_, fq = fq_; asm volatile("" : "+v"(fr), "+v"(fq));
#pragma unroll
        for (int ai = 0; ai < 2; ++ai)
#pragma unroll
            for (int m = 0; m < 4; ++m) {
                const int row = u.pm * 256 + ai * 128 + wr * 64 + m * 16 + fr;
#pragma unroll
                for (int bj = 0; bj < 2; ++bj) {
                    f32x4 v0 = acc[ai][bj][m][0], v1 = acc[ai][bj][m][1];
#pragma unroll
                    for (int j = 0; j < 4; ++j) { v0[j] = __builtin_fmaxf(v0[j], 0.f); v1[j] = __builtin_fmaxf(v1[j], 0.f); }
                    v0 = v0 * v0; v1 = v1 * v1;
                    u32x4 w; w.x = pk2(v0[0], v0[1]); w.y = pk2(v0[2], v0[3]); w.z = pk2(v1[0], v1[1]); w.w = pk2(v1[2], v1[3]);
                    *(u32x4*)(EC_HID + (size_t)row * 4096 + u.pn * 256 + bj * 128 + wc * 32 + 8 * fq) = w;
                }
            }
    }
};
template <class Epi, class Sched, bool ALIGN_EPI = false, bool SP2 = false>
__device__ __forceinline__ void gemm_phase(PG8_LAS unsigned char* lds, const Gemm g, const Sched& S, const Epi& E) {
    int tid_ = threadIdx.x; asm volatile("" : "+v"(tid_));
    const int tid = tid_, wid = __builtin_amdgcn_readfirstlane(tid >> 6), lane = tid & 63, wr = wid >> 2, wc = wid & 3, fr = lane & 15, fq = lane >> 4;
    const int K = g.K, nt = K / BK;
    unsigned voffA[2], voffB[2];
#pragma unroll
    for (int i = 0; i < 2; ++i) { int R, C; stage_rc(tid * 16 + i * 8192, R, C); const int Rb = Epi::PERM ? ((R & ~31) + perm32(R & 31)) : R;
        voffA[i] = (unsigned)(R * K + C) * 2u; voffB[i] = (unsigned)(Rb * K + C) * 2u; }
    const size_t kstep = (size_t)(BK * 2);
    const size_t hstep = (size_t)HALF * K * 2;
    const size_t tstep = 2 * hstep;
    const unsigned ldsw = (unsigned)wid * 1024u;
    const int aoff = lds_byte(wr * 64 + fr, fq * 8), boff = lds_byte(wc * 32 + fr, fq * 8);
#define PG8_SA(b, h) (((b) * 2 + (h)) * HTB)
#define PG8_SB(b, h) ((4 + (b) * 2 + (h)) * HTB)
#define PG8_STAGE(bufoff, gbase, voff) do { _Pragma("unroll") for (int _i = 0; _i < 2; ++_i) \
        __builtin_amdgcn_global_load_lds((const unsigned*)((const char*)(gbase) + (voff)[_i]), (PG8_LAS unsigned*)(lds + (bufoff) + ldsw + _i * 8192), 16, 0, 0); } while (0)
#define PG8_LDA(dst, b, h) do { _Pragma("unroll") for (int m = 0; m < 4; ++m) _Pragma("unroll") for (int k = 0; k < 2; ++k) dst[m][k] = *(const PG8_LAS bf16x8*)(lds + PG8_SA(b, h) + aoff + m * 2048 + k * 1024); } while (0)
#define PG8_LDB(dst, b, h) do { _Pragma("unroll") for (int n = 0; n < 2; ++n) _Pragma("unroll") for (int k = 0; k < 2; ++k) dst[n][k] = *(const PG8_LAS bf16x8*)(lds + PG8_SB(b, h) + boff + n * 2048 + k * 1024); } while (0)
#define PG8_MMA(ai, bj, At, Bt) do { __builtin_amdgcn_s_setprio(1); _Pragma("unroll") for (int m = 0; m < 4; ++m) _Pragma("unroll") for (int n = 0; n < 2; ++n) _Pragma("unroll") for (int k = 0; k < 2; ++k) \
        acc[ai][bj][m][n] = __builtin_amdgcn_mfma_f32_16x16x32_bf16(Bt[n][k], At[m][k], acc[ai][bj][m][n], 0, 0, 0); __builtin_amdgcn_s_setprio(0); } while (0)
#define PG8_WAIT_V(n) asm volatile("s_waitcnt vmcnt(" #n ")" ::: "memory")
#define PG8_WAIT_L(n) asm volatile("s_waitcnt lgkmcnt(" #n ")" ::: "memory")
#define PG8_BAR __builtin_amdgcn_s_barrier()
#define PG8_SCHED __builtin_amdgcn_sched_barrier(0)
    Unit cur, nxt; int ui = 0;
    if (!S.next(0, cur)) return;
    f32x4 acc[2][2][4][2];
#pragma unroll
    for (int a = 0; a < 2; ++a)
#pragma unroll
        for (int b = 0; b < 2; ++b)
#pragma unroll
            for (int m = 0; m < 4; ++m)
#pragma unroll
                for (int n = 0; n < 2; ++n) acc[a][b][m][n] = (f32x4){0.f, 0.f, 0.f, 0.f};
    bf16x8 At[4][2], B0[2][2], B1[2][2];
    const char* cA = (const char*)g.A + (size_t)cur.pm * tstep; const char* cB = (const char*)g.Bt + (size_t)cur.pn * tstep;
    S.a_ready(cur);
    if constexpr (SP2) {
        PG8_STAGE(PG8_SB(0, 0), cB, voffB); PG8_STAGE(PG8_SB(0, 1), cB + hstep, voffB); PG8_STAGE(PG8_SA(0, 0), cA, voffA); PG8_STAGE(PG8_SA(0, 1), cA + hstep, voffA);
        if (wr == 1) PG8_BAR;
        PG8_WAIT_V(2); PG8_BAR;
        PG8_STAGE(PG8_SB(1, 0), cB + kstep, voffB); PG8_STAGE(PG8_SA(1, 0), cA + kstep, voffA); PG8_STAGE(PG8_SB(1, 1), cB + hstep + kstep, voffB);
        PG8_WAIT_V(6); PG8_BAR;
    } else {
        PG8_STAGE(PG8_SB(0, 0), cB, voffB); PG8_STAGE(PG8_SA(0, 0), cA, voffA); PG8_STAGE(PG8_SB(0, 1), cB + hstep, voffB); PG8_STAGE(PG8_SA(0, 1), cA + hstep, voffA);
        if (wr == 1) PG8_BAR;
        PG8_WAIT_V(4); PG8_BAR;
        PG8_STAGE(PG8_SB(1, 0), cB + kstep, voffB); PG8_STAGE(PG8_SA(1, 0), cA + kstep, voffA); PG8_STAGE(PG8_SB(1, 1), cB + hstep + kstep, voffB);
        PG8_WAIT_V(6); PG8_BAR;
    }
    for (;;) {
        const bool has_next = S.next(ui + 1, nxt);
        const char* nA = has_next ? (const char*)g.A + (size_t)nxt.pm * tstep : cA; const char* nB = has_next ? (const char*)g.Bt + (size_t)nxt.pn * tstep : cB;
        for (int t = 0; t < nt; t += 2) {
            const bool last = (t == nt - 2);
            const char* a1 = cA + (size_t)(t + 1) * kstep;
            const char* a2 = last ? nA : cA + (size_t)(t + 2) * kstep; const char* b2 = last ? nB : cB + (size_t)(t + 2) * kstep;
            const char* a3 = a2 + kstep; const char* b3 = b2 + kstep;
            if (last && has_next) S.a_ready(nxt);
            if constexpr (SP2) {
            PG8_LDB(B0, 0, 0); PG8_LDB(B1, 0, 1); PG8_SCHED; PG8_LDA(At, 0, 0); PG8_STAGE(PG8_SA(1, 1), a1 + hstep, voffA);
            PG8_WAIT_V(8); PG8_WAIT_L(0); PG8_BAR; PG8_MMA(0, 0, At, B0); PG8_MMA(0, 1, At, B1); PG8_BAR; PG8_SCHED;
            PG8_LDA(At, 0, 1); PG8_STAGE(PG8_SB(0, 0), b2, voffB); PG8_STAGE(PG8_SB(0, 1), b2 + hstep, voffB); PG8_STAGE(PG8_SA(0, 0), a2, voffA);
            PG8_WAIT_V(8); PG8_WAIT_L(0); PG8_BAR; PG8_MMA(1, 0, At, B0); PG8_MMA(1, 1, At, B1); PG8_BAR; PG8_SCHED;
            PG8_LDB(B0, 1, 0); PG8_LDB(B1, 1, 1); PG8_SCHED; PG8_LDA(At, 1, 0); PG8_STAGE(PG8_SA(0, 1), a2 + hstep, voffA);
            PG8_WAIT_V(8); PG8_WAIT_L(0); PG8_BAR; PG8_MMA(0, 0, At, B0); PG8_MMA(0, 1, At, B1); PG8_BAR; PG8_SCHED;
            PG8_LDA(At, 1, 1); PG8_STAGE(PG8_SB(1, 0), b3, voffB); PG8_STAGE(PG8_SB(1, 1), b3 + hstep, voffB); PG8_STAGE(PG8_SA(1, 0), a3, voffA);
            PG8_WAIT_V(8); PG8_WAIT_L(0); PG8_BAR; PG8_MMA(1, 0, At, B0); PG8_MMA(1, 1, At, B1); PG8_BAR; PG8_SCHED;
            } else {
            PG8_LDB(B0, 0, 0); PG8_SCHED; PG8_LDA(At, 0, 0); PG8_STAGE(PG8_SA(1, 1), a1 + hstep, voffA);
            PG8_WAIT_L(8); PG8_BAR; PG8_WAIT_L(0); PG8_MMA(0, 0, At, B0); PG8_BAR; PG8_SCHED;
            PG8_LDB(B1, 0, 1); PG8_STAGE(PG8_SB(0, 0), b2, voffB);
            PG8_BAR; PG8_WAIT_L(0); PG8_MMA(0, 1, At, B1); PG8_BAR;
            PG8_LDA(At, 0, 1); PG8_STAGE(PG8_SA(0, 0), a2, voffA);
            PG8_BAR; PG8_WAIT_L(0); PG8_MMA(1, 0, At, B0); PG8_BAR; PG8_SCHED;
            PG8_STAGE(PG8_SB(0, 1), b2 + hstep, voffB);
            PG8_WAIT_V(6); PG8_BAR; PG8_MMA(1, 1, At, B1); PG8_BAR;
            PG8_LDB(B0, 1, 0); PG8_SCHED; PG8_LDA(At, 1, 0); PG8_STAGE(PG8_SA(0, 1), a2 + hstep, voffA);
            PG8_WAIT_L(8); PG8_BAR; PG8_WAIT_L(0); PG8_MMA(0, 0, At, B0); PG8_BAR; PG8_SCHED;
            PG8_LDB(B1, 1, 1); PG8_STAGE(PG8_SB(1, 0), b3, voffB);
            PG8_BAR; PG8_WAIT_L(0); PG8_MMA(0, 1, At, B1); PG8_BAR;
            PG8_LDA(At, 1, 1); PG8_STAGE(PG8_SA(1, 0), a3, voffA);
            PG8_BAR; PG8_WAIT_L(0); PG8_MMA(1, 0, At, B0); PG8_BAR; PG8_SCHED;
            PG8_STAGE(PG8_SB(1, 1), b3 + hstep, voffB);
            PG8_WAIT_V(6); PG8_BAR; PG8_MMA(1, 1, At, B1); PG8_BAR;
            }
        }
        if constexpr (ALIGN_EPI) { if (wr == 0) PG8_BAR; }
        if constexpr (!Epi::AFTER_DRAIN) { E(acc, cur, wr, wc, fr, fq); S.done(cur); }
        if (!has_next) break;
#pragma unroll
        for (int a = 0; a < 2; ++a)
#pragma unroll
            for (int b = 0; b < 2; ++b)
#pragma unroll
                for (int m = 0; m < 4; ++m)
#pragma unroll
                    for (int n = 0; n < 2; ++n) acc[a][b][m][n] = (f32x4){0.f, 0.f, 0.f, 0.f};
        cur = nxt; cA = nA; cB = nB; ++ui;
        if constexpr (ALIGN_EPI) { if (wr == 1) PG8_BAR; }
    }
    PG8_WAIT_V(0);
    if constexpr (!ALIGN_EPI) { if (wr == 0) PG8_BAR; }
    PG8_BAR;
    if constexpr (Epi::AFTER_DRAIN) { E.fused(acc, cur, wr, wc, fr, fq, lds, wid, lane); S.done(cur); }
#undef PG8_SA
#undef PG8_SB
#undef PG8_STAGE
#undef PG8_LDA
#undef PG8_LDB
#undef PG8_MMA
#undef PG8_WAIT_V
#undef PG8_WAIT_L
#undef PG8_BAR
#undef PG8_SCHED
}
}
#ifndef REP_P0
#define REP_P0 1
#endif
#ifndef REP_PA
#define REP_PA 1
#endif
#ifndef REP_ATT
#define REP_ATT 1
#endif
#ifndef REP_CONV
#define REP_CONV 1
#endif
#ifndef REP_C1
#define REP_C1 1
#endif
#ifndef REP_C2
#define REP_C2 1
#endif
#ifndef REP_M1
#define REP_M1 1
#endif
#ifndef REP_M2
#define REP_M2 1
#endif
#ifndef REP_SYNC
#define REP_SYNC 0
#endif

struct KArgs { const float* in[31]; float* out; unsigned char* ws; };
#define XB_TMO      128
#define XB_XCNT(j)  (256  + 64 * (j))
#define XB_XSUB(j)  (1280 + 64 * (j))
#define XB_XGEN(j)  (2304 + 64 * (j))
#define XB_TOP      3328
#define XB_TOPGEN   3392
#define XCD_BAR_WORDS 3456
#define XB_SPIN_CAP (1u << 18)

__device__ __forceinline__ unsigned xb_ld(unsigned* p)              { return __hip_atomic_load(p, __ATOMIC_RELAXED, __HIP_MEMORY_SCOPE_AGENT); }
__device__ __forceinline__ unsigned xb_add(unsigned* p, unsigned v) { return __hip_atomic_fetch_add(p, v, __ATOMIC_RELAXED, __HIP_MEMORY_SCOPE_AGENT); }
__device__ __forceinline__ unsigned xb_xcc_id() { return (unsigned)__builtin_amdgcn_s_getreg((3 << 11) | 20) & 0xFu; }
#define XB_SPIN(cond, bar) do { unsigned _sp = 0; while (cond) { __builtin_amdgcn_s_sleep(1); \
    if ((++_sp & 255u) == 0u) { if (xb_ld(&(bar)[XB_TMO])) break; if (_sp > XB_SPIN_CAP) { atomicAdd(&(bar)[XB_TMO], 1u); break; } } } } while (0)

struct XcdBarrier {
    unsigned* bar; unsigned x;
    volatile LAS unsigned* st;
};

__device__ __forceinline__ XcdBarrier xcd_barrier_post(unsigned* bar, volatile LAS unsigned* st) {
    XcdBarrier b; b.bar = bar; b.x = xb_xcc_id(); b.st = st;
    if (threadIdx.x == 0) (void)xb_add(&bar[XB_XCNT(b.x)], 1u);
    return b;
}
__device__ __forceinline__ void xcd_barrier_complete(unsigned* bar, unsigned x, unsigned& nloc, unsigned& nx) {
    const unsigned G = gridDim.x * gridDim.y * gridDim.z;
    unsigned sum, cnt, mine, sp = 0u;
    for (;;) {
        sum = 0u; cnt = 0u; mine = 0u;
#pragma unroll
        for (unsigned j = 0; j < 16; ++j) { const unsigned c = xb_ld(&bar[XB_XCNT(j)]); sum += c; cnt += (c > 0u) ? 1u : 0u; mine = (j == x) ? c : mine; }
        if (sum == G) break;
        __builtin_amdgcn_s_sleep(1);
        if ((++sp & 255u) == 0u) { if (xb_ld(&bar[XB_TMO])) break; if (sp > XB_SPIN_CAP) { atomicAdd(&bar[XB_TMO], 1u); break; } }
    }
    nloc = mine > 0u ? mine : 1u; nx = cnt > 0u ? cnt : 1u;
}

__device__ __forceinline__ void xcd_barrier(const XcdBarrier& b) {
    asm volatile("s_waitcnt vmcnt(0)" ::: "memory");
    __syncthreads();
    if (threadIdx.x == 0) {
        unsigned* bar = b.bar;
        __builtin_amdgcn_s_waitcnt(0);
        unsigned nloc = b.st[0], nx = b.st[1];
        if (nloc == 0u) { xcd_barrier_complete(bar, b.x, nloc, nx); b.st[0] = nloc; b.st[1] = nx; }
        const unsigned old = xb_add(&bar[XB_XSUB(b.x)], 1u);
        const unsigned gen = old / nloc;
        if (old + 1u == (gen + 1u) * nloc) {
            __builtin_amdgcn_fence(__ATOMIC_RELEASE, "agent");
            asm volatile("s_waitcnt vmcnt(0)" ::: "memory");
            const unsigned og = xb_add(&bar[XB_TOP], 1u);
            const unsigned tg = og / nx;
            if (og + 1u == (tg + 1u) * nx) xb_add(&bar[XB_TOPGEN], 1u);
            else XB_SPIN(xb_ld(&bar[XB_TOPGEN]) == tg, bar);
            __builtin_amdgcn_fence(__ATOMIC_ACQUIRE, "agent");
            xb_add(&bar[XB_XGEN(b.x)], 1u);
            asm volatile("s_waitcnt vmcnt(0)" ::: "memory");
        } else {
            XB_SPIN(xb_ld(&bar[XB_XGEN(b.x)]) == gen, bar);
            __builtin_amdgcn_fence(__ATOMIC_ACQUIRE, "agent");
            asm volatile("s_waitcnt vmcnt(0)" ::: "memory");
        }
    }
    __syncthreads();
}


__device__ __forceinline__ float wave_sum(float v) {
#pragma unroll
    for (int o = 1; o < 64; o <<= 1) v += __shfl_xor(v, o);
    return v;
}

__device__ __forceinline__ void transpose_item(const float* W, int K, int N, bfraw* WT, int vrow0, int n0, int k0, LAS float* scr, int lane) {
#pragma unroll 8
    for (int i = 0; i < 32; ++i) { const int kk = 2 * i + (lane >> 5); scr[kk * 33 + (lane & 31)] = W[(size_t)(k0 + kk) * N + n0 + (lane & 31)]; }
    asm volatile("s_waitcnt lgkmcnt(0)" ::: "memory");
    const int cch = lane & 7;
#pragma unroll
    for (int j = 0; j < 4; ++j) { const int n = (lane >> 3) + 8 * j; const LAS float* s = scr + (8 * cch) * 33 + n;
        u32x4_t o; o.x = pk2(s[0 * 33], s[1 * 33]); o.y = pk2(s[2 * 33], s[3 * 33]); o.z = pk2(s[4 * 33], s[5 * 33]); o.w = pk2(s[6 * 33], s[7 * 33]);
        *(u32x4_t*)(WT + (size_t)(vrow0 + n) * K + k0 + 8 * cch) = o; }
    asm volatile("s_waitcnt lgkmcnt(0)" ::: "memory");
}
__device__ __forceinline__ int vcol_map(int vb) {
    const int tile = vb >> 3, sub = vb & 7, bj = sub >> 2, wc = sub & 3;
    if (tile < 6 || tile >= 13) return vb * 32;
    if (tile < 8) return 1536 + (4 * (tile - 6) + wc) * 64 + 32 * bj;
    if (tile == 8) return 2048 + wc * 64 + 32 * bj;
    return (bj ? 2816 : 2304) + 128 * (tile - 9) + 32 * wc;
}
__device__ __forceinline__ void sincos_small(float x, float& s, float& c) {
    const float k = __builtin_rintf(x * 0.15915494309189535f);
    float r = __builtin_fmaf(-k, 6.2831854820251465f, x); r = __builtin_fmaf(-k, -1.7484555e-07f, r);
    const float y = r * 0.25f, y2 = y * y;
    float sp = __builtin_fmaf(y2, 2.7557319e-06f, -1.9841270e-04f); sp = __builtin_fmaf(sp, y2, 8.3333333e-03f); sp = __builtin_fmaf(sp, y2, -1.6666667e-01f); sp = __builtin_fmaf(sp * y2, y, y);
    float cp = __builtin_fmaf(y2, -2.7557319e-07f, 2.4801587e-05f); cp = __builtin_fmaf(cp, y2, -1.3888889e-03f); cp = __builtin_fmaf(cp, y2, 4.1666667e-02f); cp = __builtin_fmaf(cp, y2, -0.5f); cp = __builtin_fmaf(cp, y2, 1.0f);
    const float s2 = 2.f * sp * cp, c2 = cp * cp - sp * sp;
    s = 2.f * s2 * c2; c = c2 * c2 - s2 * s2;
}
__device__ __forceinline__ void modnorm_row(const float* xrow, float* xcopy, bfraw* orow, const float* nw, const float* shift, const float* scale, int lane) {
    const f32x4_t* xr = (const f32x4_t*)xrow + lane;
    f32x4_t v[4]; float s = 0.f;
#pragma unroll
    for (int j = 0; j < 4; ++j) { v[j] = xr[64 * j]; s += dot4(v[j]); }
    const float r = __builtin_amdgcn_rsqf(wave_sum(s) * (1.0f / DM) + NEPS);
#pragma unroll
    for (int j = 0; j < 4; ++j) {
        const int cidx = 4 * lane + 256 * j;
        if (xcopy) *((f32x4_t*)xcopy + lane + 64 * j) = v[j];
        const f32x4_t w = *(const f32x4_t*)(nw + cidx), sh = *(const f32x4_t*)(shift + cidx), sc = *(const f32x4_t*)(scale + cidx);
        const f32x4_t h = v[j] * r * w * (1.0f + sc) + sh;
        st_bf4(orow + cidx, h);
    }
}
__device__ __forceinline__ void finalnorm_row(float* xrow, const float* nw, int lane) {
    f32x4_t* xr = (f32x4_t*)xrow + lane;
    f32x4_t v[4]; float s = 0.f;
#pragma unroll
    for (int j = 0; j < 4; ++j) { v[j] = xr[64 * j]; s += dot4(v[j]); }
    const float r = __builtin_amdgcn_rsqf(wave_sum(s) * (1.0f / DM) + NEPS);
#pragma unroll
    for (int j = 0; j < 4; ++j) { const f32x4_t w = *(const f32x4_t*)(nw + 4 * lane + 256 * j); xr[64 * j] = v[j] * r * w; }
}

struct AttnArgs {
    const bfraw* Q; int qcol0, qcol1;
    const bfraw* Kown; const bfraw* Kc; int kstride;
    int nOwn, nTot;
    const bfraw* Vown; int vsOwn; const bfraw* Vc; int vsC;
    bfraw* O; int ocol0, ocol1;
    float lam, postscale; const float* subln;
};
constexpr int ATT_VOFF = 17408, ATT_XOFF = 36864;
template <int DV, int KROW, bool DIFF>
__device__ __forceinline__ void attn_unit(LAS unsigned char* lds, const AttnArgs& a) {
    constexpr int KROWB = KROW * 2 + 16, NKC = KROW / 64, NVC = DV / 64, NDB = DV / 32, KPR = KROW / 8;
    int tid_ = threadIdx.x; asm volatile("" : "+v"(tid_));
    const int tid = tid_, lane = tid & 63, r32 = lane & 31, hi = lane >> 5;
    const int wid = __builtin_amdgcn_readfirstlane(tid >> 6), g = wid >> 2, wq = wid & 3;
    const int kcol = (KROW == 128) ? g * 64 : 0;
    s16x8_t qf[4];
    { const bfraw* qp = a.Q + (size_t)(wq * 32 + r32) * 512 + (g ? a.qcol1 : a.qcol0) + hi * 8;
#pragma unroll
      for (int d0 = 0; d0 < 4; ++d0) qf[d0] = *(const s16x8_t*)(qp + d0 * 16); }
    f32x16_t o[NDB];
#pragma unroll
    for (int db = 0; db < NDB; ++db)
#pragma unroll
        for (int r = 0; r < 16; ++r) o[db][r] = 0.f;
    float m_run = -1e30f, l_run = 0.f;
    u32x4_t kreg[NKC], vreg[NVC];
    {
#pragma unroll
        for (int i = 0; i < NKC; ++i) { const int ch = tid + 512 * i, key = ch / KPR, part = ch % KPR; kreg[i] = *(const u32x4_t*)(a.Kown + (size_t)key * a.kstride + part * 8); }
#pragma unroll
        for (int i = 0; i < NVC; ++i) { const int ch = tid + 512 * i, d = ch >> 3, part = ch & 7; vreg[i] = *(const u32x4_t*)(a.Vown + (size_t)d * a.vsOwn + part * 8); }
    }
    for (int t = 0; t < a.nTot; ++t) {
        __syncthreads();
#pragma unroll
        for (int i = 0; i < NKC; ++i) { const int ch = tid + 512 * i, key = ch / KPR, part = ch % KPR; *(LAS u32x4_t*)(lds + key * KROWB + part * 16) = kreg[i]; }
#pragma unroll
        for (int i = 0; i < NVC; ++i) { const int ch = tid + 512 * i, d = ch >> 3, part = ch & 7; *(LAS u32x4_t*)(lds + ATT_VOFF + d * 144 + part * 16) = vreg[i]; }
        __syncthreads();
        if (t + 1 < a.nTot) {
            const int tn = t + 1; const bool own = tn < a.nOwn;
            const bfraw* kb = own ? a.Kown + (size_t)tn * 64 * a.kstride : a.Kc + (size_t)(tn - a.nOwn) * 64 * a.kstride;
            const bfraw* vb = own ? a.Vown + tn * 64 : a.Vc + (tn - a.nOwn) * 64; const int vs = own ? a.vsOwn : a.vsC;
#pragma unroll
            for (int i = 0; i < NKC; ++i) { const int ch = tid + 512 * i, key = ch / KPR, part = ch % KPR; kreg[i] = *(const u32x4_t*)(kb + (size_t)key * a.kstride + part * 8); }
#pragma unroll
            for (int i = 0; i < NVC; ++i) { const int ch = tid + 512 * i, d = ch >> 3, part = ch & 7; vreg[i] = *(const u32x4_t*)(vb + (size_t)d * vs + part * 8); }
        }
        f32x16_t p0, p1;
#pragma unroll
        for (int r = 0; r < 16; ++r) { p0[r] = 0.f; p1[r] = 0.f; }
#pragma unroll
        for (int d0 = 0; d0 < 4; ++d0) {
            const s16x8_t k0 = *(const LAS s16x8_t*)(lds + r32 * KROWB + (kcol + d0 * 16 + hi * 8) * 2);
            const s16x8_t k1 = *(const LAS s16x8_t*)(lds + (32 + r32) * KROWB + (kcol + d0 * 16 + hi * 8) * 2);
            p0 = __builtin_amdgcn_mfma_f32_32x32x16_bf16(k0, qf[d0], p0, 0, 0, 0);
            p1 = __builtin_amdgcn_mfma_f32_32x32x16_bf16(k1, qf[d0], p1, 0, 0, 0);
        }
        float mx = __builtin_fmaxf(p0[0], p1[0]);
#pragma unroll
        for (int r = 1; r < 16; ++r) mx = __builtin_fmaxf(mx, __builtin_fmaxf(p0[r], p1[r]));
        mx = __builtin_fmaxf(mx, __shfl_xor(mx, 32));
        const float m_new = __builtin_fmaxf(m_run, mx);
        const float alpha = __builtin_amdgcn_exp2f(m_run - m_new);
        m_run = m_new; l_run *= alpha;
#pragma unroll
        for (int db = 0; db < NDB; ++db)
#pragma unroll
            for (int r = 0; r < 16; ++r) o[db][r] *= alpha;
        float rs = 0.f;
#pragma unroll
        for (int r = 0; r < 16; ++r) { p0[r] = __builtin_amdgcn_exp2f(p0[r] - m_new); p1[r] = __builtin_amdgcn_exp2f(p1[r] - m_new); rs += p0[r] + p1[r]; }
        l_run += rs;
#pragma unroll
        for (int j = 0; j < 2; ++j)
#pragma unroll
            for (int s2 = 0; s2 < 2; ++s2) {
                u32x4_t pw;
                if (j == 0) { pw.x = pk2(p0[8 * s2 + 0], p0[8 * s2 + 1]); pw.y = pk2(p0[8 * s2 + 2], p0[8 * s2 + 3]); pw.z = pk2(p0[8 * s2 + 4], p0[8 * s2 + 5]); pw.w = pk2(p0[8 * s2 + 6], p0[8 * s2 + 7]); }
                else        { pw.x = pk2(p1[8 * s2 + 0], p1[8 * s2 + 1]); pw.y = pk2(p1[8 * s2 + 2], p1[8 * s2 + 3]); pw.z = pk2(p1[8 * s2 + 4], p1[8 * s2 + 5]); pw.w = pk2(p1[8 * s2 + 6], p1[8 * s2 + 7]); }
                const s16x8_t pf = __builtin_bit_cast(s16x8_t, pw);
                const int kb0 = 32 * j + 16 * s2 + 4 * hi;
#pragma unroll
                for (int db = 0; db < NDB; ++db) {
                    const LAS unsigned char* vp = lds + ATT_VOFF + (32 * db + r32) * 144 + kb0 * 2;
                    const u32x2_t lo = *(const LAS u32x2_t*)vp, hh = *(const LAS u32x2_t*)(vp + 16);
                    u32x4_t vw; vw.x = lo.x; vw.y = lo.y; vw.z = hh.x; vw.w = hh.y;
                    o[db] = __builtin_amdgcn_mfma_f32_32x32x16_bf16(__builtin_bit_cast(s16x8_t, vw), pf, o[db], 0, 0, 0);
                }
            }
    }
    const float ltot = l_run + __shfl_xor(l_run, 32);
    const float inv = 1.0f / ltot;
    const int qrow = wq * 32 + r32;
    if (DIFF) {
        LAS float* xch = (LAS float*)(lds + ATT_XOFF) + wq * 64 * 64 + lane;
        if (g == 1) {
            const float sc = inv * a.lam;
#pragma unroll
            for (int db = 0; db < NDB; ++db)
#pragma unroll
                for (int r = 0; r < 16; ++r) xch[(db * 16 + r) * 64] = o[db][r] * sc;
        }
        __syncthreads();
        if (g == 0) {
            float ss = 0.f;
#pragma unroll
            for (int db = 0; db < NDB; ++db)
#pragma unroll
                for (int r = 0; r < 16; ++r) { const float v = o[db][r] * inv - xch[(db * 16 + r) * 64]; o[db][r] = v; ss += v * v; }
            ss += __shfl_xor(ss, 32);
            const float rn = __builtin_amdgcn_rsqf(ss * (1.0f / 128.0f) + NEPS) * a.postscale;
            bfraw* op = a.O + (size_t)qrow * 512 + a.ocol0 + 4 * hi;
#pragma unroll
            for (int db = 0; db < NDB; ++db)
#pragma unroll
                for (int rr = 0; rr < 4; ++rr) {
                    const int d = 32 * db + 8 * rr;
                    const f32x4_t w = *(const f32x4_t*)(a.subln + d + 4 * hi);
                    f32x4_t v; v[0] = o[db][4 * rr] * rn * w[0]; v[1] = o[db][4 * rr + 1] * rn * w[1]; v[2] = o[db][4 * rr + 2] * rn * w[2]; v[3] = o[db][4 * rr + 3] * rn * w[3];
                    st_bf4(op + d, v);
                }
        }
    } else {
        bfraw* op = a.O + (size_t)qrow * 512 + (g ? a.ocol1 : a.ocol0) + 4 * hi;
#pragma unroll
        for (int db = 0; db < NDB; ++db)
#pragma unroll
            for (int rr = 0; rr < 4; ++rr) {
                f32x4_t v; v[0] = o[db][4 * rr] * inv; v[1] = o[db][4 * rr + 1] * inv; v[2] = o[db][4 * rr + 2] * inv; v[3] = o[db][4 * rr + 3] * inv;
                st_bf4(op + 32 * db + 8 * rr, v);
            }
    }
    __syncthreads();
}

__device__ __forceinline__ void conv_unit(LAS unsigned char* lds, int unit, const bfraw* U, bfraw* UC, const float* cw, const float* cb, const float* lg, const float* lbeta) {
    int tid_ = threadIdx.x; asm volatile("" : "+v"(tid_));
    const int tid = tid_, lane = tid & 63, wid = tid >> 6, c = tid;
    const int m0 = unit * 32;
    int lo, hi_;
    if (m0 < NCTX) { lo = (m0 / CSEQ) * CSEQ; hi_ = lo + CSEQ; } else { lo = NCTX + ((m0 - NCTX) / LSEQ) * LSEQ; hi_ = lo + LSEQ; }
    float w[31];
#pragma unroll
    for (int j = 0; j < 31; ++j) w[j] = cw[j * 512 + c];
    float acc[32];
    const float bias = cb[c];
#pragma unroll
    for (int o = 0; o < 32; ++o) acc[o] = bias;
    bfraw raw[62];
#pragma unroll
    for (int i = 0; i < 62; ++i) { int tok = m0 - 15 + i; tok = tok < lo ? lo : (tok >= hi_ ? hi_ - 1 : tok); raw[i] = U[(size_t)tok * 512 + c]; }
#pragma unroll
    for (int i = 0; i < 62; ++i) {
        const int tok = m0 - 15 + i;
        const float v = (tok >= lo && tok < hi_) ? bf2f(raw[i]) : 0.f;
#pragma unroll
        for (int o = 0; o < 32; ++o) { const int j = i - o; if (j >= 0 && j < 31) acc[o] += v * w[j]; }
    }
    LAS float* sm = (LAS float*)lds;
    LAS float* st = (LAS float*)(lds + 65536);
#pragma unroll
    for (int o = 0; o < 32; ++o) sm[o * 512 + c] = acc[o];
    __syncthreads();
#pragma unroll
    for (int tt = 0; tt < 4; ++tt) {
        const int tok = wid * 4 + tt; float s = 0.f, q = 0.f;
#pragma unroll
        for (int k = 0; k < 8; ++k) { const float x = sm[tok * 512 + lane + 64 * k]; s += x; q += x * x; }
        s = wave_sum(s); q = wave_sum(q);
        const float mu = s * (1.0f / 512.0f), var = __builtin_fmaxf(q * (1.0f / 512.0f) - mu * mu, 0.f);
        if (lane == 0) { st[tok * 2] = mu; st[tok * 2 + 1] = __builtin_amdgcn_rsqf(var + NEPS); }
    }
    __syncthreads();
    const float gg = lg[c], bb = lbeta[c];
#pragma unroll
    for (int o = 0; o < 32; ++o) {
        const float y = (acc[o] - st[o * 2]) * st[o * 2 + 1] * gg + bb;
        UC[(size_t)(m0 + o) * 512 + c] = f2bf(y * sigmoidf_(y));
    }
    __syncthreads();
}

template <bool PERMIN>
__device__ __forceinline__ void convert_item(const float* W, int K, int N, bfraw* WT, int vrow0, int n0, int k0, LAS float* scr, int tid) {
    const int lane = tid & 63, wave = tid >> 6;
    float v[16][4];
#pragma unroll
    for (int g4 = 0; g4 < 4; ++g4) {
        const int vc = g4 * 64 + lane;
        const int col = PERMIN ? vcol_map((vrow0 + vc) >> 5) + (vc & 31) : n0 + vc;
#pragma unroll
        for (int r = 0; r < 16; ++r) v[r][g4] = W[(size_t)(k0 + wave * 16 + r) * N + col];
    }
#pragma unroll
    for (int r = 0; r < 16; ++r)
#pragma unroll
        for (int g4 = 0; g4 < 4; ++g4) scr[(wave * 16 + r) * 257 + g4 * 64 + lane] = v[r][g4];
    __syncthreads();
#pragma unroll
    for (int it = 0; it < 8; ++it) {
        const int ch = it * 512 + tid, n = ch >> 4, kc = ch & 15;
        const LAS float* s = scr + (8 * kc) * 257 + n;
        u32x4_t o; o.x = pk2(s[0], s[257]); o.y = pk2(s[2 * 257], s[3 * 257]); o.z = pk2(s[4 * 257], s[5 * 257]); o.w = pk2(s[6 * 257], s[7 * 257]);
        *(u32x4_t*)(WT + (size_t)(vrow0 + n) * K + k0 + 8 * kc) = o;
    }
    __syncthreads();
}
#define P0_CONVERT { \
        LAS float* scr = (LAS float*)lds; \
        constexpr int I_IN = 8 * 25, I_BR = 3 * 16, I_O = 32, I_1 = 128, I_2 = 128, I_L = I_IN + I_BR + I_O + I_1 + I_2; \
        for (int it = G - 1 - bid; it < 2 * I_L; it += G) { \
            const int l = it / I_L; int r = it % I_L; \
            if (r < I_IN) { const int kb = r / 25, nt = r % 25; convert_item<true>(a.in[12] + (size_t)l * DM * INW, DM, INW, (bfraw*)(ws + WS_WIN + l * WIN_L), nt * 256, 0, kb * 128, scr, tid); continue; } r -= I_IN; \
            if (r < I_BR) { const int br = r >> 4, rr = r & 15, kb = rr >> 2, nt = rr & 3; const float* W = (br == 0 ? a.in[18] : br == 1 ? a.in[21] : a.in[26]) + (size_t)l * 512 * 1024; \
                convert_item<false>(W, 512, 1024, (bfraw*)(ws + WS_WBR + l * WBR_L) + (size_t)br * 1024 * 512, nt * 256, nt * 256, kb * 128, scr, tid); continue; } r -= I_BR; \
            if (r < I_O) { const int kb = r >> 2, nt = r & 3; convert_item<false>(a.in[27] + (size_t)l * 1024 * 1024, 1024, 1024, (bfraw*)(ws + WS_WO + l * WO_L), nt * 256, nt * 256, kb * 128, scr, tid); continue; } r -= I_O; \
            if (r < I_1) { const int kb = r >> 4, nt = r & 15; convert_item<false>(a.in[28] + (size_t)l * 1024 * 4096, 1024, 4096, (bfraw*)(ws + WS_W1 + l * W1_L), nt * 256, nt * 256, kb * 128, scr, tid); continue; } r -= I_1; \
            { const int kb = r >> 2, nt = r & 3; convert_item<false>(a.in[29] + (size_t)l * 4096 * 1024, 4096, 1024, (bfraw*)(ws + WS_W2 + l * W2_L), nt * 256, nt * 256, kb * 128, scr, tid); } \
        } }
#define CONV_PHASE \
            for (int u = bid; u < NTOK / 32; u += G) \
                conv_unit(lds, u, (const bfraw*)(P_PROJ + P_U), P_ABR + (size_t)2 * NTOK * 512, a.in[22] + l * 31 * 512, a.in[23] + l * 512, a.in[24] + l * 512, a.in[25] + l * 512);
#define PH_BEGIN unsigned char* ws = a.ws; asm volatile("" : "+s"(ws)); int tid = threadIdx.x; asm volatile("" : "+v"(tid)); \
    const int lane = tid & 63, wave = __builtin_amdgcn_readfirstlane(tid >> 6), gw = bid * 8 + wave, NGW = G * 8; (void)lane; (void)gw; (void)NGW; (void)wave;
#define P_MOD ((float*)(ws + WS_MOD))
#define P_HB ((bfraw*)(ws + WS_HB))
#define P_ABR ((bfraw*)(ws + WS_ABR))
#define P_PROJ (ws + WS_PROJ)
#define P_X (a.out + O_X)
__global__ void __launch_bounds__(512, 2) fwd_kernel(KArgs a) {
    extern __shared__ __attribute__((aligned(16))) unsigned char lds_raw[];
    LAS unsigned char* lds = (LAS unsigned char*)lds_raw;
    cg::grid_group grid = cg::this_grid();
    const int bid = blockIdx.x, G = gridDim.x;
    volatile LAS unsigned* bst = (volatile LAS unsigned*)(lds + 147392);
    {
        PH_BEGIN
        unsigned* barw = (unsigned*)(ws + WS_BAR);
        if (tid == 0) { bst[0] = 0u; bst[1] = 0u; }
        if (bid == 0) for (int i = tid; i < XCD_BAR_WORDS; i += 512) __hip_atomic_store(barw + i, 0u, __ATOMIC_RELAXED, __HIP_MEMORY_SCOPE_AGENT);
        __syncthreads();
    }
#pragma unroll 1
    for (int rep_ = 0; rep_ < REP_P0; ++rep_) {
        PH_BEGIN
        LAS float* sil = (LAS float*)lds;
        for (int i = tid; i < 3072; i += 512) { const int cond = i >> 10, k = i & 1023; const float v = cond == 0 ? a.in[7][k] : a.in[6][(cond - 1) * 1024 + k]; sil[i] = v * sigmoidf_(v); }
        __syncthreads();
        LAS float* part = (LAS float*)(lds + 16384);
        for (int item = bid; item < 192; item += G) {
            const int l = item / 96, nb = (item % 96) * 64;
            const float* W = a.in[8] + (size_t)l * 1024 * 6144 + nb + lane;
            const int k0 = wave * 128;
            float a0 = 0.f, a1 = 0.f, a2 = 0.f;
#pragma unroll 32
            for (int kk = 0; kk < 128; ++kk) { const float wv = W[(size_t)(k0 + kk) * 6144]; a0 += sil[k0 + kk] * wv; a1 += sil[1024 + k0 + kk] * wv; a2 += sil[2048 + k0 + kk] * wv; }
            part[(wave * 3 + 0) * 64 + lane] = a0; part[(wave * 3 + 1) * 64 + lane] = a1; part[(wave * 3 + 2) * 64 + lane] = a2;
            __syncthreads();
            if (tid < 192) { const int cnd = tid >> 6, ln = tid & 63; float s = 0.f;
#pragma unroll
                for (int wv = 0; wv < 8; ++wv) s += part[(wv * 3 + cnd) * 64 + ln];
                P_MOD[(size_t)(l * 3 + cnd) * 6144 + nb + ln] = s + a.in[9][l * 6144 + nb + ln]; }
            __syncthreads();
        }
        if (bid == G - 1) {
            float* ROPEC = (float*)(ws + WS_ROPEC); float* ROPES = (float*)(ws + WS_ROPES);
            for (int i = tid; i < 1024; i += 512) { const int pos = i >> 4, j = i & 15; const float freq = __builtin_amdgcn_exp2f(-(float)j * 0.8304820237218406f);
                float s, c; sincos_small((float)pos * freq, s, c); ROPEC[i] = c; ROPES[i] = s; }
        }
        __syncthreads();
        P0_CONVERT
        const int gt = bid * 512 + tid, GT = G * 512;
        bfraw* CDK = (bfraw*)(ws + WS_CDK); bfraw* CDVT = (bfraw*)(ws + WS_CDVT); bfraw* CGK = (bfraw*)(ws + WS_CGK); bfraw* CGVT = (bfraw*)(ws + WS_CGVT);
        for (int i = gt; i < 2 * 2 * 256 * 512; i += GT) { const int col = i & 511, s = (i >> 9) & 255, l = (i >> 17) & 1, lb = i >> 18;
            CDK[((size_t)(l * 2 + lb) * 256 + s) * 512 + col] = f2bf(a.in[2][i]); CDVT[((size_t)(l * 2 + lb) * 512 + col) * 256 + s] = f2bf(a.in[3][i]); }
        for (int i = gt; i < 2 * 2 * 256 * 128; i += GT) { const int col = i & 127, s = (i >> 7) & 255, l = (i >> 15) & 1, lb = i >> 16;
            CGK[((size_t)(l * 2 + lb) * 256 + s) * 128 + col] = f2bf(a.in[4][i]); CGVT[((size_t)(l * 2 + lb) * 128 + col) * 256 + s] = f2bf(a.in[5][i]); }
    }
    grid.sync();
    const XcdBarrier bar = xcd_barrier_post((unsigned*)(a.ws + WS_BAR), bst);
    for (int rep_ = 0; rep_ < REP_SYNC; ++rep_) xcd_barrier(bar);
    {
        PH_BEGIN
        for (int m = gw; m < NTOK; m += NGW) {
            const float* src = m < NCTX ? a.in[0] + (size_t)m * DM : a.in[1] + (size_t)(m - NCTX) * DM;
            const int cond = m < NCTX ? 0 : 1 + ((m - NCTX) >> 11);
            const float* md = P_MOD + (size_t)cond * 6144;
            modnorm_row(src, P_X + (size_t)m * DM, P_HB + (size_t)m * DM, a.in[10], md + M_SH1, md + M_SC1, lane);
        }
    }
    xcd_barrier(bar);

#pragma unroll 1
    for (int l = 0; l < 2; ++l) {
#pragma unroll 1
        for (int rep_ = 0; rep_ < REP_PA; ++rep_) {
            PH_BEGIN
            EpiCtx ec; ec.l = l; ec.out = a.out; ec.ws = ws; ec.qn = a.in[19] + l * 64; ec.kn = a.in[20] + l * 64;
            pg8::Gemm g{P_HB, (const bfraw*)(ws + WS_WIN + l * WIN_L), NTOK, INW, DM}; pg8::StaticOrder S; S.init(NTOK, INW, G, bid);
            pg8::EpiIn E{ec};
            pg8::gemm_phase<pg8::EpiIn, pg8::StaticOrder, true, true>(lds, g, S, E);
        }
        xcd_barrier(bar);
#pragma unroll 1
        for (int rep_ = 0; rep_ < REP_ATT; ++rep_) {
            PH_BEGIN
            float d1 = 0.f, d2 = 0.f;
            for (int i = 0; i < 64; ++i) { d1 += a.in[13][l * 64 + i] * a.in[14][l * 64 + i]; d2 += a.in[15][l * 64 + i] * a.in[16][l * 64 + i]; }
            const float lam_init = l == 0 ? 0.2f : 0.35550907f;
            const float lam = __builtin_amdgcn_exp2f(d1 * 1.4426950408889634f) - __builtin_amdgcn_exp2f(d2 * 1.4426950408889634f) + lam_init;
            const bfraw* CDK = (const bfraw*)(ws + WS_CDK); const bfraw* CDVT = (const bfraw*)(ws + WS_CDVT); const bfraw* CGK = (const bfraw*)(ws + WS_CGK); const bfraw* CGVT = (const bfraw*)(ws + WS_CGVT);
            bfraw* const DQ = (bfraw*)(P_PROJ + P_DQ); bfraw* const DK = (bfraw*)(P_PROJ + P_DK); bfraw* const DVtC = (bfraw*)(P_PROJ + P_DVTC); bfraw* const DVtL = (bfraw*)(P_PROJ + P_DVTL);
            bfraw* const GQ = (bfraw*)(P_PROJ + P_GQ); bfraw* const GK = (bfraw*)(P_PROJ + P_GK); bfraw* const GVtC = (bfraw*)(P_PROJ + P_GVTC); bfraw* const GVtL = (bfraw*)(P_PROJ + P_GVTL);
            bfraw* const ABR = P_ABR;
            for (int k = 0; ; ++k) {
                int u;
                if (G == 256) { if (bid < 128) { if (k > 0) break; u = bid; } else { if (k > 2) break; u = 128 * (k + 1) + (bid - 128); } }
                else { u = bid + k * G; if (u >= 512) break; }
                const int cls = u >> 7, i = u & 127;
                AttnArgs t;
                t.lam = lam; t.postscale = 1.0f - lam_init; t.subln = a.in[17] + l * 128;
                if (cls == 0) {
                    const int lb = i >> 6, h = (i >> 4) & 3, qb = i & 15; const int row0 = NCTX + lb * LSEQ;
                    t.Q = DQ + (size_t)(row0 + qb * 128) * 512; t.qcol0 = h * 128; t.qcol1 = h * 128 + 64;
                    t.Kown = DK + (size_t)row0 * 512 + h * 128; t.Kc = CDK + (size_t)(l * 2 + lb) * 256 * 512 + h * 128; t.kstride = 512; t.nOwn = 32; t.nTot = 36;
                    t.Vown = DVtL + ((size_t)lb * 512 + h * 128) * 2048; t.vsOwn = 2048; t.Vc = CDVT + ((size_t)(l * 2 + lb) * 512 + h * 128) * 256; t.vsC = 256;
                    t.O = ABR + (size_t)(row0 + qb * 128) * 512; t.ocol0 = h * 128; t.ocol1 = 0;
                    attn_unit<128, 128, true>(lds, t);
                } else if (cls == 2) {
                    const int cb = i >> 3, h = (i >> 1) & 3, qb = i & 1; const int row0 = cb * CSEQ;
                    t.Q = DQ + (size_t)(row0 + qb * 128) * 512; t.qcol0 = h * 128; t.qcol1 = h * 128 + 64;
                    t.Kown = DK + (size_t)row0 * 512 + h * 128; t.Kc = t.Kown; t.kstride = 512; t.nOwn = 4; t.nTot = 4;
                    t.Vown = DVtC + ((size_t)cb * 512 + h * 128) * 256; t.vsOwn = 256; t.Vc = t.Vown; t.vsC = 256;
                    t.O = ABR + (size_t)(row0 + qb * 128) * 512; t.ocol0 = h * 128; t.ocol1 = 0;
                    attn_unit<128, 128, true>(lds, t);
                } else if (cls == 1) {
                    const int lb = i >> 6, pr = (i >> 4) & 3, qb = i & 15, kvh = pr >> 1, h0 = kvh * 4 + (pr & 1) * 2; const int row0 = NCTX + lb * LSEQ;
                    t.Q = GQ + (size_t)(row0 + qb * 128) * 512; t.qcol0 = h0 * 64; t.qcol1 = h0 * 64 + 64;
                    t.Kown = GK + (size_t)row0 * 128 + kvh * 64; t.Kc = CGK + (size_t)(l * 2 + lb) * 256 * 128 + kvh * 64; t.kstride = 128; t.nOwn = 32; t.nTot = 36;
                    t.Vown = GVtL + ((size_t)lb * 128 + kvh * 64) * 2048; t.vsOwn = 2048; t.Vc = CGVT + ((size_t)(l * 2 + lb) * 128 + kvh * 64) * 256; t.vsC = 256;
                    t.O = ABR + (size_t)NTOK * 512 + (size_t)(row0 + qb * 128) * 512; t.ocol0 = h0 * 64; t.ocol1 = h0 * 64 + 64;
                    attn_unit<64, 64, false>(lds, t);
                } else {
                    const int cb = i >> 3, pr = (i >> 1) & 3, qb = i & 1, kvh = pr >> 1, h0 = kvh * 4 + (pr & 1) * 2; const int row0 = cb * CSEQ;
                    t.Q = GQ + (size_t)(row0 + qb * 128) * 512; t.qcol0 = h0 * 64; t.qcol1 = h0 * 64 + 64;
                    t.Kown = GK + (size_t)row0 * 128 + kvh * 64; t.Kc = t.Kown; t.kstride = 128; t.nOwn = 4; t.nTot = 4;
                    t.Vown = GVtC + ((size_t)cb * 128 + kvh * 64) * 256; t.vsOwn = 256; t.Vc = t.Vown; t.vsC = 256;
                    t.O = ABR + (size_t)NTOK * 512 + (size_t)(row0 + qb * 128) * 512; t.ocol0 = h0 * 64; t.ocol1 = h0 * 64 + 64;
                    attn_unit<64, 64, false>(lds, t);
                }
            }
        }
#pragma unroll 1
        for (int rep_ = 0; rep_ < REP_CONV; ++rep_) {
            PH_BEGIN
            CONV_PHASE
        }
        xcd_barrier(bar);
#pragma unroll 1
        for (int rep_ = 0; rep_ < REP_C1; ++rep_) {
            PH_BEGIN
            EpiCtx ec; ec.l = l; ec.out = a.out; ec.ws = ws; ec.qn = nullptr; ec.kn = nullptr;
            pg8::Gemm g{P_ABR, (const bfraw*)(ws + WS_WBR + l * WBR_L), 3 * NTOK, 3 * 1024, 512}; pg8::BranchOrder S{bid};
            pg8::EpiBranch E{ec};
            pg8::gemm_phase<pg8::EpiBranch, pg8::BranchOrder, true, true>(lds, g, S, E);
        }
        xcd_barrier(bar);
#pragma unroll 1
        for (int rep_ = 0; rep_ < REP_C2; ++rep_) {
            PH_BEGIN
            EpiCtx ec; ec.l = l; ec.out = a.out; ec.ws = ws; ec.qn = nullptr; ec.kn = nullptr;
            pg8::Gemm g{P_HB, (const bfraw*)(ws + WS_WO + l * WO_L), NTOK, DM, DM}; pg8::StaticOrder S; S.init(NTOK, DM, G, bid);
            pg8::EpiRes E{ec, M_G1, (rep_ + 1 < REP_C2) ? (bfraw*)(ws + WS_ABR) : nullptr};
            pg8::gemm_phase<pg8::EpiRes, pg8::StaticOrder, true, true>(lds, g, S, E);
        }
        xcd_barrier(bar);
        {
            PH_BEGIN
            for (int m = gw; m < NTOK; m += NGW) {
                const int cond = m < NCTX ? 0 : 1 + ((m - NCTX) >> 11);
                const float* md = P_MOD + (size_t)(l * 3 + cond) * 6144;
                modnorm_row(P_X + (size_t)m * DM, nullptr, P_HB + (size_t)m * DM, a.in[11] + l * DM, md + M_SH2, md + M_SC2, lane);
            }
        }
        xcd_barrier(bar);
#pragma unroll 1
        for (int rep_ = 0; rep_ < REP_M1; ++rep_) {
            PH_BEGIN
            EpiCtx ec; ec.l = l; ec.out = a.out; ec.ws = ws; ec.qn = nullptr; ec.kn = nullptr;
            pg8::Gemm g{P_HB, (const bfraw*)(ws + WS_W1 + l * W1_L), NTOK, FF, DM}; pg8::StaticOrder S; S.init(NTOK, FF, G, bid);
            pg8::EpiRelu2 E{ec};
            pg8::gemm_phase<pg8::EpiRelu2, pg8::StaticOrder, true, true>(lds, g, S, E);
        }
        xcd_barrier(bar);
#pragma unroll 1
        for (int rep_ = 0; rep_ < REP_M2; ++rep_) {
            PH_BEGIN
            EpiCtx ec; ec.l = l; ec.out = a.out; ec.ws = ws; ec.qn = nullptr; ec.kn = nullptr;
            pg8::Gemm g{(const bfraw*)P_PROJ, (const bfraw*)(ws + WS_W2 + l * W2_L), NTOK, DM, FF}; pg8::StaticOrder S; S.init(NTOK, DM, G, bid);
            pg8::EpiRes E{ec, M_G2, (rep_ + 1 < REP_M2) ? (bfraw*)(ws + WS_HB) : nullptr};
            pg8::gemm_phase<pg8::EpiRes, pg8::StaticOrder, true, true>(lds, g, S, E);
        }
        xcd_barrier(bar);
        {
            PH_BEGIN
            if (l == 0) {
                for (int m = gw; m < NTOK; m += NGW) {
                    const int cond = m < NCTX ? 0 : 1 + ((m - NCTX) >> 11);
                    const float* md = P_MOD + (size_t)(3 + cond) * 6144;
                    modnorm_row(P_X + (size_t)m * DM, nullptr, P_HB + (size_t)m * DM, a.in[10] + DM, md + M_SH1, md + M_SC1, lane);
                }
            } else {
                for (int m = gw; m < NTOK; m += NGW) finalnorm_row(P_X + (size_t)m * DM, a.in[30], lane);
            }
        }
        if (l == 0) xcd_barrier(bar);
    }
}

extern "C" void kernel_launch(void* const* d_in, const int* in_sizes, int n_in, void* d_out, int out_size, void* d_ws, size_t ws_size, hipStream_t stream) {
    static int grid_blocks = 0;
    if (grid_blocks == 0) {
        if (n_in != 31 || ws_size < WS_END) { fprintf(stderr, "kernel_launch: unexpected n_in %d / ws_size %zu\n", n_in, ws_size); grid_blocks = -1; return; }
        int dev = 0, cus = 0, per_cu = 0;
        hipGetDevice(&dev);
        hipDeviceGetAttribute(&cus, hipDeviceAttributeMultiprocessorCount, dev);
        if (hipFuncSetAttribute((const void*)fwd_kernel, hipFuncAttributeMaxDynamicSharedMemorySize, LDS_BYTES) != hipSuccess) { fprintf(stderr, "kernel_launch: hipFuncSetAttribute failed\n"); grid_blocks = -1; return; }
        if (hipOccupancyMaxActiveBlocksPerMultiprocessor(&per_cu, (const void*)fwd_kernel, 512, LDS_BYTES) != hipSuccess || per_cu < 1) { fprintf(stderr, "kernel_launch: occupancy query gave %d\n", per_cu); (void)hipGetLastError(); per_cu = 1; }
        grid_blocks = cus * 1;
    }
    if (grid_blocks < 0) return;
    KArgs a{};
    for (int i = 0; i < 31; ++i) a.in[i] = (const float*)d_in[i];
    a.out = (float*)d_out; a.ws = (unsigned char*)d_ws;
    void* args[] = {&a};
    hipError_t e = hipLaunchCooperativeKernel((const void*)fwd_kernel, dim3(grid_blocks), dim3(512), args, LDS_BYTES, stream);
    if (e != hipSuccess) fprintf(stderr, "cooperative launch failed: %s (grid %d)\n", hipGetErrorString(e), grid_blocks);
}
```

```cpp
#include <hip/hip_runtime.h>
#include <hip/hip_cooperative_groups.h>
#include <cstdio>
#include <cstdint>
namespace cg = cooperative_groups;

typedef float f32x4_t __attribute__((ext_vector_type(4)));
typedef float f32x2_t __attribute__((ext_vector_type(2)));
typedef float f32x16_t __attribute__((ext_vector_type(16)));
typedef unsigned u32x4_t __attribute__((ext_vector_type(4)));
typedef unsigned u32x2_t __attribute__((ext_vector_type(2)));
typedef short s16x8_t __attribute__((ext_vector_type(8)));
typedef __bf16 bf16x2_t __attribute__((ext_vector_type(2)));
typedef unsigned short bfraw;

__device__ __forceinline__ unsigned pk2(float lo, float hi) { f32x2_t v = {lo, hi}; bf16x2_t b = __builtin_convertvector(v, bf16x2_t); return __builtin_bit_cast(unsigned, b); }
__device__ __forceinline__ bfraw f2bf(float x) { return (bfraw)(pk2(x, 0.f) & 0xffffu); }
__device__ __forceinline__ float bf2f(bfraw x) { return __builtin_bit_cast(float, (unsigned)x << 16); }
__device__ __forceinline__ float sigmoidf_(float x) { return __builtin_amdgcn_rcpf(1.0f + __builtin_amdgcn_exp2f(-1.4426950408889634f * x)); }

constexpr int DM = 1024, NTOK = 8192, NCTX = 4096, CSEQ = 256, LSEQ = 2048, PAST = 256, INW = 6400, FF = 4096;
constexpr float NEPS = 1e-6f;
constexpr float QSCALE = 0.125f * 1.4426950408889634f;
constexpr size_t O_X = 0, O_NDK = 8388608, O_NDV = 12582912, O_NGK = 16777216, O_NGV = 17825792;
constexpr int M_SH1 = 0, M_SC1 = 1024, M_G1 = 2048, M_SH2 = 3072, M_SC2 = 4096, M_G2 = 5120;

struct EpiCtx { int l; float* out; unsigned char* ws; const float* qn; const float* kn; };
#define LAS __attribute__((address_space(3)))
constexpr size_t MiB = 1u << 20;
constexpr size_t WS_MOD = 0, WS_ROPEC = 160 * 1024, WS_ROPES = 164 * 1024, WS_BAR = 192 * 1024;
constexpr size_t WS_CDK = 1 * MiB, WS_CDVT = 2 * MiB, WS_CGK = 3 * MiB, WS_CGVT = 3 * MiB + 256 * 1024;
constexpr size_t WS_WIN = 4 * MiB, WIN_L = (size_t)INW * DM * 2;
constexpr size_t WS_WBR = 29 * MiB, WBR_L = 3 * MiB;
constexpr size_t WS_WO = 35 * MiB, WO_L = 2 * MiB;
constexpr size_t WS_W1 = 39 * MiB, W1_L = 8 * MiB;
constexpr size_t WS_W2 = 55 * MiB, W2_L = 8 * MiB;
constexpr size_t WS_HB = 72 * MiB;
constexpr size_t WS_ABR = 88 * MiB;
constexpr size_t WS_PROJ = 112 * MiB;
constexpr size_t P_DQ = 0, P_DK = 8 * MiB, P_DVTC = 16 * MiB, P_DVTL = 20 * MiB, P_GQ = 24 * MiB, P_GK = 32 * MiB, P_GVTC = 34 * MiB, P_GVTL = 35 * MiB, P_U = 36 * MiB, P_G = 44 * MiB;
constexpr size_t WS_END = 204 * MiB;
constexpr int LDS_BYTES = 147456;

__device__ __forceinline__ void st_bf4(bfraw* p, f32x4_t v) { u32x2_t w; w.x = pk2(v[0], v[1]); w.y = pk2(v[2], v[3]); *(u32x2_t*)p = w; }
__device__ __forceinline__ float dot4(f32x4_t v) { return (v[0] * v[0] + v[1] * v[1]) + (v[2] * v[2] + v[3] * v[3]); }
namespace pg8 {
#define PG8_LAS __attribute__((address_space(3)))
typedef unsigned short bf16_t;
typedef short bf16x8 __attribute__((ext_vector_type(8)));
typedef float f32x4 __attribute__((ext_vector_type(4)));
typedef unsigned u32x4 __attribute__((ext_vector_type(4)));
constexpr int BM = 256, BK = 64, HALF = 128, HTB = HALF * BK * 2  , STAGE_BYTES = 8 * HTB, NXCD = 8, WGM = 8;

__host__ __device__ __forceinline__ int lds_byte(int r, int c) { const int st = (r >> 4) * 2 + (c >> 5), rr = r & 15, cc = c & 31, ob = rr * 64 + cc * 2; return st * 1024 + (ob ^ (((ob >> 9) & 1) << 5)); }
__host__ __device__ __forceinline__ void stage_rc(int b, int& R, int& C) { const int st = b / 1024, sb = b % 1024, swz = sb ^ (((sb >> 9) & 1) << 5); R = (st >> 1) * 16 + swz / 64; C = (st & 1) * 32 + (swz % 64) / 2; }
__host__ __device__ __forceinline__ int perm32(int rho) { const int n = rho >> 4, i = rho & 15; return 8 * (i >> 2) + 4 * n + (i & 3); }

struct Unit { int pm, pn; };
struct Gemm { const bf16_t* A; const bf16_t* Bt; int M, N, K; };

struct StaticOrder {
    int nM, nN, nwg, G, c;
    __host__ __device__ void init(int M, int N, int G_, int c_) { nM = M / BM; nN = N / BM; nwg = nM * nN; G = G_; c = c_; }
    __host__ __device__ bool next(int i, Unit& u) const {
        const long L = (long)i * G + c; if (L >= nwg) return false;
        int wgid = (int)L; { const int q = nwg / NXCD, r = nwg % NXCD, xcd = wgid % NXCD, off = wgid / NXCD; wgid = (xcd < r ? xcd * (q + 1) : r * (q + 1) + (xcd - r) * q) + off; }
        const int nig = WGM * nN, gid = wgid / nig, fm = gid * WGM, gsz = (nM - fm) < WGM ? (nM - fm) : WGM;
        u.pm = fm + ((wgid % nig) % gsz); u.pn = (wgid % nig) / gsz; return true;
    }
    __device__ __forceinline__ void a_ready(const Unit&) const {}
    __device__ __forceinline__ void done(const Unit&) const {}
};

__device__ __forceinline__ unsigned cvt_pk_bf16(float lo, float hi) { unsigned r; asm volatile("v_cvt_pk_bf16_f32 %0, %1, %2" : "=v"(r) : "v"(lo), "v"(hi)); return r; }
typedef float f32x2 __attribute__((ext_vector_type(2)));
#define EC_DQ ((bfraw*)(c.ws + WS_PROJ + P_DQ))
#define EC_DK ((bfraw*)(c.ws + WS_PROJ + P_DK))
#define EC_DVtC ((bfraw*)(c.ws + WS_PROJ + P_DVTC))
#define EC_DVtL ((bfraw*)(c.ws + WS_PROJ + P_DVTL))
#define EC_GQ ((bfraw*)(c.ws + WS_PROJ + P_GQ))
#define EC_GK ((bfraw*)(c.ws + WS_PROJ + P_GK))
#define EC_GVtC ((bfraw*)(c.ws + WS_PROJ + P_GVTC))
#define EC_GVtL ((bfraw*)(c.ws + WS_PROJ + P_GVTL))
#define EC_U ((bfraw*)(c.ws + WS_PROJ + P_U))
#define EC_G ((bfraw*)(c.ws + WS_PROJ + P_G))
#define EC_TMP ((float*)(c.ws + WS_PROJ))
#define EC_HB ((bfraw*)(c.ws + WS_HB))
#define EC_HID ((bfraw*)(c.ws + WS_PROJ))
#define EC_mod ((const float*)(c.ws + WS_MOD))
#define EC_ropec ((const float*)(c.ws + WS_ROPEC))
#define EC_ropes ((const float*)(c.ws + WS_ROPES))

struct EpiIn {
    static constexpr bool PERM = false, AFTER_DRAIN = false;
    EpiCtx c;
    __device__ __forceinline__ void operator()(const f32x4 (&acc)[2][2][4][2], const Unit& u, int wr, int wc, int fr_, int fq_) const {
        int fr = fr_, fq = fq_; asm volatile("" : "+v"(fr), "+v"(fq));
        const int pn = u.pn, pm = u.pm, l = c.l;
        const bool ctx = pm < 16;
        const int rbase = pm * 256 + wr * 64 + fr;
        const int lb = (pm - 16) >> 3;
        if (pn < 2) {
#pragma unroll
            for (int ai = 0; ai < 2; ++ai)
#pragma unroll
                for (int m = 0; m < 4; ++m) {
                    const int row = rbase + ai * 128 + m * 16; const int t = (row - NCTX) & (LSEQ - 1);
                    f32x4 cs = {1.f, 1.f, 1.f, 1.f}, sn = {0.f, 0.f, 0.f, 0.f};
                    if (!ctx) { const int pos = (wc & 1) ? (t & 63) : (t >> 6); cs = *(const f32x4*)(EC_ropec + pos * 16 + 4 * fq); sn = *(const f32x4*)(EC_ropes + pos * 16 + 4 * fq); }
#pragma unroll
                    for (int bj = 0; bj < 2; ++bj) {
                        const f32x4 x1 = acc[ai][bj][m][0], x2 = acc[ai][bj][m][1];
                        const f32x4 o1 = (x1 * cs - x2 * sn) * QSCALE, o2 = (x2 * cs + x1 * sn) * QSCALE;
                        bfraw* p = EC_DQ + (size_t)row * 512 + pn * 256 + bj * 128 + wc * 32 + 4 * fq;
                        st_bf4(p, o1); st_bf4(p + 16, o2);
                    }
                }
        } else if (pn < 4) {
#pragma unroll
            for (int ai = 0; ai < 2; ++ai)
#pragma unroll
                for (int m = 0; m < 4; ++m) {
                    const int row = rbase + ai * 128 + m * 16; const int t = (row - NCTX) & (LSEQ - 1);
                    f32x4 cs = {1.f, 1.f, 1.f, 1.f}, sn = {0.f, 0.f, 0.f, 0.f};
                    if (!ctx) { const int pos = (wc & 1) ? (t & 63) : (t >> 6); cs = *(const f32x4*)(EC_ropec + pos * 16 + 4 * fq); sn = *(const f32x4*)(EC_ropes + pos * 16 + 4 * fq); }
#pragma unroll
                    for (int bj = 0; bj < 2; ++bj) {
                        const f32x4 x1 = acc[ai][bj][m][0], x2 = acc[ai][bj][m][1];
                        const f32x4 o1 = x1 * cs - x2 * sn, o2 = x2 * cs + x1 * sn;
                        const int colb = (pn - 2) * 256 + bj * 128 + wc * 32 + 4 * fq;
                        if (ctx) { float* op = c.out + O_NDK + ((size_t)(pm * 2 + l) * 256 + (row & 255)) * 512 + colb; *(f32x4*)op = x1; *(f32x4*)(op + 16) = x2; }
                        bfraw* p = EC_DK + (size_t)row * 512 + colb;
                        st_bf4(p, o1); st_bf4(p + 16, o2);
                    }
                }
        } else if (pn < 6) {
#pragma unroll
            for (int ai = 0; ai < 2; ++ai)
#pragma unroll
                for (int m = 0; m < 4; ++m) {
                    const int row = rbase + ai * 128 + m * 16; const int t = (row - NCTX) & (LSEQ - 1); const int s = row & 255;
#pragma unroll
                    for (int bj = 0; bj < 2; ++bj)
#pragma unroll
                        for (int n = 0; n < 2; ++n) {
                            const f32x4 x = acc[ai][bj][m][n];
                            const int colb = (pn - 4) * 256 + bj * 128 + wc * 32 + 16 * n + 4 * fq;
                            if (ctx) { *(f32x4*)(c.out + O_NDV + ((size_t)(pm * 2 + l) * 256 + s) * 512 + colb) = x;
#pragma unroll
                                for (int j = 0; j < 4; ++j) EC_DVtC[((size_t)pm * 512 + colb + j) * 256 + s] = f2bf(x[j]); }
                            else {
#pragma unroll
                                for (int j = 0; j < 4; ++j) EC_DVtL[((size_t)lb * 512 + colb + j) * 2048 + t] = f2bf(x[j]); }
                        }
                }
        } else if (pn < 8 || (pn == 8 && wc < 2)) {
            const bool isq = pn < 8;
            const float* nw = isq ? c.qn : c.kn;
            const int head = isq ? 4 * (pn - 6) + wc : wc;
            const float osc = isq ? QSCALE : 1.0f;
#pragma unroll
            for (int ai = 0; ai < 2; ++ai)
#pragma unroll
                for (int m = 0; m < 4; ++m) {
                    const int row = rbase + ai * 128 + m * 16; const int t = (row - NCTX) & (LSEQ - 1);
                    float ss = (dot4(acc[ai][0][m][0]) + dot4(acc[ai][0][m][1])) + (dot4(acc[ai][1][m][0]) + dot4(acc[ai][1][m][1]));
                    ss += __shfl_xor(ss, 16); ss += __shfl_xor(ss, 32);
                    const float r = __builtin_amdgcn_rsqf(ss * (1.0f / 64.0f) + NEPS);
#pragma unroll
                    for (int bj = 0; bj < 2; ++bj) {
                        const f32x4 wa = *(const f32x4*)(nw + 32 * bj + 4 * fq), wb = *(const f32x4*)(nw + 32 * bj + 16 + 4 * fq);
                        const f32x4 x1 = acc[ai][bj][m][0] * r * wa, x2 = acc[ai][bj][m][1] * r * wb;
                        f32x4 cs = {1.f, 1.f, 1.f, 1.f}, sn = {0.f, 0.f, 0.f, 0.f};
                        if (!ctx) { const int pos = bj ? (t & 63) : (t >> 6); cs = *(const f32x4*)(EC_ropec + pos * 16 + 4 * fq); sn = *(const f32x4*)(EC_ropes + pos * 16 + 4 * fq); }
                        const f32x4 o1 = (x1 * cs - x2 * sn) * osc, o2 = (x2 * cs + x1 * sn) * osc;
                        const int d0 = head * 64 + 32 * bj + 4 * fq;
                        if (isq) { bfraw* p = EC_GQ + (size_t)row * 512 + d0; st_bf4(p, o1); st_bf4(p + 16, o2); }
                        else {
                            if (ctx) { float* op = c.out + O_NGK + ((size_t)(pm * 2 + l) * 256 + (row & 255)) * 128 + d0; *(f32x4*)op = x1; *(f32x4*)(op + 16) = x2; }
                            bfraw* p = EC_GK + (size_t)row * 128 + d0; st_bf4(p, o1); st_bf4(p + 16, o2);
                        }
                    }
                    asm volatile("" ::: "memory");
                }
        } else if (pn == 8) {
            const int kvh = wc - 2;
#pragma unroll
            for (int ai = 0; ai < 2; ++ai)
#pragma unroll
                for (int m = 0; m < 4; ++m) {
                    const int row = rbase + ai * 128 + m * 16; const int t = (row - NCTX) & (LSEQ - 1); const int s = row & 255;
#pragma unroll
                    for (int bj = 0; bj < 2; ++bj)
#pragma unroll
                        for (int n = 0; n < 2; ++n) {
                            const f32x4 x = acc[ai][bj][m][n];
                            const int d0 = kvh * 64 + 32 * bj + 16 * n + 4 * fq;
                            if (ctx) { *(f32x4*)(c.out + O_NGV + ((size_t)(pm * 2 + l) * 256 + s) * 128 + d0) = x;
#pragma unroll
                                for (int j = 0; j < 4; ++j) EC_GVtC[((size_t)pm * 128 + d0 + j) * 256 + s] = f2bf(x[j]); }
                            else {
#pragma unroll
                                for (int j = 0; j < 4; ++j) EC_GVtL[((size_t)lb * 128 + d0 + j) * 2048 + t] = f2bf(x[j]); }
                        }
                }
        } else if (pn < 13) {
            const int q = pn - 9;
#pragma unroll
            for (int ai = 0; ai < 2; ++ai)
#pragma unroll
                for (int m = 0; m < 4; ++m) {
                    const int row = rbase + ai * 128 + m * 16;
#pragma unroll
                    for (int n = 0; n < 2; ++n) {
                        const f32x4 a = acc[ai][0][m][n], g = acc[ai][1][m][n];
                        f32x4 o; o[0] = a[0] * sigmoidf_(g[0]); o[1] = a[1] * sigmoidf_(g[1]); o[2] = a[2] * sigmoidf_(g[2]); o[3] = a[3] * sigmoidf_(g[3]);
                        st_bf4(EC_U + (size_t)row * 512 + q * 128 + wc * 32 + 16 * n + 4 * fq, o);
                    }
                }
        } else {
#pragma unroll
            for (int ai = 0; ai < 2; ++ai)
#pragma unroll
                for (int m = 0; m < 4; ++m) {
                    const int row = rbase + ai * 128 + m * 16;
#pragma unroll
                    for (int bj = 0; bj < 2; ++bj)
#pragma unroll
                        for (int n = 0; n < 2; ++n) {
                            const f32x4 g = acc[ai][bj][m][n];
                            f32x4 o; o[0] = sigmoidf_(g[0]); o[1] = sigmoidf_(g[1]); o[2] = sigmoidf_(g[2]); o[3] = sigmoidf_(g[3]);
                            st_bf4(EC_G + (size_t)row * 3072 + (pn - 13) * 256 + bj * 128 + wc * 32 + 16 * n + 4 * fq, o);
                        }
                }
        }
    }
};

struct EpiBranch {
    static constexpr bool PERM = true, AFTER_DRAIN = false;
    EpiCtx c;
    __device__ __forceinline__ void operator()(const f32x4 (&acc)[2][2][4][2], const Unit& u, int wr, int wc, int fr_, int fq_) const {
        int fr = fr_, fq = fq_; asm volatile("" : "+v"(fr), "+v"(fq));
        const int br = u.pm >> 5, pm = u.pm & 31, pn = u.pn & 3;
#pragma unroll
        for (int ai = 0; ai < 2; ++ai)
#pragma unroll
            for (int m = 0; m < 4; ++m) {
                const int row = pm * 256 + ai * 128 + wr * 64 + m * 16 + fr;
#pragma unroll
                for (int bj = 0; bj < 2; ++bj) {
                    const int col8 = pn * 256 + bj * 128 + wc * 32 + 8 * fq;
                    const u32x4 gw = *(const u32x4*)(EC_G + (size_t)row * 3072 + br * 1024 + col8);
                    f32x4 g0, g1;
                    g0[0] = __builtin_bit_cast(float, gw.x << 16); g0[1] = __builtin_bit_cast(float, gw.x & 0xffff0000u);
                    g0[2] = __builtin_bit_cast(float, gw.y << 16); g0[3] = __builtin_bit_cast(float, gw.y & 0xffff0000u);
                    g1[0] = __builtin_bit_cast(float, gw.z << 16); g1[1] = __builtin_bit_cast(float, gw.z & 0xffff0000u);
                    g1[2] = __builtin_bit_cast(float, gw.w << 16); g1[3] = __builtin_bit_cast(float, gw.w & 0xffff0000u);
                    f32x4 v0 = acc[ai][bj][m][0] * g0, v1 = acc[ai][bj][m][1] * g1;
                    float* tp = EC_TMP + (size_t)row * 1024 + col8;
                    if (br == 0) { *(f32x4*)tp = v0; *(f32x4*)(tp + 4) = v1; }
                    else {
                        v0 += *(const f32x4*)tp; v1 += *(const f32x4*)(tp + 4);
                        if (br == 1) { *(f32x4*)tp = v0; *(f32x4*)(tp + 4) = v1; }
                        else { u32x4 w; w.x = pk2(v0[0], v0[1]); w.y = pk2(v0[2], v0[3]); w.z = pk2(v1[0], v1[1]); w.w = pk2(v1[2], v1[3]); *(u32x4*)(EC_HB + (size_t)row * 1024 + col8) = w; }
                    }
                }
            }
    }
};
struct BranchOrder {
    int c;
    __device__ bool next(int i, Unit& u) const { if (c >= 128 || i >= 3) return false; u.pm = i * 32 + (c >> 2); u.pn = i * 4 + (c & 3); return true; }
    __device__ __forceinline__ void a_ready(const Unit&) const {}
    __device__ __forceinline__ void done(const Unit&) const {}
};

struct EpiRes {
    static constexpr bool PERM = false, AFTER_DRAIN = false;
    EpiCtx c; int goff; bfraw* dummy;
    __device__ __forceinline__ void operator()(const f32x4 (&acc)[2][2][4][2], const Unit& u, int wr, int wc, int fr_, int fq_) const {
        int fr = fr_, fq = fq_; asm volatile("" : "+v"(fr), "+v"(fq));
        const int pm = u.pm, pn = u.pn;
        const int cond = pm < 16 ? 0 : 1 + ((pm - 16) >> 3);
        const float* gp = EC_mod + (size_t)(c.l * 3 + cond) * 6144 + goff;
#pragma unroll
        for (int bj = 0; bj < 2; ++bj)
#pragma unroll
            for (int n = 0; n < 2; ++n) {
                const int colb = pn * 256 + bj * 128 + wc * 32 + 16 * n + 4 * fq;
                const f32x4 gv = *(const f32x4*)(gp + colb);
#pragma unroll
                for (int ai = 0; ai < 2; ++ai)
#pragma unroll
                    for (int m = 0; m < 4; ++m) {
                        const int row = pm * 256 + ai * 128 + wr * 64 + m * 16 + fr;
                        float* xp = c.out + O_X + (size_t)row * 1024 + colb;
                        const f32x4 nv = *(const f32x4*)xp + gv * acc[ai][bj][m][n];
                        if (dummy) st_bf4(dummy + (size_t)row * 1024 + colb, nv); else *(f32x4*)xp = nv;
                    }
            }
    }
};

struct EpiRelu2 {
    static constexpr bool PERM = true, AFTER_DRAIN = false;
    EpiCtx c;
    __device__ __forceinline__ void operator()(const f32x4 (&acc)[2][2][4][2], const Unit& u, int wr, int wc, int fr_, int fq_) const {
        int fr = fr_, fq = fq_; asm volatile("" : "+v"(fr), "+v"(fq));
#pragma unroll
        for (int ai = 0; ai < 2; ++ai)
#pragma unroll
            for (int m = 0; m < 4; ++m) {
                const int row = u.pm * 256 + ai * 128 + wr * 64 + m * 16 + fr;
#pragma unroll
                for (int bj = 0; bj < 2; ++bj) {
                    f32x4 v0 = acc[ai][bj][m][0], v1 = acc[ai][bj][m][1];
#pragma unroll
                    for (int j = 0; j < 4; ++j) { v0[j] = __builtin_fmaxf(v0[j], 0.f); v1[j] = __builtin_fmaxf(v1[j], 0.f); }
                    v0 = v0 * v0; v1 = v1 * v1;
                    u32x4 w; w.x = pk2(v0[0], v0[1]); w.y = pk2(v0[2], v0[3]); w.z = pk2(v1[0], v1[1]); w.w = pk2(v1[2], v1[3]);
                    *(u32x4*)(EC_HID + (size_t)row * 4096 + u.pn * 256 + bj * 128 + wc * 32 + 8 * fq) = w;
                }
            }
    }
};
template <class Epi, class Sched, bool ALIGN_EPI = false, bool SP2 = false>
__device__ __forceinline__ void gemm_phase(PG8_LAS unsigned char* lds, const Gemm g, const Sched& S, const Epi& E) {
    int tid_ = threadIdx.x; asm volatile("" : "+v"(tid_));
    const int tid = tid_, wid = __builtin_amdgcn_readfirstlane(tid >> 6), lane = tid & 63, wr = wid >> 2, wc = wid & 3, fr = lane & 15, fq = lane >> 4;
    const int K = g.K, nt = K / BK;
    unsigned voffA[2], voffB[2];
#pragma unroll
    for (int i = 0; i < 2; ++i) { int R, C; stage_rc(tid * 16 + i * 8192, R, C); const int Rb = Epi::PERM ? ((R & ~31) + perm32(R & 31)) : R;
        voffA[i] = (unsigned)(R * K + C) * 2u; voffB[i] = (unsigned)(Rb * K + C) * 2u; }
    const size_t kstep = (size_t)(BK * 2);
    const size_t hstep = (size_t)HALF * K * 2;
    const size_t tstep = 2 * hstep;
    const unsigned ldsw = (unsigned)wid * 1024u;
    const int aoff = lds_byte(wr * 64 + fr, fq * 8), boff = lds_byte(wc * 32 + fr, fq * 8);
#define PG8_SA(b, h) (((b) * 2 + (h)) * HTB)
#define PG8_SB(b, h) ((4 + (b) * 2 + (h)) * HTB)
#define PG8_STAGE(bufoff, gbase, voff) do { _Pragma("unroll") for (int _i = 0; _i < 2; ++_i) \
        __builtin_amdgcn_global_load_lds((const unsigned*)((const char*)(gbase) + (voff)[_i]), (PG8_LAS unsigned*)(lds + (bufoff) + ldsw + _i * 8192), 16, 0, 0); } while (0)
#define PG8_LDA(dst, b, h) do { _Pragma("unroll") for (int m = 0; m < 4; ++m) _Pragma("unroll") for (int k = 0; k < 2; ++k) dst[m][k] = *(const PG8_LAS bf16x8*)(lds + PG8_SA(b, h) + aoff + m * 2048 + k * 1024); } while (0)
#define PG8_LDB(dst, b, h) do { _Pragma("unroll") for (int n = 0; n < 2; ++n) _Pragma("unroll") for (int k = 0; k < 2; ++k) dst[n][k] = *(const PG8_LAS bf16x8*)(lds + PG8_SB(b, h) + boff + n * 2048 + k * 1024); } while (0)
#define PG8_MMA(ai, bj, At, Bt) do { __builtin_amdgcn_s_setprio(1); _Pragma("unroll") for (int m = 0; m < 4; ++m) _Pragma("unroll") for (int n = 0; n < 2; ++n) _Pragma("unroll") for (int k = 0; k < 2; ++k) \
        acc[ai][bj][m][n] = __builtin_amdgcn_mfma_f32_16x16x32_bf16(Bt[n][k], At[m][k], acc[ai][bj][m][n], 0, 0, 0); __builtin_amdgcn_s_setprio(0); } while (0)
#define PG8_WAIT_V(n) asm volatile("s_waitcnt vmcnt(" #n ")" ::: "memory")
#define PG8_WAIT_L(n) asm volatile("s_waitcnt lgkmcnt(" #n ")" ::: "memory")
#define PG8_BAR __builtin_amdgcn_s_barrier()
#define PG8_SCHED __builtin_amdgcn_sched_barrier(0)
    Unit cur, nxt; int ui = 0;
    if (!S.next(0, cur)) return;
    f32x4 acc[2][2][4][2];
#pragma unroll
    for (int a = 0; a < 2; ++a)
#pragma unroll
        for (int b = 0; b < 2; ++b)
#pragma unroll
            for (int m = 0; m < 4; ++m)
#pragma unroll
                for (int n = 0; n < 2; ++n) acc[a][b][m][n] = (f32x4){0.f, 0.f, 0.f, 0.f};
    bf16x8 At[4][2], B0[2][2], B1[2][2];
    const char* cA = (const char*)g.A + (size_t)cur.pm * tstep; const char* cB = (const char*)g.Bt + (size_t)cur.pn * tstep;
    S.a_ready(cur);
    if constexpr (SP2) {
        PG8_STAGE(PG8_SB(0, 0), cB, voffB); PG8_STAGE(PG8_SB(0, 1), cB + hstep, voffB); PG8_STAGE(PG8_SA(0, 0), cA, voffA); PG8_STAGE(PG8_SA(0, 1), cA + hstep, voffA);
        if (wr == 1) PG8_BAR;
        PG8_WAIT_V(2); PG8_BAR;
        PG8_STAGE(PG8_SB(1, 0), cB + kstep, voffB); PG8_STAGE(PG8_SA(1, 0), cA + kstep, voffA); PG8_STAGE(PG8_SB(1, 1), cB + hstep + kstep, voffB);
        PG8_WAIT_V(6); PG8_BAR;
    } else {
        PG8_STAGE(PG8_SB(0, 0), cB, voffB); PG8_STAGE(PG8_SA(0, 0), cA, voffA); PG8_STAGE(PG8_SB(0, 1), cB + hstep, voffB); PG8_STAGE(PG8_SA(0, 1), cA + hstep, voffA);
        if (wr == 1) PG8_BAR;
        PG8_WAIT_V(4); PG8_BAR;
        PG8_STAGE(PG8_SB(1, 0), cB + kstep, voffB); PG8_STAGE(PG8_SA(1, 0), cA + kstep, voffA); PG8_STAGE(PG8_SB(1, 1), cB + hstep + kstep, voffB);
        PG8_WAIT_V(6); PG8_BAR;
    }
    for (;;) {
        const bool has_next = S.next(ui + 1, nxt);
        const char* nA = has_next ? (const char*)g.A + (size_t)nxt.pm * tstep : cA; const char* nB = has_next ? (const char*)g.Bt + (size_t)nxt.pn * tstep : cB;
        for (int t = 0; t < nt; t += 2) {
            const bool last = (t == nt - 2);
            const char* a1 = cA + (size_t)(t + 1) * kstep;
            const char* a2 = last ? nA : cA + (size_t)(t + 2) * kstep; const char* b2 = last ? nB : cB + (size_t)(t + 2) * kstep;
            const char* a3 = a2 + kstep; const char* b3 = b2 + kstep;
            if (last && has_next) S.a_ready(nxt);
            if constexpr (SP2) {
            PG8_LDB(B0, 0, 0); PG8_LDB(B1, 0, 1); PG8_SCHED; PG8_LDA(At, 0, 0); PG8_STAGE(PG8_SA(1, 1), a1 + hstep, voffA);
            PG8_WAIT_V(8); PG8_WAIT_L(0); PG8_BAR; PG8_MMA(0, 0, At, B0); PG8_MMA(0, 1, At, B1); PG8_BAR; PG8_SCHED;
            PG8_LDA(At, 0, 1); PG8_STAGE(PG8_SB(0, 0), b2, voffB); PG8_STAGE(PG8_SB(0, 1), b2 + hstep, voffB); PG8_STAGE(PG8_SA(0, 0), a2, voffA);
            PG8_WAIT_V(8); PG8_WAIT_L(0); PG8_BAR; PG8_MMA(1, 0, At, B0); PG8_MMA(1, 1, At, B1); PG8_BAR; PG8_SCHED;
            PG8_LDB(B0, 1, 0); PG8_LDB(B1, 1, 1); PG8_SCHED; PG8_LDA(At, 1, 0); PG8_STAGE(PG8_SA(0, 1), a2 + hstep, voffA);
            PG8_WAIT_V(8); PG8_WAIT_L(0); PG8_BAR; PG8_MMA(0, 0, At, B0); PG8_MMA(0, 1, At, B1); PG8_BAR; PG8_SCHED;
            PG8_LDA(At, 1, 1); PG8_STAGE(PG8_SB(1, 0), b3, voffB); PG8_STAGE(PG8_SB(1, 1), b3 + hstep, voffB); PG8_STAGE(PG8_SA(1, 0), a3, voffA);
            PG8_WAIT_V(8); PG8_WAIT_L(0); PG8_BAR; PG8_MMA(1, 0, At, B0); PG8_MMA(1, 1, At, B1); PG8_BAR; PG8_SCHED;
            } else {
            PG8_LDB(B0, 0, 0); PG8_SCHED; PG8_LDA(At, 0, 0); PG8_STAGE(PG8_SA(1, 1), a1 + hstep, voffA);
            PG8_WAIT_L(8); PG8_BAR; PG8_WAIT_L(0); PG8_MMA(0, 0, At, B0); PG8_BAR; PG8_SCHED;
            PG8_LDB(B1, 0, 1); PG8_STAGE(PG8_SB(0, 0), b2, voffB);
            PG8_BAR; PG8_WAIT_L(0); PG8_MMA(0, 1, At, B1); PG8_BAR;
            PG8_LDA(At, 0, 1); PG8_STAGE(PG8_SA(0, 0), a2, voffA);
            PG8_BAR; PG8_WAIT_L(0); PG8_MMA(1, 0, At, B0); PG8_BAR; PG8_SCHED;
            PG8_STAGE(PG8_SB(0, 1), b2 + hstep, voffB);
            PG8_WAIT_V(6); PG8_BAR; PG8_MMA(1, 1, At, B1); PG8_BAR;
            PG8_LDB(B0, 1, 0); PG8_SCHED; PG8_LDA(At, 1, 0); PG8_STAGE(PG8_SA(0, 1), a2 + hstep, voffA);
            PG8_WAIT_L(8); PG8_BAR; PG8_WAIT_L(0); PG8_MMA(0, 0, At, B0); PG8_BAR; PG8_SCHED;
            PG8_LDB(B1, 1, 1); PG8_STAGE(PG8_SB(1, 0), b3, voffB);
            PG8_BAR; PG8_WAIT_L(0); PG8_MMA(0, 1, At, B1); PG8_BAR;
            PG8_LDA(At, 1, 1); PG8_STAGE(PG8_SA(1, 0), a3, voffA);
            PG8_BAR; PG8_WAIT_L(0); PG8_MMA(1, 0, At, B0); PG8_BAR; PG8_SCHED;
            PG8_STAGE(PG8_SB(1, 1), b3 + hstep, voffB);
            PG8_WAIT_V(6); PG8_BAR; PG8_MMA(1, 1, At, B1); PG8_BAR;
            }
        }
        if constexpr (ALIGN_EPI) { if (wr == 0) PG8_BAR; }
        if constexpr (!Epi::AFTER_DRAIN) { E(acc, cur, wr, wc, fr, fq); S.done(cur); }
        if (!has_next) break;
#pragma unroll
        for (int a = 0; a < 2; ++a)
#pragma unroll
            for (int b = 0; b < 2; ++b)
#pragma unroll
                for (int m = 0; m < 4; ++m)
#pragma unroll
                    for (int n = 0; n < 2; ++n) acc[a][b][m][n] = (f32x4){0.f, 0.f, 0.f, 0.f};
        cur = nxt; cA = nA; cB = nB; ++ui;
        if constexpr (ALIGN_EPI) { if (wr == 1) PG8_BAR; }
    }
    PG8_WAIT_V(0);
    if constexpr (!ALIGN_EPI) { if (wr == 0) PG8_BAR; }
    PG8_BAR;
    if constexpr (Epi::AFTER_DRAIN) { E.fused(acc, cur, wr, wc, fr, fq, lds, wid, lane); S.done(cur); }
#undef PG8_SA
#undef PG8_SB
#undef PG8_STAGE
#undef PG8_LDA
#undef PG8_LDB
#undef PG8_MMA
#undef PG8_WAIT_V
#undef PG8_WAIT_L
#undef PG8_BAR
#undef PG8_SCHED
}
}
#ifndef REP_P0
#define REP_P0 1
#endif
#ifndef REP_PA
#define REP_PA 1
#endif
#ifndef REP_ATT
#define REP_ATT 1
#endif
#ifndef REP_CONV
#define REP_CONV 1
#endif
#ifndef REP_C1
#define REP_C1 1
#endif
#ifndef REP_C2
#define REP_C2 1
#endif
#ifndef REP_M1
#define REP_M1 1
#endif
#ifndef REP_M2
#define REP_M2 1
#endif
#ifndef REP_SYNC
#define REP_SYNC 0
#endif

struct KArgs { const float* in[31]; float* out; unsigned char* ws; };
#define XB_TMO      128
#define XB_XCNT(j)  (256  + 64 * (j))
#define XB_XSUB(j)  (1280 + 64 * (j))
#define XB_XGEN(j)  (2304 + 64 * (j))
#define XB_TOP      3328
#define XB_TOPGEN   3392
#define XCD_BAR_WORDS 3456
#define XB_SPIN_CAP (1u << 18)

__device__ __forceinline__ unsigned xb_ld(unsigned* p)              { return __hip_atomic_load(p, __ATOMIC_RELAXED, __HIP_MEMORY_SCOPE_AGENT); }
__device__ __forceinline__ unsigned xb_add(unsigned* p, unsigned v) { return __hip_atomic_fetch_add(p, v, __ATOMIC_RELAXED, __HIP_MEMORY_SCOPE_AGENT); }
__device__ __forceinline__ unsigned xb_xcc_id() { return (unsigned)__builtin_amdgcn_s_getreg((3 << 11) | 20) & 0xFu; }
#define XB_SPIN(cond, bar) do { unsigned _sp = 0; while (cond) { __builtin_amdgcn_s_sleep(1); \
    if ((++_sp & 255u) == 0u) { if (xb_ld(&(bar)[XB_TMO])) break; if (_sp > XB_SPIN_CAP) { atomicAdd(&(bar)[XB_TMO], 1u); break; } } } } while (0)

struct XcdBarrier {
    unsigned* bar; unsigned x;
    volatile LAS unsigned* st;
};

__device__ __forceinline__ XcdBarrier xcd_barrier_post(unsigned* bar, volatile LAS unsigned* st) {
    XcdBarrier b; b.bar = bar; b.x = xb_xcc_id(); b.st = st;
    if (threadIdx.x == 0) (void)xb_add(&bar[XB_XCNT(b.x)], 1u);
    return b;
}
__device__ __forceinline__ void xcd_barrier_complete(unsigned* bar, unsigned x, unsigned& nloc, unsigned& nx) {
    const unsigned G = gridDim.x * gridDim.y * gridDim.z;
    unsigned sum, cnt, mine, sp = 0u;
    for (;;) {
        sum = 0u; cnt = 0u; mine = 0u;
#pragma unroll
        for (unsigned j = 0; j < 16; ++j) { const unsigned c = xb_ld(&bar[XB_XCNT(j)]); sum += c; cnt += (c > 0u) ? 1u : 0u; mine = (j == x) ? c : mine; }
        if (sum == G) break;
        __builtin_amdgcn_s_sleep(1);
        if ((++sp & 255u) == 0u) { if (xb_ld(&bar[XB_TMO])) break; if (sp > XB_SPIN_CAP) { atomicAdd(&bar[XB_TMO], 1u); break; } }
    }
    nloc = mine > 0u ? mine : 1u; nx = cnt > 0u ? cnt : 1u;
}

__device__ __forceinline__ void xcd_barrier(const XcdBarrier& b) {
    asm volatile("s_waitcnt vmcnt(0)" ::: "memory");
    __syncthreads();
    if (threadIdx.x == 0) {
        unsigned* bar = b.bar;
        __builtin_amdgcn_s_waitcnt(0);
        unsigned nloc = b.st[0], nx = b.st[1];
        if (nloc == 0u) { xcd_barrier_complete(bar, b.x, nloc, nx); b.st[0] = nloc; b.st[1] = nx; }
        const unsigned old = xb_add(&bar[XB_XSUB(b.x)], 1u);
        const unsigned gen = old / nloc;
        if (old + 1u == (gen + 1u) * nloc) {
            __builtin_amdgcn_fence(__ATOMIC_RELEASE, "agent");
            asm volatile("s_waitcnt vmcnt(0)" ::: "memory");
            const unsigned og = xb_add(&bar[XB_TOP], 1u);
            const unsigned tg = og / nx;
            if (og + 1u == (tg + 1u) * nx) xb_add(&bar[XB_TOPGEN], 1u);
            else XB_SPIN(xb_ld(&bar[XB_TOPGEN]) == tg, bar);
            __builtin_amdgcn_fence(__ATOMIC_ACQUIRE, "agent");
            xb_add(&bar[XB_XGEN(b.x)], 1u);
            asm volatile("s_waitcnt vmcnt(0)" ::: "memory");
        } else {
            XB_SPIN(xb_ld(&bar[XB_XGEN(b.x)]) == gen, bar);
            __builtin_amdgcn_fence(__ATOMIC_ACQUIRE, "agent");
            asm volatile("s_waitcnt vmcnt(0)" ::: "memory");
        }
    }
    __syncthreads();
}


__device__ __forceinline__ float wave_sum(float v) {
#pragma unroll
    for (int o = 1; o < 64; o <<= 1) v += __shfl_xor(v, o);
    return v;
}

__device__ __forceinline__ void transpose_item(const float* W, int K, int N, bfraw* WT, int vrow0, int n0, int k0, LAS float* scr, int lane) {
#pragma unroll 8
    for (int i = 0; i < 32; ++i) { const int kk = 2 * i + (lane >> 5); scr[kk * 33 + (lane & 31)] = W[(size_t)(k0 + kk) * N + n0 + (lane & 31)]; }
    asm volatile("s_waitcnt lgkmcnt(0)" ::: "memory");
    const int cch = lane & 7;
#pragma unroll
    for (int j = 0; j < 4; ++j) { const int n = (lane >> 3) + 8 * j; const LAS float* s = scr + (8 * cch) * 33 + n;
        u32x4_t o; o.x = pk2(s[0 * 33], s[1 * 33]); o.y = pk2(s[2 * 33], s[3 * 33]); o.z = pk2(s[4 * 33], s[5 * 33]); o.w = pk2(s[6 * 33], s[7 * 33]);
        *(u32x4_t*)(WT + (size_t)(vrow0 + n) * K + k0 + 8 * cch) = o; }
    asm volatile("s_waitcnt lgkmcnt(0)" ::: "memory");
}
__device__ __forceinline__ int vcol_map(int vb) {
    const int tile = vb >> 3, sub = vb & 7, bj = sub >> 2, wc = sub & 3;
    if (tile < 6 || tile >= 13) return vb * 32;
    if (tile < 8) return 1536 + (4 * (tile - 6) + wc) * 64 + 32 * bj;
    if (tile == 8) return 2048 + wc * 64 + 32 * bj;
    return (bj ? 2816 : 2304) + 128 * (tile - 9) + 32 * wc;
}
__device__ __forceinline__ void sincos_small(float x, float& s, float& c) {
    const float k = __builtin_rintf(x * 0.15915494309189535f);
    float r = __builtin_fmaf(-k, 6.2831854820251465f, x); r = __builtin_fmaf(-k, -1.7484555e-07f, r);
    const float y = r * 0.25f, y2 = y * y;
    float sp = __builtin_fmaf(y2, 2.7557319e-06f, -1.9841270e-04f); sp = __builtin_fmaf(sp, y2, 8.3333333e-03f); sp = __builtin_fmaf(sp, y2, -1.6666667e-01f); sp = __builtin_fmaf(sp * y2, y, y);
    float cp = __builtin_fmaf(y2, -2.7557319e-07f, 2.4801587e-05f); cp = __builtin_fmaf(cp, y2, -1.3888889e-03f); cp = __builtin_fmaf(cp, y2, 4.1666667e-02f); cp = __builtin_fmaf(cp, y2, -0.5f); cp = __builtin_fmaf(cp, y2, 1.0f);
    const float s2 = 2.f * sp * cp, c2 = cp * cp - sp * sp;
    s = 2.f * s2 * c2; c = c2 * c2 - s2 * s2;
}
__device__ __forceinline__ void modnorm_row(const float* xrow, float* xcopy, bfraw* orow, const float* nw, const float* shift, const float* scale, int lane) {
    const f32x4_t* xr = (const f32x4_t*)xrow + lane;
    f32x4_t v[4]; float s = 0.f;
#pragma unroll
    for (int j = 0; j < 4; ++j) { v[j] = xr[64 * j]; s += dot4(v[j]); }
    const float r = __builtin_amdgcn_rsqf(wave_sum(s) * (1.0f / DM) + NEPS);
#pragma unroll
    for (int j = 0; j < 4; ++j) {
        const int cidx = 4 * lane + 256 * j;
        if (xcopy) *((f32x4_t*)xcopy + lane + 64 * j) = v[j];
        const f32x4_t w = *(const f32x4_t*)(nw + cidx), sh = *(const f32x4_t*)(shift + cidx), sc = *(const f32x4_t*)(scale + cidx);
        const f32x4_t h = v[j] * r * w * (1.0f + sc) + sh;
        st_bf4(orow + cidx, h);
    }
}
__device__ __forceinline__ void finalnorm_row(float* xrow, const float* nw, int lane) {
    f32x4_t* xr = (f32x4_t*)xrow + lane;
    f32x4_t v[4]; float s = 0.f;
#pragma unroll
    for (int j = 0; j < 4; ++j) { v[j] = xr[64 * j]; s += dot4(v[j]); }
    const float r = __builtin_amdgcn_rsqf(wave_sum(s) * (1.0f / DM) + NEPS);
#pragma unroll
    for (int j = 0; j < 4; ++j) { const f32x4_t w = *(const f32x4_t*)(nw + 4 * lane + 256 * j); xr[64 * j] = v[j] * r * w; }
}

struct AttnArgs {
    const bfraw* Q; int qcol0, qcol1;
    const bfraw* Kown; const bfraw* Kc; int kstride;
    int nOwn, nTot;
    const bfraw* Vown; int vsOwn; const bfraw* Vc; int vsC;
    bfraw* O; int ocol0, ocol1;
    float lam, postscale; const float* subln;
};
constexpr int ATT_VOFF = 17408, ATT_XOFF = 36864;
template <int DV, int KROW, bool DIFF>
__device__ __forceinline__ void attn_unit(LAS unsigned char* lds, const AttnArgs& a) {
    constexpr int KROWB = KROW * 2 + 16, NKC = KROW / 64, NVC = DV / 64, NDB = DV / 32, KPR = KROW / 8;
    int tid_ = threadIdx.x; asm volatile("" : "+v"(tid_));
    const int tid = tid_, lane = tid & 63, r32 = lane & 31, hi = lane >> 5;
    const int wid = __builtin_amdgcn_readfirstlane(tid >> 6), g = wid >> 2, wq = wid & 3;
    const int kcol = (KROW == 128) ? g * 64 : 0;
    s16x8_t qf[4];
    { const bfraw* qp = a.Q + (size_t)(wq * 32 + r32) * 512 + (g ? a.qcol1 : a.qcol0) + hi * 8;
#pragma unroll
      for (int d0 = 0; d0 < 4; ++d0) qf[d0] = *(const s16x8_t*)(qp + d0 * 16); }
    f32x16_t o[NDB];
#pragma unroll
    for (int db = 0; db < NDB; ++db)
#pragma unroll
        for (int r = 0; r < 16; ++r) o[db][r] = 0.f;
    float m_run = -1e30f, l_run = 0.f;
    u32x4_t kreg[NKC], vreg[NVC];
    {
#pragma unroll
        for (int i = 0; i < NKC; ++i) { const int ch = tid + 512 * i, key = ch / KPR, part = ch % KPR; kreg[i] = *(const u32x4_t*)(a.Kown + (size_t)key * a.kstride + part * 8); }
#pragma unroll
        for (int i = 0; i < NVC; ++i) { const int ch = tid + 512 * i, d = ch >> 3, part = ch & 7; vreg[i] = *(const u32x4_t*)(a.Vown + (size_t)d * a.vsOwn + part * 8); }
    }
    for (int t = 0; t < a.nTot; ++t) {
        __syncthreads();
#pragma unroll
        for (int i = 0; i < NKC; ++i) { const int ch = tid + 512 * i, key = ch / KPR, part = ch % KPR; *(LAS u32x4_t*)(lds + key * KROWB + part * 16) = kreg[i]; }
#pragma unroll
        for (int i = 0; i < NVC; ++i) { const int ch = tid + 512 * i, d = ch >> 3, part = ch & 7; *(LAS u32x4_t*)(lds + ATT_VOFF + d * 144 + part * 16) = vreg[i]; }
        __syncthreads();
        if (t + 1 < a.nTot) {
            const int tn = t + 1; const bool own = tn < a.nOwn;
            const bfraw* kb = own ? a.Kown + (size_t)tn * 64 * a.kstride : a.Kc + (size_t)(tn - a.nOwn) * 64 * a.kstride;
            const bfraw* vb = own ? a.Vown + tn * 64 : a.Vc + (tn - a.nOwn) * 64; const int vs = own ? a.vsOwn : a.vsC;
#pragma unroll
            for (int i = 0; i < NKC; ++i) { const int ch = tid + 512 * i, key = ch / KPR, part = ch % KPR; kreg[i] = *(const u32x4_t*)(kb + (size_t)key * a.kstride + part * 8); }
#pragma unroll
            for (int i = 0; i < NVC; ++i) { const int ch = tid + 512 * i, d = ch >> 3, part = ch & 7; vreg[i] = *(const u32x4_t*)(vb + (size_t)d * vs + part * 8); }
        }
        f32x16_t p0, p1;
#pragma unroll
        for (int r = 0; r < 16; ++r) { p0[r] = 0.f; p1[r] = 0.f; }
#pragma unroll
        for (int d0 = 0; d0 < 4; ++d0) {
            const s16x8_t k0 = *(const LAS s16x8_t*)(lds + r32 * KROWB + (kcol + d0 * 16 + hi * 8) * 2);
            const s16x8_t k1 = *(const LAS s16x8_t*)(lds + (32 + r32) * KROWB + (kcol + d0 * 16 + hi * 8) * 2);
            p0 = __builtin_amdgcn_mfma_f32_32x32x16_bf16(k0, qf[d0], p0, 0, 0, 0);
            p1 = __builtin_amdgcn_mfma_f32_32x32x16_bf16(k1, qf[d0], p1, 0, 0, 0);
        }
        float mx = __builtin_fmaxf(p0[0], p1[0]);
#pragma unroll
        for (int r = 1; r < 16; ++r) mx = __builtin_fmaxf(mx, __builtin_fmaxf(p0[r], p1[r]));
        mx = __builtin_fmaxf(mx, __shfl_xor(mx, 32));
        const float m_new = __builtin_fmaxf(m_run, mx);
        const float alpha = __builtin_amdgcn_exp2f(m_run - m_new);
        m_run = m_new; l_run *= alpha;
#pragma unroll
        for (int db = 0; db < NDB; ++db)
#pragma unroll
            for (int r = 0; r < 16; ++r) o[db][r] *= alpha;
        float rs = 0.f;
#pragma unroll
        for (int r = 0; r < 16; ++r) { p0[r] = __builtin_amdgcn_exp2f(p0[r] - m_new); p1[r] = __builtin_amdgcn_exp2f(p1[r] - m_new); rs += p0[r] + p1[r]; }
        l_run += rs;
#pragma unroll
        for (int j = 0; j < 2; ++j)
#pragma unroll
            for (int s2 = 0; s2 < 2; ++s2) {
                u32x4_t pw;
                if (j == 0) { pw.x = pk2(p0[8 * s2 + 0], p0[8 * s2 + 1]); pw.y = pk2(p0[8 * s2 + 2], p0[8 * s2 + 3]); pw.z = pk2(p0[8 * s2 + 4], p0[8 * s2 + 5]); pw.w = pk2(p0[8 * s2 + 6], p0[8 * s2 + 7]); }
                else        { pw.x = pk2(p1[8 * s2 + 0], p1[8 * s2 + 1]); pw.y = pk2(p1[8 * s2 + 2], p1[8 * s2 + 3]); pw.z = pk2(p1[8 * s2 + 4], p1[8 * s2 + 5]); pw.w = pk2(p1[8 * s2 + 6], p1[8 * s2 + 7]); }
                const s16x8_t pf = __builtin_bit_cast(s16x8_t, pw);
                const int kb0 = 32 * j + 16 * s2 + 4 * hi;
#pragma unroll
                for (int db = 0; db < NDB; ++db) {
                    const LAS unsigned char* vp = lds + ATT_VOFF + (32 * db + r32) * 144 + kb0 * 2;
                    const u32x2_t lo = *(const LAS u32x2_t*)vp, hh = *(const LAS u32x2_t*)(vp + 16);
                    u32x4_t vw; vw.x = lo.x; vw.y = lo.y; vw.z = hh.x; vw.w = hh.y;
                    o[db] = __builtin_amdgcn_mfma_f32_32x32x16_bf16(__builtin_bit_cast(s16x8_t, vw), pf, o[db], 0, 0, 0);
                }
            }
    }
    const float ltot = l_run + __shfl_xor(l_run, 32);
    const float inv = 1.0f / ltot;
    const int qrow = wq * 32 + r32;
    if (DIFF) {
        LAS float* xch = (LAS float*)(lds + ATT_XOFF) + wq * 64 * 64 + lane;
        if (g == 1) {
            const float sc = inv * a.lam;
#pragma unroll
            for (int db = 0; db < NDB; ++db)
#pragma unroll
                for (int r = 0; r < 16; ++r) xch[(db * 16 + r) * 64] = o[db][r] * sc;
        }
        __syncthreads();
        if (g == 0) {
            float ss = 0.f;
#pragma unroll
            for (int db = 0; db < NDB; ++db)
#pragma unroll
                for (int r = 0; r < 16; ++r) { const float v = o[db][r] * inv - xch[(db * 16 + r) * 64]; o[db][r] = v; ss += v * v; }
            ss += __shfl_xor(ss, 32);
            const float rn = __builtin_amdgcn_rsqf(ss * (1.0f / 128.0f) + NEPS) * a.postscale;
            bfraw* op = a.O + (size_t)qrow * 512 + a.ocol0 + 4 * hi;
#pragma unroll
            for (int db = 0; db < NDB; ++db)
#pragma unroll
                for (int rr = 0; rr < 4; ++rr) {
                    const int d = 32 * db + 8 * rr;
                    const f32x4_t w = *(const f32x4_t*)(a.subln + d + 4 * hi);
                    f32x4_t v; v[0] = o[db][4 * rr] * rn * w[0]; v[1] = o[db][4 * rr + 1] * rn * w[1]; v[2] = o[db][4 * rr + 2] * rn * w[2]; v[3] = o[db][4 * rr + 3] * rn * w[3];
                    st_bf4(op + d, v);
                }
        }
    } else {
        bfraw* op = a.O + (size_t)qrow * 512 + (g ? a.ocol1 : a.ocol0) + 4 * hi;
#pragma unroll
        for (int db = 0; db < NDB; ++db)
#pragma unroll
            for (int rr = 0; rr < 4; ++rr) {
                f32x4_t v; v[0] = o[db][4 * rr] * inv; v[1] = o[db][4 * rr + 1] * inv; v[2] = o[db][4 * rr + 2] * inv; v[3] = o[db][4 * rr + 3] * inv;
                st_bf4(op + 32 * db + 8 * rr, v);
            }
    }
    __syncthreads();
}

__device__ __forceinline__ void conv_unit(LAS unsigned char* lds, int unit, const bfraw* U, bfraw* UC, const float* cw, const float* cb, const float* lg, const float* lbeta) {
    int tid_ = threadIdx.x; asm volatile("" : "+v"(tid_));
    const int tid = tid_, lane = tid & 63, wid = tid >> 6, c = tid;
    const int m0 = unit * 32;
    int lo, hi_;
    if (m0 < NCTX) { lo = (m0 / CSEQ) * CSEQ; hi_ = lo + CSEQ; } else { lo = NCTX + ((m0 - NCTX) / LSEQ) * LSEQ; hi_ = lo + LSEQ; }
    LAS bfraw* sin_ = (LAS bfraw*)lds;
    LAS float* sm = (LAS float*)(lds + 65536);
    LAS float* st = (LAS float*)(lds + 131072);
#pragma unroll
    for (int k = 0; k < 8; ++k) {
        const int ch = tid + 512 * k, i = ch >> 6, part = ch & 63; int tok = m0 - 15 + i;
        const bool ok = tok >= lo && tok < hi_ && i < 62;
        tok = tok < lo ? lo : (tok >= hi_ ? hi_ - 1 : tok);
        u32x4_t v = *(const u32x4_t*)(U + (size_t)tok * 512 + part * 8);
        if (!ok) v = (u32x4_t){0u, 0u, 0u, 0u};
        if (i < 62) *(LAS u32x4_t*)(sin_ + i * 512 + part * 8) = v;
    }
    float w[31];
#pragma unroll
    for (int j = 0; j < 31; ++j) w[j] = cw[j * 512 + c];
    const float bias = cb[c];
    __syncthreads();
#pragma unroll 1
    for (int g = 0; g < 4; ++g) {
        float acc[8];
#pragma unroll
        for (int o = 0; o < 8; ++o) acc[o] = bias;
        const LAS bfraw* sp = sin_ + (8 * g) * 512 + c;
#pragma unroll
        for (int i = 0; i < 38; ++i) {
            const float v = bf2f(sp[i * 512]);
#pragma unroll
            for (int o = 0; o < 8; ++o) { const int j = i - o; if (j >= 0 && j < 31) acc[o] += v * w[j]; }
        }
#pragma unroll
        for (int o = 0; o < 8; ++o) sm[(8 * g + o) * 512 + c] = acc[o];
    }
    __syncthreads();
#pragma unroll
    for (int tt = 0; tt < 4; ++tt) {
        const int tok = wid * 4 + tt; float s = 0.f, q = 0.f;
#pragma unroll
        for (int k = 0; k < 8; ++k) { const float x = sm[tok * 512 + lane + 64 * k]; s += x; q += x * x; }
        s = wave_sum(s); q = wave_sum(q);
        const float mu = s * (1.0f / 512.0f), var = __builtin_fmaxf(q * (1.0f / 512.0f) - mu * mu, 0.f);
        if (lane == 0) { st[tok * 2] = mu; st[tok * 2 + 1] = __builtin_amdgcn_rsqf(var + NEPS); }
    }
    __syncthreads();
    const float gg = lg[c], bb = lbeta[c];
#pragma unroll 8
    for (int o = 0; o < 32; ++o) {
        const float y = (sm[o * 512 + c] - st[o * 2]) * st[o * 2 + 1] * gg + bb;
        UC[(size_t)(m0 + o) * 512 + c] = f2bf(y * sigmoidf_(y));
    }
    __syncthreads();
}

template <bool PERMIN>
__device__ __forceinline__ void convert_item(const float* W, int K, int N, bfraw* WT, int vrow0, int n0, int k0, LAS float* scr, int tid) {
    const int lane = tid & 63, wave = tid >> 6;
    float v[16][4];
#pragma unroll
    for (int g4 = 0; g4 < 4; ++g4) {
        const int vc = g4 * 64 + lane;
        const int col = PERMIN ? vcol_map((vrow0 + vc) >> 5) + (vc & 31) : n0 + vc;
#pragma unroll
        for (int r = 0; r < 16; ++r) v[r][g4] = W[(size_t)(k0 + wave * 16 + r) * N + col];
    }
#pragma unroll
    for (int r = 0; r < 16; ++r)
#pragma unroll
        for (int g4 = 0; g4 < 4; ++g4) scr[(wave * 16 + r) * 257 + g4 * 64 + lane] = v[r][g4];
    __syncthreads();
#pragma unroll
    for (int it = 0; it < 8; ++it) {
        const int ch = it * 512 + tid, n = ch >> 4, kc = ch & 15;
        const LAS float* s = scr + (8 * kc) * 257 + n;
        u32x4_t o; o.x = pk2(s[0], s[257]); o.y = pk2(s[2 * 257], s[3 * 257]); o.z = pk2(s[4 * 257], s[5 * 257]); o.w = pk2(s[6 * 257], s[7 * 257]);
        *(u32x4_t*)(WT + (size_t)(vrow0 + n) * K + k0 + 8 * kc) = o;
    }
    __syncthreads();
}
#define P0_CONVERT { \
        LAS float* scr = (LAS float*)lds; \
        constexpr int I_IN = 8 * 25, I_BR = 3 * 16, I_O = 32, I_1 = 128, I_2 = 128, I_L = I_IN + I_BR + I_O + I_1 + I_2; \
        for (int it = G - 1 - bid; it < 2 * I_L; it += G) { \
            const int l = it / I_L; int r = it % I_L; \
            if (r < I_IN) { const int kb = r / 25, nt = r % 25; convert_item<true>(a.in[12] + (size_t)l * DM * INW, DM, INW, (bfraw*)(ws + WS_WIN + l * WIN_L), nt * 256, 0, kb * 128, scr, tid); continue; } r -= I_IN; \
            if (r < I_BR) { const int br = r >> 4, rr = r & 15, kb = rr >> 2, nt = rr & 3; const float* W = (br == 0 ? a.in[18] : br == 1 ? a.in[21] : a.in[26]) + (size_t)l * 512 * 1024; \
                convert_item<false>(W, 512, 1024, (bfraw*)(ws + WS_WBR + l * WBR_L) + (size_t)br * 1024 * 512, nt * 256, nt * 256, kb * 128, scr, tid); continue; } r -= I_BR; \
            if (r < I_O) { const int kb = r >> 2, nt = r & 3; convert_item<false>(a.in[27] + (size_t)l * 1024 * 1024, 1024, 1024, (bfraw*)(ws + WS_WO + l * WO_L), nt * 256, nt * 256, kb * 128, scr, tid); continue; } r -= I_O; \
            if (r < I_1) { const int kb = r >> 4, nt = r & 15; convert_item<false>(a.in[28] + (size_t)l * 1024 * 4096, 1024, 4096, (bfraw*)(ws + WS_W1 + l * W1_L), nt * 256, nt * 256, kb * 128, scr, tid); continue; } r -= I_1; \
            { const int kb = r >> 2, nt = r & 3; convert_item<false>(a.in[29] + (size_t)l * 4096 * 1024, 4096, 1024, (bfraw*)(ws + WS_W2 + l * W2_L), nt * 256, nt * 256, kb * 128, scr, tid); } \
        } }
#define CONV_PHASE \
            for (int u = bid; u < NTOK / 32; u += G) \
                conv_unit(lds, u, (const bfraw*)(P_PROJ + P_U), P_ABR + (size_t)2 * NTOK * 512, a.in[22] + l * 31 * 512, a.in[23] + l * 512, a.in[24] + l * 512, a.in[25] + l * 512);
#define PH_BEGIN GAS_ unsigned char* wsg_ = (GAS_ unsigned char*)a.ws; asm volatile("" : "+s"(wsg_)); unsigned char* ws = (unsigned char*)wsg_; int tid = threadIdx.x; asm volatile("" : "+v"(tid)); \
    const int lane = tid & 63, wave = __builtin_amdgcn_readfirstlane(tid >> 6), gw = bid * 8 + wave, NGW = G * 8; (void)lane; (void)gw; (void)NGW; (void)wave;
#define GAS_ __attribute__((address_space(1)))
#define P_MOD ((float*)(ws + WS_MOD))
#define P_HB ((bfraw*)(ws + WS_HB))
#define P_ABR ((bfraw*)(ws + WS_ABR))
#define P_PROJ (ws + WS_PROJ)
#define P_X (a.out + O_X)
__global__ void __launch_bounds__(512, 2) fwd_kernel(KArgs a) {
    extern __shared__ __attribute__((aligned(16))) unsigned char lds_raw[];
    LAS unsigned char* lds = (LAS unsigned char*)lds_raw;
    cg::grid_group grid = cg::this_grid();
    const int bid = blockIdx.x, G = gridDim.x;
    volatile LAS unsigned* bst = (volatile LAS unsigned*)(lds + 147392);
    {
        PH_BEGIN
        unsigned* barw = (unsigned*)(ws + WS_BAR);
        if (tid == 0) { bst[0] = 0u; bst[1] = 0u; }
        if (bid == 0) for (int i = tid; i < XCD_BAR_WORDS; i += 512) __hip_atomic_store(barw + i, 0u, __ATOMIC_RELAXED, __HIP_MEMORY_SCOPE_AGENT);
        __syncthreads();
    }
#pragma unroll 1
    for (int rep_ = 0; rep_ < REP_P0; ++rep_) {
        PH_BEGIN
        LAS float* sil = (LAS float*)lds;
        for (int i = tid; i < 3072; i += 512) { const int cond = i >> 10, k = i & 1023; const float v = cond == 0 ? a.in[7][k] : a.in[6][(cond - 1) * 1024 + k]; sil[i] = v * sigmoidf_(v); }
        __syncthreads();
        LAS float* part = (LAS float*)(lds + 16384);
        for (int item = bid; item < 192; item += G) {
            const int l = item / 96, nb = (item % 96) * 64;
            const float* W = a.in[8] + (size_t)l * 1024 * 6144 + nb + lane;
            const int k0 = wave * 128;
            float a0 = 0.f, a1 = 0.f, a2 = 0.f;
#pragma unroll 32
            for (int kk = 0; kk < 128; ++kk) { const float wv = W[(size_t)(k0 + kk) * 6144]; a0 += sil[k0 + kk] * wv; a1 += sil[1024 + k0 + kk] * wv; a2 += sil[2048 + k0 + kk] * wv; }
            part[(wave * 3 + 0) * 64 + lane] = a0; part[(wave * 3 + 1) * 64 + lane] = a1; part[(wave * 3 + 2) * 64 + lane] = a2;
            __syncthreads();
            if (tid < 192) { const int cnd = tid >> 6, ln = tid & 63; float s = 0.f;
#pragma unroll
                for (int wv = 0; wv < 8; ++wv) s += part[(wv * 3 + cnd) * 64 + ln];
                P_MOD[(size_t)(l * 3 + cnd) * 6144 + nb + ln] = s + a.in[9][l * 6144 + nb + ln]; }
            __syncthreads();
        }
        if (bid == G - 1) {
            float* ROPEC = (float*)(ws + WS_ROPEC); float* ROPES = (float*)(ws + WS_ROPES);
            for (int i = tid; i < 1024; i += 512) { const int pos = i >> 4, j = i & 15; const float freq = __builtin_amdgcn_exp2f(-(float)j * 0.8304820237218406f);
                float s, c; sincos_small((float)pos * freq, s, c); ROPEC[i] = c; ROPES[i] = s; }
        }
        __syncthreads();
        P0_CONVERT
        const int gt = bid * 512 + tid, GT = G * 512;
        bfraw* CDK = (bfraw*)(ws + WS_CDK); bfraw* CDVT = (bfraw*)(ws + WS_CDVT); bfraw* CGK = (bfraw*)(ws + WS_CGK); bfraw* CGVT = (bfraw*)(ws + WS_CGVT);
        for (int i = gt; i < 2 * 2 * 256 * 512; i += GT) { const int col = i & 511, s = (i >> 9) & 255, l = (i >> 17) & 1, lb = i >> 18;
            CDK[((size_t)(l * 2 + lb) * 256 + s) * 512 + col] = f2bf(a.in[2][i]); CDVT[((size_t)(l * 2 + lb) * 512 + col) * 256 + s] = f2bf(a.in[3][i]); }
        for (int i = gt; i < 2 * 2 * 256 * 128; i += GT) { const int col = i & 127, s = (i >> 7) & 255, l = (i >> 15) & 1, lb = i >> 16;
            CGK[((size_t)(l * 2 + lb) * 256 + s) * 128 + col] = f2bf(a.in[4][i]); CGVT[((size_t)(l * 2 + lb) * 128 + col) * 256 + s] = f2bf(a.in[5][i]); }
    }
    grid.sync();
    const XcdBarrier bar = xcd_barrier_post((unsigned*)(a.ws + WS_BAR), bst);
    for (int rep_ = 0; rep_ < REP_SYNC; ++rep_) xcd_barrier(bar);
    {
        PH_BEGIN
        for (int m = gw; m < NTOK; m += NGW) {
            const float* src = m < NCTX ? a.in[0] + (size_t)m * DM : a.in[1] + (size_t)(m - NCTX) * DM;
            const int cond = m < NCTX ? 0 : 1 + ((m - NCTX) >> 11);
            const float* md = P_MOD + (size_t)cond * 6144;
            modnorm_row(src, P_X + (size_t)m * DM, P_HB + (size_t)m * DM, a.in[10], md + M_SH1, md + M_SC1, lane);
        }
    }
    xcd_barrier(bar);

#pragma unroll 1
    for (int l = 0; l < 2; ++l) {
#pragma unroll 1
        for (int rep_ = 0; rep_ < REP_PA; ++rep_) {
            PH_BEGIN
            EpiCtx ec; ec.l = l; ec.out = a.out; ec.ws = ws; ec.qn = a.in[19] + l * 64; ec.kn = a.in[20] + l * 64;
            pg8::Gemm g{P_HB, (const bfraw*)(ws + WS_WIN + l * WIN_L), NTOK, INW, DM}; pg8::StaticOrder S; S.init(NTOK, INW, G, bid);
            pg8::EpiIn E{ec};
            pg8::gemm_phase<pg8::EpiIn, pg8::StaticOrder, true, true>(lds, g, S, E);
        }
        xcd_barrier(bar);
#pragma unroll 1
        for (int rep_ = 0; rep_ < REP_ATT; ++rep_) {
            PH_BEGIN
            float d1 = 0.f, d2 = 0.f;
            for (int i = 0; i < 64; ++i) { d1 += a.in[13][l * 64 + i] * a.in[14][l * 64 + i]; d2 += a.in[15][l * 64 + i] * a.in[16][l * 64 + i]; }
            const float lam_init = l == 0 ? 0.2f : 0.35550907f;
            const float lam = __builtin_amdgcn_exp2f(d1 * 1.4426950408889634f) - __builtin_amdgcn_exp2f(d2 * 1.4426950408889634f) + lam_init;
            const bfraw* CDK = (const bfraw*)(ws + WS_CDK); const bfraw* CDVT = (const bfraw*)(ws + WS_CDVT); const bfraw* CGK = (const bfraw*)(ws + WS_CGK); const bfraw* CGVT = (const bfraw*)(ws + WS_CGVT);
            bfraw* const DQ = (bfraw*)(P_PROJ + P_DQ); bfraw* const DK = (bfraw*)(P_PROJ + P_DK); bfraw* const DVtC = (bfraw*)(P_PROJ + P_DVTC); bfraw* const DVtL = (bfraw*)(P_PROJ + P_DVTL);
            bfraw* const GQ = (bfraw*)(P_PROJ + P_GQ); bfraw* const GK = (bfraw*)(P_PROJ + P_GK); bfraw* const GVtC = (bfraw*)(P_PROJ + P_GVTC); bfraw* const GVtL = (bfraw*)(P_PROJ + P_GVTL);
            bfraw* const ABR = P_ABR;
            for (int k = 0; ; ++k) {
                int u;
                if (G == 256) { if (bid < 128) { if (k > 0) break; u = bid; } else { if (k > 2) break; u = 128 * (k + 1) + (bid - 128); } }
                else { u = bid + k * G; if (u >= 512) break; }
                const int cls = u >> 7, i = u & 127;
                AttnArgs t;
                t.lam = lam; t.postscale = 1.0f - lam_init; t.subln = a.in[17] + l * 128;
                if (cls == 0) {
                    const int lb = i >> 6, h = (i >> 4) & 3, qb = i & 15; const int row0 = NCTX + lb * LSEQ;
                    t.Q = DQ + (size_t)(row0 + qb * 128) * 512; t.qcol0 = h * 128; t.qcol1 = h * 128 + 64;
                    t.Kown = DK + (size_t)row0 * 512 + h * 128; t.Kc = CDK + (size_t)(l * 2 + lb) * 256 * 512 + h * 128; t.kstride = 512; t.nOwn = 32; t.nTot = 36;
                    t.Vown = DVtL + ((size_t)lb * 512 + h * 128) * 2048; t.vsOwn = 2048; t.Vc = CDVT + ((size_t)(l * 2 + lb) * 512 + h * 128) * 256; t.vsC = 256;
                    t.O = ABR + (size_t)(row0 + qb * 128) * 512; t.ocol0 = h * 128; t.ocol1 = 0;
                    attn_unit<128, 128, true>(lds, t);
                } else if (cls == 2) {
                    const int cb = i >> 3, h = (i >> 1) & 3, qb = i & 1; const int row0 = cb * CSEQ;
                    t.Q = DQ + (size_t)(row0 + qb * 128) * 512; t.qcol0 = h * 128; t.qcol1 = h * 128 + 64;
                    t.Kown = DK + (size_t)row0 * 512 + h * 128; t.Kc = t.Kown; t.kstride = 512; t.nOwn = 4; t.nTot = 4;
                    t.Vown = DVtC + ((size_t)cb * 512 + h * 128) * 256; t.vsOwn = 256; t.Vc = t.Vown; t.vsC = 256;
                    t.O = ABR + (size_t)(row0 + qb * 128) * 512; t.ocol0 = h * 128; t.ocol1 = 0;
                    attn_unit<128, 128, true>(lds, t);
                } else if (cls == 1) {
                    const int lb = i >> 6, pr = (i >> 4) & 3, qb = i & 15, kvh = pr >> 1, h0 = kvh * 4 + (pr & 1) * 2; const int row0 = NCTX + lb * LSEQ;
                    t.Q = GQ + (size_t)(row0 + qb * 128) * 512; t.qcol0 = h0 * 64; t.qcol1 = h0 * 64 + 64;
                    t.Kown = GK + (size_t)row0 * 128 + kvh * 64; t.Kc = CGK + (size_t)(l * 2 + lb) * 256 * 128 + kvh * 64; t.kstride = 128; t.nOwn = 32; t.nTot = 36;
                    t.Vown = GVtL + ((size_t)lb * 128 + kvh * 64) * 2048; t.vsOwn = 2048; t.Vc = CGVT + ((size_t)(l * 2 + lb) * 128 + kvh * 64) * 256; t.vsC = 256;
                    t.O = ABR + (size_t)NTOK * 512 + (size_t)(row0 + qb * 128) * 512; t.ocol0 = h0 * 64; t.ocol1 = h0 * 64 + 64;
                    attn_unit<64, 64, false>(lds, t);
                } else {
                    const int cb = i >> 3, pr = (i >> 1) & 3, qb = i & 1, kvh = pr >> 1, h0 = kvh * 4 + (pr & 1) * 2; const int row0 = cb * CSEQ;
                    t.Q = GQ + (size_t)(row0 + qb * 128) * 512; t.qcol0 = h0 * 64; t.qcol1 = h0 * 64 + 64;
                    t.Kown = GK + (size_t)row0 * 128 + kvh * 64; t.Kc = t.Kown; t.kstride = 128; t.nOwn = 4; t.nTot = 4;
                    t.Vown = GVtC + ((size_t)cb * 128 + kvh * 64) * 256; t.vsOwn = 256; t.Vc = t.Vown; t.vsC = 256;
                    t.O = ABR + (size_t)NTOK * 512 + (size_t)(row0 + qb * 128) * 512; t.ocol0 = h0 * 64; t.ocol1 = h0 * 64 + 64;
                    attn_unit<64, 64, false>(lds, t);
                }
            }
        }
#pragma unroll 1
        for (int rep_ = 0; rep_ < REP_CONV; ++rep_) {
            PH_BEGIN
            CONV_PHASE
        }
        xcd_barrier(bar);
#pragma unroll 1
        for (int rep_ = 0; rep_ < REP_C1; ++rep_) {
            PH_BEGIN
            EpiCtx ec; ec.l = l; ec.out = a.out; ec.ws = ws; ec.qn = nullptr; ec.kn = nullptr;
            pg8::Gemm g{P_ABR, (const bfraw*)(ws + WS_WBR + l * WBR_L), 3 * NTOK, 3 * 1024, 512}; pg8::BranchOrder S{bid};
            pg8::EpiBranch E{ec};
            pg8::gemm_phase<pg8::EpiBranch, pg8::BranchOrder, true, true>(lds, g, S, E);
        }
        xcd_barrier(bar);
#pragma unroll 1
        for (int rep_ = 0; rep_ < REP_C2; ++rep_) {
            PH_BEGIN
            EpiCtx ec; ec.l = l; ec.out = a.out; ec.ws = ws; ec.qn = nullptr; ec.kn = nullptr;
            pg8::Gemm g{P_HB, (const bfraw*)(ws + WS_WO + l * WO_L), NTOK, DM, DM}; pg8::StaticOrder S; S.init(NTOK, DM, G, bid);
            pg8::EpiRes E{ec, M_G1, (rep_ + 1 < REP_C2) ? (bfraw*)(ws + WS_ABR) : nullptr};
            pg8::gemm_phase<pg8::EpiRes, pg8::StaticOrder, true, true>(lds, g, S, E);
        }
        xcd_barrier(bar);
        {
            PH_BEGIN
            for (int m = gw; m < NTOK; m += NGW) {
                const int cond = m < NCTX ? 0 : 1 + ((m - NCTX) >> 11);
                const float* md = P_MOD + (size_t)(l * 3 + cond) * 6144;
                modnorm_row(P_X + (size_t)m * DM, nullptr, P_HB + (size_t)m * DM, a.in[11] + l * DM, md + M_SH2, md + M_SC2, lane);
            }
        }
        xcd_barrier(bar);
#pragma unroll 1
        for (int rep_ = 0; rep_ < REP_M1; ++rep_) {
            PH_BEGIN
            EpiCtx ec; ec.l = l; ec.out = a.out; ec.ws = ws; ec.qn = nullptr; ec.kn = nullptr;
            pg8::Gemm g{P_HB, (const bfraw*)(ws + WS_W1 + l * W1_L), NTOK, FF, DM}; pg8::StaticOrder S; S.init(NTOK, FF, G, bid);
            pg8::EpiRelu2 E{ec};
            pg8::gemm_phase<pg8::EpiRelu2, pg8::StaticOrder, true, true>(lds, g, S, E);
        }
        xcd_barrier(bar);
#pragma unroll 1
        for (int rep_ = 0; rep_ < REP_M2; ++rep_) {
            PH_BEGIN
            EpiCtx ec; ec.l = l; ec.out = a.out; ec.ws = ws; ec.qn = nullptr; ec.kn = nullptr;
            pg8::Gemm g{(const bfraw*)P_PROJ, (const bfraw*)(ws + WS_W2 + l * W2_L), NTOK, DM, FF}; pg8::StaticOrder S; S.init(NTOK, DM, G, bid);
            pg8::EpiRes E{ec, M_G2, (rep_ + 1 < REP_M2) ? (bfraw*)(ws + WS_HB) : nullptr};
            pg8::gemm_phase<pg8::EpiRes, pg8::StaticOrder, true, true>(lds, g, S, E);
        }
        xcd_barrier(bar);
        {
            PH_BEGIN
            if (l == 0) {
                for (int m = gw; m < NTOK; m += NGW) {
                    const int cond = m < NCTX ? 0 : 1 + ((m - NCTX) >> 11);
                    const float* md = P_MOD + (size_t)(3 + cond) * 6144;
                    modnorm_row(P_X + (size_t)m * DM, nullptr, P_HB + (size_t)m * DM, a.in[10] + DM, md + M_SH1, md + M_SC1, lane);
                }
            } else {
                for (int m = gw; m < NTOK; m += NGW) finalnorm_row(P_X + (size_t)m * DM, a.in[30], lane);
            }
        }
        if (l == 0) xcd_barrier(bar);
    }
}

extern "C" void kernel_launch(void* const* d_in, const int* in_sizes, int n_in, void* d_out, int out_size, void* d_ws, size_t ws_size, hipStream_t stream) {
    static int grid_blocks = 0;
    if (grid_blocks == 0) {
        if (n_in != 31 || ws_size < WS_END) { fprintf(stderr, "kernel_launch: unexpected n_in %d / ws_size %zu\n", n_in, ws_size); grid_blocks = -1; return; }
        int dev = 0, cus = 0, per_cu = 0;
        hipGetDevice(&dev);
        hipDeviceGetAttribute(&cus, hipDeviceAttributeMultiprocessorCount, dev);
        if (hipFuncSetAttribute((const void*)fwd_kernel, hipFuncAttributeMaxDynamicSharedMemorySize, LDS_BYTES) != hipSuccess) { fprintf(stderr, "kernel_launch: hipFuncSetAttribute failed\n"); grid_blocks = -1; return; }
        if (hipOccupancyMaxActiveBlocksPerMultiprocessor(&per_cu, (const void*)fwd_kernel, 512, LDS_BYTES) != hipSuccess || per_cu < 1) { fprintf(stderr, "kernel_launch: occupancy query gave %d\n", per_cu); (void)hipGetLastError(); per_cu = 1; }
        grid_blocks = cus * 1;
    }
    if (grid_blocks < 0) return;
    KArgs a{};
    for (int i = 0; i < 31; ++i) a.in[i] = (const float*)d_in[i];
    a.out = (float*)d_out; a.ws = (unsigned char*)d_ws;
    void* args[] = {&a};
    hipError_t e = hipLaunchCooperativeKernel((const void*)fwd_kernel, dim3(grid_blocks), dim3(512), args, LDS_BYTES, stream);
    if (e != hipSuccess) fprintf(stderr, "cooperative launch failed: %s (grid %d)\n", hipGetErrorString(e), grid_blocks);
}
```

```cpp
#include <hip/hip_runtime.h>
#include <hip/hip_cooperative_groups.h>
#include <cstdio>
#include <cstdint>
namespace cg = cooperative_groups;

typedef float f32x4_t __attribute__((ext_vector_type(4)));
typedef float f32x2_t __attribute__((ext_vector_type(2)));
typedef float f32x16_t __attribute__((ext_vector_type(16)));
typedef unsigned u32x4_t __attribute__((ext_vector_type(4)));
typedef unsigned u32x2_t __attribute__((ext_vector_type(2)));
typedef short s16x8_t __attribute__((ext_vector_type(8)));
typedef __bf16 bf16x2_t __attribute__((ext_vector_type(2)));
typedef unsigned short bfraw;

__device__ __forceinline__ unsigned pk2(float lo, float hi) { f32x2_t v = {lo, hi}; bf16x2_t b = __builtin_convertvector(v, bf16x2_t); return __builtin_bit_cast(unsigned, b); }
__device__ __forceinline__ bfraw f2bf(float x) { return (bfraw)(pk2(x, 0.f) & 0xffffu); }
__device__ __forceinline__ float bf2f(bfraw x) { return __builtin_bit_cast(float, (unsigned)x << 16); }
__device__ __forceinline__ float sigmoidf_(float x) { return __builtin_amdgcn_rcpf(1.0f + __builtin_amdgcn_exp2f(-1.4426950408889634f * x)); }

constexpr int DM = 1024, NTOK = 8192, NCTX = 4096, CSEQ = 256, LSEQ = 2048, PAST = 256, INW = 6400, FF = 4096;
constexpr float NEPS = 1e-6f;
constexpr float QSCALE = 0.125f * 1.4426950408889634f;
constexpr size_t O_X = 0, O_NDK = 8388608, O_NDV = 12582912, O_NGK = 16777216, O_NGV = 17825792;
constexpr int M_SH1 = 0, M_SC1 = 1024, M_G1 = 2048, M_SH2 = 3072, M_SC2 = 4096, M_G2 = 5120;

struct EpiCtx { int l; float* out; unsigned char* ws; };
#define LAS __attribute__((address_space(3)))
constexpr size_t MiB = 1u << 20;
constexpr size_t WS_MOD = 0, WS_ROPEC = 160 * 1024, WS_ROPES = 164 * 1024, WS_BAR = 192 * 1024, WS_FLAG = WS_BAR + 16384, WS_FLAG2 = WS_BAR + 5632 * 4, WS_QKN = 176 * 1024, WS_LAM = 180 * 1024;
constexpr size_t WS_CDK = 1 * MiB, WS_CDVT = 2 * MiB, WS_CGK = 3 * MiB, WS_CGVT = 3 * MiB + 256 * 1024;
constexpr size_t WS_WIN = 4 * MiB, WIN_L = (size_t)INW * DM * 2;
constexpr size_t WS_WBR = 29 * MiB, WBR_L = 3 * MiB;
constexpr size_t WS_WO = 35 * MiB, WO_L = 2 * MiB;
constexpr size_t WS_W1 = 39 * MiB, W1_L = 8 * MiB;
constexpr size_t WS_W2 = 55 * MiB, W2_L = 8 * MiB;
constexpr size_t WS_HB = 72 * MiB;
constexpr size_t WS_ABR = 88 * MiB;
constexpr size_t WS_PROJ = 112 * MiB;
constexpr size_t P_DQ = 0, P_DK = 8 * MiB, P_DVTC = 16 * MiB, P_DVTL = 20 * MiB, P_GQ = 24 * MiB, P_GK = 32 * MiB, P_GVTC = 34 * MiB, P_GVTL = 35 * MiB, P_U = 36 * MiB, P_G = 44 * MiB;
constexpr size_t WS_PART = 204 * MiB;
constexpr size_t WS_END = 236 * MiB;
constexpr int LDS_BYTES = 147456;

__device__ __forceinline__ void st_bf4(bfraw* p, f32x4_t v) { u32x2_t w; w.x = pk2(v[0], v[1]); w.y = pk2(v[2], v[3]); *(u32x2_t*)p = w; }
__device__ __forceinline__ float dot4(f32x4_t v) { return (v[0] * v[0] + v[1] * v[1]) + (v[2] * v[2] + v[3] * v[3]); }
namespace pg8 {
#define PG8_LAS __attribute__((address_space(3)))
typedef unsigned short bf16_t;
typedef short bf16x8 __attribute__((ext_vector_type(8)));
typedef float f32x4 __attribute__((ext_vector_type(4)));
typedef unsigned u32x4 __attribute__((ext_vector_type(4)));
constexpr int BM = 256, BK = 64, HALF = 128, HTB = HALF * BK * 2  , STAGE_BYTES = 8 * HTB, NXCD = 8, WGM = 4;

__host__ __device__ __forceinline__ int lds_byte(int r, int c) { const int st = (r >> 4) * 2 + (c >> 5), rr = r & 15, cc = c & 31, ob = rr * 64 + cc * 2; return st * 1024 + (ob ^ (((ob >> 9) & 1) << 5)); }
__host__ __device__ __forceinline__ void stage_rc(int b, int& R, int& C) { const int st = b / 1024, sb = b % 1024, swz = sb ^ (((sb >> 9) & 1) << 5); R = (st >> 1) * 16 + swz / 64; C = (st & 1) * 32 + (swz % 64) / 2; }
__host__ __device__ __forceinline__ int perm32(int rho) { const int n = rho >> 4, i = rho & 15; return 8 * (i >> 2) + 4 * n + (i & 3); }

struct Unit { int pm, pn; };
struct Gemm { const bf16_t* A; const bf16_t* Bt; int M, N, K, Kloop, bjsel; };

struct StaticOrder {
    int nM, nN, nwg, G, c;
    __host__ __device__ void init(int M, int N, int G_, int c_) { nM = M / BM; nN = N / BM; nwg = nM * nN; G = G_; c = c_; }
    __host__ __device__ bool next(int i, Unit& u) const {
        const long L = (long)i * G + c; if (L >= nwg) return false;
        int wgid = (int)L; { const int q = nwg / NXCD, r = nwg % NXCD, xcd = wgid % NXCD, off = wgid / NXCD; wgid = (xcd < r ? xcd * (q + 1) : r * (q + 1) + (xcd - r) * q) + off; }
        const int nig = WGM * nN, gid = wgid / nig, fm = gid * WGM, gsz = (nM - fm) < WGM ? (nM - fm) : WGM;
        u.pm = fm + ((wgid % nig) % gsz); u.pn = (wgid % nig) / gsz; return true;
    }
    __device__ __forceinline__ void a_ready(const Unit&) const {}
    __device__ __forceinline__ void done(const Unit&) const {}
};

__device__ __forceinline__ unsigned cvt_pk_bf16(float lo, float hi) { unsigned r; asm volatile("v_cvt_pk_bf16_f32 %0, %1, %2" : "=v"(r) : "v"(lo), "v"(hi)); return r; }
typedef float f32x2 __attribute__((ext_vector_type(2)));
#define EC_DQ ((bfraw*)(c.ws + WS_PROJ + P_DQ))
#define EC_DK ((bfraw*)(c.ws + WS_PROJ + P_DK))
#define EC_DVtC ((bfraw*)(c.ws + WS_PROJ + P_DVTC))
#define EC_DVtL ((bfraw*)(c.ws + WS_PROJ + P_DVTL))
#define EC_GQ ((bfraw*)(c.ws + WS_PROJ + P_GQ))
#define EC_GK ((bfraw*)(c.ws + WS_PROJ + P_GK))
#define EC_GVtC ((bfraw*)(c.ws + WS_PROJ + P_GVTC))
#define EC_GVtL ((bfraw*)(c.ws + WS_PROJ + P_GVTL))
#define EC_U ((bfraw*)(c.ws + WS_PROJ + P_U))
#define EC_G ((bfraw*)(c.ws + WS_PROJ + P_G))
#define EC_TMP ((float*)(c.ws + WS_PROJ))
#define EC_HB ((bfraw*)(c.ws + WS_HB))
#define EC_HID ((bfraw*)(c.ws + WS_PROJ))
#define EC_mod ((const float*)(c.ws + WS_MOD))
#define EC_ropec ((const float*)(c.ws + WS_ROPEC))
#define EC_ropes ((const float*)(c.ws + WS_ROPES))

struct EpiIn {
    static constexpr bool PERM = false, AFTER_DRAIN = false;
    EpiCtx c; int q;
    __device__ __forceinline__ void operator()(const f32x4 (&acc)[2][2][4][2], const Unit& u, int wr, int wc, int fr_, int fq_) const {
        int fr = fr_, fq = fq_; asm volatile("" : "+v"(fr), "+v"(fq));
        const int pn = u.pn, pm = u.pm, l = c.l;
        const bool ctx = pm < 16;
        const int rbase = pm * 256 + wr * 64 + fr;
        const int lb = (pm - 16) >> 3;
        if (pn < 2) {
#pragma unroll
            for (int ai = 0; ai < 2; ++ai)
#pragma unroll
                for (int m = 0; m < 4; ++m) {
                    const int row = rbase + ai * 128 + m * 16; const int t = (row - NCTX) & (LSEQ - 1);
                    f32x4 cs = {1.f, 1.f, 1.f, 1.f}, sn = {0.f, 0.f, 0.f, 0.f};
                    if (!ctx) { const int pos = (wc & 1) ? (t & 63) : (t >> 6); cs = *(const f32x4*)(EC_ropec + pos * 16 + 4 * fq); sn = *(const f32x4*)(EC_ropes + pos * 16 + 4 * fq); }
#pragma unroll
                    for (int bj = 0; bj < 2; ++bj) {
                        const f32x4 x1 = acc[ai][bj][m][0], x2 = acc[ai][bj][m][1];
                        const f32x4 o1 = (x1 * cs - x2 * sn) * QSCALE, o2 = (x2 * cs + x1 * sn) * QSCALE;
                        bfraw* p = EC_DQ + (size_t)row * 512 + pn * 256 + bj * 128 + wc * 32 + 4 * fq;
                        st_bf4(p, o1); st_bf4(p + 16, o2);
                    }
                }
        } else if (pn < 4) {
#pragma unroll
            for (int ai = 0; ai < 2; ++ai)
#pragma unroll
                for (int m = 0; m < 4; ++m) {
                    const int row = rbase + ai * 128 + m * 16; const int t = (row - NCTX) & (LSEQ - 1);
                    f32x4 cs = {1.f, 1.f, 1.f, 1.f}, sn = {0.f, 0.f, 0.f, 0.f};
                    if (!ctx) { const int pos = (wc & 1) ? (t & 63) : (t >> 6); cs = *(const f32x4*)(EC_ropec + pos * 16 + 4 * fq); sn = *(const f32x4*)(EC_ropes + pos * 16 + 4 * fq); }
#pragma unroll
                    for (int bj = 0; bj < 2; ++bj) {
                        const f32x4 x1 = acc[ai][bj][m][0], x2 = acc[ai][bj][m][1];
                        const f32x4 o1 = x1 * cs - x2 * sn, o2 = x2 * cs + x1 * sn;
                        const int colb = (pn - 2) * 256 + bj * 128 + wc * 32 + 4 * fq;
                        if (ctx) { float* op = c.out + O_NDK + ((size_t)(pm * 2 + l) * 256 + (row & 255)) * 512 + colb; *(f32x4*)op = x1; *(f32x4*)(op + 16) = x2; }
                        bfraw* p = EC_DK + (size_t)row * 512 + colb;
                        st_bf4(p, o1); st_bf4(p + 16, o2);
                    }
                }
        } else if (pn < 6) {
#pragma unroll
            for (int ai = 0; ai < 2; ++ai)
#pragma unroll
                for (int m = 0; m < 4; ++m) {
                    const int row = rbase + ai * 128 + m * 16; const int t = (row - NCTX) & (LSEQ - 1); const int s = row & 255;
#pragma unroll
                    for (int bj = 0; bj < 2; ++bj)
#pragma unroll
                        for (int n = 0; n < 2; ++n) {
                            const f32x4 x = acc[ai][bj][m][n];
                            const int colb = (pn - 4) * 256 + bj * 128 + wc * 32 + 16 * n + 4 * fq;
                            if (ctx) { *(f32x4*)(c.out + O_NDV + ((size_t)(pm * 2 + l) * 256 + s) * 512 + colb) = x;
#pragma unroll
                                for (int j = 0; j < 4; ++j) EC_DVtC[((size_t)pm * 512 + colb + j) * 256 + s] = f2bf(x[j]); }
                            else {
#pragma unroll
                                for (int j = 0; j < 4; ++j) EC_DVtL[((size_t)lb * 512 + colb + j) * 2048 + t] = f2bf(x[j]);
#ifdef DUPV
                                asm volatile("" ::: "memory");
#pragma unroll
                                for (int j = 0; j < 4; ++j) EC_DVtL[((size_t)lb * 512 + colb + j) * 2048 + t] = f2bf(x[j]);
#endif
                            }
                        }
                }
        } else if (pn < 8 || (pn == 8 && wc < 2)) {
            const bool isq = pn < 8;
            const float* nw = (const float*)(c.ws + WS_QKN) + l * 128 + (isq ? 0 : 64);
            const int head = isq ? 4 * (pn - 6) + wc : wc;
            const float osc = isq ? QSCALE : 1.0f;
#pragma unroll
            for (int ai = 0; ai < 2; ++ai)
#pragma unroll
                for (int m = 0; m < 4; ++m) {
                    const int row = rbase + ai * 128 + m * 16; const int t = (row - NCTX) & (LSEQ - 1);
                    float ss = (dot4(acc[ai][0][m][0]) + dot4(acc[ai][0][m][1])) + (dot4(acc[ai][1][m][0]) + dot4(acc[ai][1][m][1]));
                    ss += __shfl_xor(ss, 16); ss += __shfl_xor(ss, 32);
                    const float r = __builtin_amdgcn_rsqf(ss * (1.0f / 64.0f) + NEPS);
#pragma unroll
                    for (int bj = 0; bj < 2; ++bj) {
                        const f32x4 wa = *(const f32x4*)(nw + 32 * bj + 4 * fq), wb = *(const f32x4*)(nw + 32 * bj + 16 + 4 * fq);
                        const f32x4 x1 = acc[ai][bj][m][0] * r * wa, x2 = acc[ai][bj][m][1] * r * wb;
                        f32x4 cs = {1.f, 1.f, 1.f, 1.f}, sn = {0.f, 0.f, 0.f, 0.f};
                        if (!ctx) { const int pos = bj ? (t & 63) : (t >> 6); cs = *(const f32x4*)(EC_ropec + pos * 16 + 4 * fq); sn = *(const f32x4*)(EC_ropes + pos * 16 + 4 * fq); }
                        const f32x4 o1 = (x1 * cs - x2 * sn) * osc, o2 = (x2 * cs + x1 * sn) * osc;
                        const int d0 = head * 64 + 32 * bj + 4 * fq;
                        if (isq) { bfraw* p = EC_GQ + (size_t)row * 512 + d0; st_bf4(p, o1); st_bf4(p + 16, o2); }
                        else {
                            if (ctx) { float* op = c.out + O_NGK + ((size_t)(pm * 2 + l) * 256 + (row & 255)) * 128 + d0; *(f32x4*)op = x1; *(f32x4*)(op + 16) = x2; }
                            bfraw* p = EC_GK + (size_t)row * 128 + d0; st_bf4(p, o1); st_bf4(p + 16, o2);
                        }
                    }
                    asm volatile("" ::: "memory");
                }
        } else if (pn == 8) {
            const int kvh = wc - 2;
#pragma unroll
            for (int ai = 0; ai < 2; ++ai)
#pragma unroll
                for (int m = 0; m < 4; ++m) {
                    const int row = rbase + ai * 128 + m * 16; const int t = (row - NCTX) & (LSEQ - 1); const int s = row & 255;
#pragma unroll
                    for (int bj = 0; bj < 2; ++bj)
#pragma unroll
                        for (int n = 0; n < 2; ++n) {
                            const f32x4 x = acc[ai][bj][m][n];
                            const int d0 = kvh * 64 + 32 * bj + 16 * n + 4 * fq;
                            if (ctx) { *(f32x4*)(c.out + O_NGV + ((size_t)(pm * 2 + l) * 256 + s) * 128 + d0) = x;
#pragma unroll
                                for (int j = 0; j < 4; ++j) EC_GVtC[((size_t)pm * 128 + d0 + j) * 256 + s] = f2bf(x[j]); }
                            else {
#pragma unroll
                                for (int j = 0; j < 4; ++j) EC_GVtL[((size_t)lb * 128 + d0 + j) * 2048 + t] = f2bf(x[j]); }
                        }
                }
        } else if (pn < 13) {
            const int q = pn - 9;
#pragma unroll
            for (int ai = 0; ai < 2; ++ai)
#pragma unroll
                for (int m = 0; m < 4; ++m) {
                    const int row = rbase + ai * 128 + m * 16;
#pragma unroll
                    for (int n = 0; n < 2; ++n) {
                        const f32x4 a = acc[ai][0][m][n], g = acc[ai][1][m][n];
                        f32x4 o; o[0] = a[0] * sigmoidf_(g[0]); o[1] = a[1] * sigmoidf_(g[1]); o[2] = a[2] * sigmoidf_(g[2]); o[3] = a[3] * sigmoidf_(g[3]);
                        st_bf4(EC_U + (size_t)row * 512 + q * 128 + wc * 32 + 16 * n + 4 * fq, o);
                    }
                }
        } else {
#pragma unroll
            for (int ai = 0; ai < 2; ++ai) {
#pragma unroll
                for (int m = 0; m < 4; ++m) {
                    const int row = rbase + ai * 128 + m * 16;
#pragma unroll
                    for (int bj = 0; bj < 2; ++bj) {
                        if (q >= 0 && bj != q) continue;
#pragma unroll
                        for (int n = 0; n < 2; ++n) {
                            const f32x4 g = acc[ai][bj][m][n];
                            f32x4 o; o[0] = sigmoidf_(g[0]); o[1] = sigmoidf_(g[1]); o[2] = sigmoidf_(g[2]); o[3] = sigmoidf_(g[3]);
                            st_bf4(EC_G + (size_t)row * 3072 + (pn - 13) * 256 + bj * 128 + wc * 32 + 16 * n + 4 * fq, o);
                        }
                    }
                }
            }
        }
    }
};

struct EpiBranch {
    static constexpr bool PERM = true, AFTER_DRAIN = false;
    EpiCtx c; int bjsel; int pair; unsigned epoch;
    __device__ __forceinline__ void operator()(const f32x4 (&acc)[2][2][4][2], const Unit& u, int wr, int wc, int fr_, int fq_) const {
        int fr = fr_, fq = fq_; asm volatile("" : "+v"(fr), "+v"(fq));
        const int br = u.pm >> 5, pm = u.pm & 31, pn = u.pn & 3;
        unsigned* const flag = (unsigned*)(c.ws + WS_FLAG2) + (pm * 4 + pn) * 8 + wr * 4 + wc;
        const bool last = pair ? (br == 1) : (br == 2);
        if (pair && br == 1) {
            unsigned spins = 0;
            while (__hip_atomic_load(flag, __ATOMIC_RELAXED, __HIP_MEMORY_SCOPE_AGENT) != epoch) { __builtin_amdgcn_s_sleep(1); if (++spins > (1u << 22)) break; }
            __builtin_amdgcn_fence(__ATOMIC_ACQUIRE, "agent");
        }
#pragma unroll
        for (int ai = 0; ai < 2; ++ai)
#pragma unroll
            for (int m = 0; m < 4; ++m) {
                const int row = pm * 256 + ai * 128 + wr * 64 + m * 16 + fr;
#pragma unroll
                for (int bj = 0; bj < 2; ++bj) {
                    if (bjsel >= 0 && bj != bjsel) continue;
                    const int col8 = pn * 256 + bj * 128 + wc * 32 + 8 * fq;
                    const u32x4 gw = *(const u32x4*)(EC_G + (size_t)row * 3072 + br * 1024 + col8);
                    f32x4 g0, g1;
                    g0[0] = __builtin_bit_cast(float, gw.x << 16); g0[1] = __builtin_bit_cast(float, gw.x & 0xffff0000u);
                    g0[2] = __builtin_bit_cast(float, gw.y << 16); g0[3] = __builtin_bit_cast(float, gw.y & 0xffff0000u);
                    g1[0] = __builtin_bit_cast(float, gw.z << 16); g1[1] = __builtin_bit_cast(float, gw.z & 0xffff0000u);
                    g1[2] = __builtin_bit_cast(float, gw.w << 16); g1[3] = __builtin_bit_cast(float, gw.w & 0xffff0000u);
                    f32x4 v0 = acc[ai][bj][m][0] * g0, v1 = acc[ai][bj][m][1] * g1;
                    bfraw* tp = (bfraw*)EC_TMP + (size_t)row * 1024 + col8;
                    float* t2 = (float*)(c.ws + WS_PART) + (size_t)row * 1024 + col8;
                    if (pair && br == 2) { *(f32x4*)t2 = v0; *(f32x4*)(t2 + 4) = v1; }
                    else {
                        if (br != 0) { const u32x4 tw = *(const u32x4*)tp;
                            v0[0] += __builtin_bit_cast(float, tw.x << 16); v0[1] += __builtin_bit_cast(float, tw.x & 0xffff0000u); v0[2] += __builtin_bit_cast(float, tw.y << 16); v0[3] += __builtin_bit_cast(float, tw.y & 0xffff0000u);
                            v1[0] += __builtin_bit_cast(float, tw.z << 16); v1[1] += __builtin_bit_cast(float, tw.z & 0xffff0000u); v1[2] += __builtin_bit_cast(float, tw.w << 16); v1[3] += __builtin_bit_cast(float, tw.w & 0xffff0000u); }
                        if (last && pair) { v0 += *(const f32x4*)t2; v1 += *(const f32x4*)(t2 + 4); }
                        u32x4 w; w.x = pk2(v0[0], v0[1]); w.y = pk2(v0[2], v0[3]); w.z = pk2(v1[0], v1[1]); w.w = pk2(v1[2], v1[3]);
                        if (last) *(u32x4*)(EC_HB + (size_t)row * 1024 + col8) = w; else *(u32x4*)tp = w;
                    }
                }
            }
        if (pair && br == 2) {
            asm volatile("s_waitcnt vmcnt(0)" ::: "memory");
            if (fr + 16 * fq == 0) __hip_atomic_store(flag, epoch, __ATOMIC_RELAXED, __HIP_MEMORY_SCOPE_AGENT);
        }
    }
};
struct QuarterOrder {
    int c;
    __device__ bool next(int i, Unit& u) const { if (i > 0 || c >= 64) return false; u.pm = 4 * (c & 7) + (c >> 4); u.pn = 24; return true; }
    __device__ __forceinline__ void a_ready(const Unit&) const {}
    __device__ __forceinline__ void done(const Unit&) const {}
};
struct BranchOrder {
    int c, role, pair;
    __device__ bool next(int i, Unit& u) const {
        if (c >= 128) return false;
        int br = i;
        if (pair) { if (role == 0) { if (i >= 2) return false; } else { if (i >= 1) return false; br = 2; } }
        else if (i >= 3) return false;
        const int x = c & 7, j = c >> 3; u.pm = br * 32 + 4 * x + (j >> 2); u.pn = br * 4 + (j & 3); return true;
    }
    __device__ __forceinline__ void a_ready(const Unit&) const {}
    __device__ __forceinline__ void done(const Unit&) const {}
};

struct EpiRes {
    static constexpr bool PERM = false, AFTER_DRAIN = true;
    EpiCtx c; int goff; int part;
    __device__ __forceinline__ void fused(f32x4 (&acc)[2][2][4][2], const Unit& u, int wr, int wc, int fr_, int fq_, PG8_LAS unsigned char* lds, int wid, int lane_) const {
        int fr = fr_, fq = fq_, lane = lane_; asm volatile("" : "+v"(fr), "+v"(fq), "+v"(lane));
        const int pm = u.pm, pn = u.pn;
        const int cond = pm < 16 ? 0 : 1 + ((pm - 16) >> 3);
        const float* gp = EC_mod + (size_t)(c.l * 3 + cond) * 6144 + goff + pn * 256;
        float* const dst = c.out + O_X + (size_t)(pm * 256) * 1024 + pn * 256 + 4 * lane;
        bfraw* const dstp = (bfraw*)(c.ws + WS_PART) + (part == 2 ? (size_t)NTOK * 1024 : 0) + (size_t)(pm * 256) * 1024 + pn * 256 + 4 * lane;
        PG8_LAS float* const lf = (PG8_LAS float*)lds;
#pragma unroll
        for (int ai = 0; ai < 2; ++ai) {
#pragma unroll
            for (int bj = 0; bj < 2; ++bj)
#pragma unroll
                for (int n = 0; n < 2; ++n) {
                    const int col = bj * 128 + wc * 32 + 16 * n + 4 * fq;
                    const f32x4 gv = *(const f32x4*)(gp + col);
#pragma unroll
                    for (int m = 0; m < 4; ++m) *(PG8_LAS f32x4*)(lf + (wr * 64 + m * 16 + fr) * 260 + col) = gv * acc[ai][bj][m][n];
                }
            asm volatile("s_waitcnt lgkmcnt(0)" ::: "memory"); __builtin_amdgcn_s_barrier(); asm volatile("" ::: "memory");
#pragma unroll 4
            for (int r = 0; r < 16; ++r) {
                const int rl = wid * 16 + r;
                const f32x4 v = *(const PG8_LAS f32x4*)(lf + rl * 260 + 4 * lane);
                float* xp = dst + (size_t)(ai * 128 + rl) * 1024;
                if (part) st_bf4(dstp + (size_t)(ai * 128 + rl) * 1024, v); else *(f32x4*)xp = *(const f32x4*)xp + v;
            }
            asm volatile("s_waitcnt lgkmcnt(0)" ::: "memory"); __builtin_amdgcn_s_barrier(); asm volatile("" ::: "memory");
        }
    }
};

struct EpiRelu2 {
    static constexpr bool PERM = true, AFTER_DRAIN = false;
    EpiCtx c;
    __device__ __forceinline__ void operator()(const f32x4 (&acc)[2][2][4][2], const Unit& u, int wr, int wc, int fr_, int fq_) const {
        int fr = fr_, fq = fq_; asm volatile("" : "+v"(fr), "+v"(fq));
#pragma unroll
        for (int ai = 0; ai < 2; ++ai)
#pragma unroll
            for (int m = 0; m < 4; ++m) {
                const int row = u.pm * 256 + ai * 128 + wr * 64 + m * 16 + fr;
#pragma unroll
                for (int bj = 0; bj < 2; ++bj) {
                    f32x4 v0 = acc[ai][bj][m][0], v1 = acc[ai][bj][m][1];
#pragma unroll
                    for (int j = 0; j < 4; ++j) { v0[j] = __builtin_fmaxf(v0[j], 0.f); v1[j] = __builtin_fmaxf(v1[j], 0.f); }
                    v0 = v0 * v0; v1 = v1 * v1;
                    u32x4 w; w.x = pk2(v0[0], v0[1]); w.y = pk2(v0[2], v0[3]); w.z = pk2(v1[0], v1[1]); w.w = pk2(v1[2], v1[3]);
                    *(u32x4*)(EC_HID + (size_t)row * 4096 + u.pn * 256 + bj * 128 + wc * 32 + 8 * fq) = w;
                }
            }
    }
};
template <class Epi, class Sched, bool ALIGN_EPI = false, bool SP2 = false>
__device__ __forceinline__ void gemm_phase(PG8_LAS unsigned char* lds, const Gemm g, const Sched& S, const Epi& E) {
    int tid_ = threadIdx.x; asm volatile("" : "+v"(tid_));
    const int tid = tid_, wid = __builtin_amdgcn_readfirstlane(tid >> 6), lane = tid & 63, wr = wid >> 2, wc = wid & 3, fr = lane & 15, fq = lane >> 4;
    const int K = g.K, nt = g.Kloop / BK, bjs = g.bjsel;
    unsigned voffA[2], voffB[2];
#pragma unroll
    for (int i = 0; i < 2; ++i) { int R, C; stage_rc(tid * 16 + i * 8192, R, C); const int Rb = Epi::PERM ? ((R & ~31) + perm32(R & 31)) : R;
        voffA[i] = (unsigned)(R * K + C) * 2u; voffB[i] = (unsigned)(Rb * K + C) * 2u; }
    const size_t kstep = (size_t)(BK * 2);
    const size_t hstep = (size_t)HALF * K * 2;
    const size_t tstep = 2 * hstep;
    const unsigned ldsw = (unsigned)wid * 1024u;
    const int aoff = lds_byte(wr * 64 + fr, fq * 8), boff = lds_byte(wc * 32 + fr, fq * 8);
#define PG8_SA(b, h) (((b) * 2 + (h)) * HTB)
#define PG8_SB(b, h) ((4 + (b) * 2 + (h)) * HTB)
#define PG8_STAGE(bufoff, gbase, voff) do { _Pragma("unroll") for (int _i = 0; _i < 2; ++_i) \
        __builtin_amdgcn_global_load_lds((const unsigned*)((const char*)(gbase) + (voff)[_i]), (PG8_LAS unsigned*)(lds + (bufoff) + ldsw + _i * 8192), 16, 0, 0); } while (0)
#define PG8_LDA(dst, b, h) do { _Pragma("unroll") for (int m = 0; m < 4; ++m) _Pragma("unroll") for (int k = 0; k < 2; ++k) dst[m][k] = *(const PG8_LAS bf16x8*)(lds + PG8_SA(b, h) + aoff + m * 2048 + k * 1024); } while (0)
#define PG8_LDB(dst, b, h) do { _Pragma("unroll") for (int n = 0; n < 2; ++n) _Pragma("unroll") for (int k = 0; k < 2; ++k) dst[n][k] = *(const PG8_LAS bf16x8*)(lds + PG8_SB(b, h) + boff + n * 2048 + k * 1024); } while (0)
#define PG8_MMA(ai, bj, At, Bt) do { __builtin_amdgcn_s_setprio(1); _Pragma("unroll") for (int m = 0; m < 4; ++m) _Pragma("unroll") for (int n = 0; n < 2; ++n) _Pragma("unroll") for (int k = 0; k < 2; ++k) \
        acc[ai][bj][m][n] = __builtin_amdgcn_mfma_f32_16x16x32_bf16(Bt[n][k], At[m][k], acc[ai][bj][m][n], 0, 0, 0); __builtin_amdgcn_s_setprio(0); } while (0)
#define PG8_WAIT_V(n) asm volatile("s_waitcnt vmcnt(" #n ")" ::: "memory")
#define PG8_WAIT_L(n) asm volatile("s_waitcnt lgkmcnt(" #n ")" ::: "memory")
#define PG8_BAR __builtin_amdgcn_s_barrier()
#define PG8_SCHED __builtin_amdgcn_sched_barrier(0)
    Unit cur, nxt; int ui = 0;
    if (!S.next(0, cur)) return;
    f32x4 acc[2][2][4][2];
#pragma unroll
    for (int a = 0; a < 2; ++a)
#pragma unroll
        for (int b = 0; b < 2; ++b)
#pragma unroll
            for (int m = 0; m < 4; ++m)
#pragma unroll
                for (int n = 0; n < 2; ++n) acc[a][b][m][n] = (f32x4){0.f, 0.f, 0.f, 0.f};
    bf16x8 At[4][2], B0[2][2], B1[2][2];
    const char* cA = (const char*)g.A + (size_t)cur.pm * tstep; const char* cB = (const char*)g.Bt + (size_t)cur.pn * tstep;
    S.a_ready(cur);
    if constexpr (SP2) {
        PG8_STAGE(PG8_SB(0, 0), cB, voffB); PG8_STAGE(PG8_SB(0, 1), cB + hstep, voffB); PG8_STAGE(PG8_SA(0, 0), cA, voffA); PG8_STAGE(PG8_SA(0, 1), cA + hstep, voffA);
        if (wr == 1) PG8_BAR;
        PG8_WAIT_V(2); PG8_BAR;
        PG8_STAGE(PG8_SB(1, 0), cB + kstep, voffB); PG8_STAGE(PG8_SA(1, 0), cA + kstep, voffA); PG8_STAGE(PG8_SB(1, 1), cB + hstep + kstep, voffB);
        PG8_WAIT_V(6); PG8_BAR;
    } else {
        PG8_STAGE(PG8_SB(0, 0), cB, voffB); PG8_STAGE(PG8_SA(0, 0), cA, voffA); PG8_STAGE(PG8_SB(0, 1), cB + hstep, voffB); PG8_STAGE(PG8_SA(0, 1), cA + hstep, voffA);
        if (wr == 1) PG8_BAR;
        PG8_WAIT_V(4); PG8_BAR;
        PG8_STAGE(PG8_SB(1, 0), cB + kstep, voffB); PG8_STAGE(PG8_SA(1, 0), cA + kstep, voffA); PG8_STAGE(PG8_SB(1, 1), cB + hstep + kstep, voffB);
        PG8_WAIT_V(6); PG8_BAR;
    }
    for (;;) {
        const bool has_next = S.next(ui + 1, nxt);
        const char* nA = has_next ? (const char*)g.A + (size_t)nxt.pm * tstep : cA; const char* nB = has_next ? (const char*)g.Bt + (size_t)nxt.pn * tstep : cB;
        for (int t = 0; t < nt; t += 2) {
            const bool last = (t == nt - 2);
            const char* a1 = cA + (size_t)(t + 1) * kstep;
            const char* a2 = last ? nA : cA + (size_t)(t + 2) * kstep; const char* b2 = last ? nB : cB + (size_t)(t + 2) * kstep;
            const char* a3 = a2 + kstep; const char* b3 = b2 + kstep;
            if (last && has_next) S.a_ready(nxt);
            if constexpr (SP2) {
            PG8_LDB(B0, 0, 0); PG8_LDB(B1, 0, 1); PG8_SCHED; PG8_LDA(At, 0, 0); PG8_STAGE(PG8_SA(1, 1), a1 + hstep, voffA);
            PG8_WAIT_V(8); PG8_WAIT_L(0); PG8_BAR; if (bjs != 1) PG8_MMA(0, 0, At, B0); if (bjs != 0) PG8_MMA(0, 1, At, B1); PG8_BAR; PG8_SCHED;
            PG8_LDA(At, 0, 1); PG8_STAGE(PG8_SB(0, 0), b2, voffB); PG8_STAGE(PG8_SB(0, 1), b2 + hstep, voffB); PG8_STAGE(PG8_SA(0, 0), a2, voffA);
            PG8_WAIT_V(8); PG8_WAIT_L(0); PG8_BAR; if (bjs != 1) PG8_MMA(1, 0, At, B0); if (bjs != 0) PG8_MMA(1, 1, At, B1); PG8_BAR; PG8_SCHED;
            PG8_LDB(B0, 1, 0); PG8_LDB(B1, 1, 1); PG8_SCHED; PG8_LDA(At, 1, 0); PG8_STAGE(PG8_SA(0, 1), a2 + hstep, voffA);
            PG8_WAIT_V(8); PG8_WAIT_L(0); PG8_BAR; if (bjs != 1) PG8_MMA(0, 0, At, B0); if (bjs != 0) PG8_MMA(0, 1, At, B1); PG8_BAR; PG8_SCHED;
            PG8_LDA(At, 1, 1); PG8_STAGE(PG8_SB(1, 0), b3, voffB); PG8_STAGE(PG8_SB(1, 1), b3 + hstep, voffB); PG8_STAGE(PG8_SA(1, 0), a3, voffA);
            PG8_WAIT_V(8); PG8_WAIT_L(0); PG8_BAR; if (bjs != 1) PG8_MMA(1, 0, At, B0); if (bjs != 0) PG8_MMA(1, 1, At, B1); PG8_BAR; PG8_SCHED;
            } else {
            PG8_LDB(B0, 0, 0); PG8_SCHED; PG8_LDA(At, 0, 0); PG8_STAGE(PG8_SA(1, 1), a1 + hstep, voffA);
            PG8_WAIT_L(8); PG8_BAR; PG8_WAIT_L(0); PG8_MMA(0, 0, At, B0); PG8_BAR; PG8_SCHED;
            PG8_LDB(B1, 0, 1); PG8_STAGE(PG8_SB(0, 0), b2, voffB);
            PG8_BAR; PG8_WAIT_L(0); PG8_MMA(0, 1, At, B1); PG8_BAR;
            PG8_LDA(At, 0, 1); PG8_STAGE(PG8_SA(0, 0), a2, voffA);
            PG8_BAR; PG8_WAIT_L(0); PG8_MMA(1, 0, At, B0); PG8_BAR; PG8_SCHED;
            PG8_STAGE(PG8_SB(0, 1), b2 + hstep, voffB);
            PG8_WAIT_V(6); PG8_BAR; PG8_MMA(1, 1, At, B1); PG8_BAR;
            PG8_LDB(B0, 1, 0); PG8_SCHED; PG8_LDA(At, 1, 0); PG8_STAGE(PG8_SA(0, 1), a2 + hstep, voffA);
            PG8_WAIT_L(8); PG8_BAR; PG8_WAIT_L(0); PG8_MMA(0, 0, At, B0); PG8_BAR; PG8_SCHED;
            PG8_LDB(B1, 1, 1); PG8_STAGE(PG8_SB(1, 0), b3, voffB);
            PG8_BAR; PG8_WAIT_L(0); PG8_MMA(0, 1, At, B1); PG8_BAR;
            PG8_LDA(At, 1, 1); PG8_STAGE(PG8_SA(1, 0), a3, voffA);
            PG8_BAR; PG8_WAIT_L(0); PG8_MMA(1, 0, At, B0); PG8_BAR; PG8_SCHED;
            PG8_STAGE(PG8_SB(1, 1), b3 + hstep, voffB);
            PG8_WAIT_V(6); PG8_BAR; PG8_MMA(1, 1, At, B1); PG8_BAR;
            }
        }
        if constexpr (ALIGN_EPI) { if (wr == 0) PG8_BAR; }
        if constexpr (!Epi::AFTER_DRAIN) { E(acc, cur, wr, wc, fr, fq); S.done(cur); }
        if (!has_next) break;
#pragma unroll
        for (int a = 0; a < 2; ++a)
#pragma unroll
            for (int b = 0; b < 2; ++b)
#pragma unroll
                for (int m = 0; m < 4; ++m)
#pragma unroll
                    for (int n = 0; n < 2; ++n) acc[a][b][m][n] = (f32x4){0.f, 0.f, 0.f, 0.f};
        cur = nxt; cA = nA; cB = nB; ++ui;
        if constexpr (ALIGN_EPI) { if (wr == 1) PG8_BAR; }
    }
    PG8_WAIT_V(0);
    if constexpr (!ALIGN_EPI) { if (wr == 0) PG8_BAR; }
    PG8_BAR;
    if constexpr (Epi::AFTER_DRAIN) { E.fused(acc, cur, wr, wc, fr, fq, lds, wid, lane); S.done(cur); }
#undef PG8_SA
#undef PG8_SB
#undef PG8_STAGE
#undef PG8_LDA
#undef PG8_LDB
#undef PG8_MMA
#undef PG8_WAIT_V
#undef PG8_WAIT_L
#undef PG8_BAR
#undef PG8_SCHED
}
}
#ifndef REP_P0
#define REP_P0 1
#endif
#ifndef REP_PA
#define REP_PA 1
#endif
#ifndef REP_ATT
#define REP_ATT 1
#endif
#ifndef REP_CONV
#define REP_CONV 1
#endif
#ifndef REP_C1
#define REP_C1 1
#endif
#ifndef REP_C2
#define REP_C2 1
#endif
#ifndef REP_M1
#define REP_M1 1
#endif
#ifndef REP_M2
#define REP_M2 1
#endif
#ifndef REP_SYNC
#define REP_SYNC 0
#endif

struct KArgs { const float* in[31]; float* out; unsigned char* ws; };
#define XB_TMO      128
#define XB_XCNT(j)  (256  + 64 * (j))
#define XB_XSUB(j)  (1280 + 64 * (j))
#define XB_XGEN(j)  (2304 + 64 * (j))
#define XB_TOP      3328
#define XB_TOPGEN   3392
#define XCD_BAR_WORDS 3456
#define XB_SPIN_CAP (1u << 18)

__device__ __forceinline__ unsigned xb_ld(unsigned* p)              { return __hip_atomic_load(p, __ATOMIC_RELAXED, __HIP_MEMORY_SCOPE_AGENT); }
__device__ __forceinline__ unsigned xb_add(unsigned* p, unsigned v) { return __hip_atomic_fetch_add(p, v, __ATOMIC_RELAXED, __HIP_MEMORY_SCOPE_AGENT); }
__device__ __forceinline__ unsigned xb_xcc_id() { return (unsigned)__builtin_amdgcn_s_getreg((3 << 11) | 20) & 0xFu; }
#define XB_SPIN(cond, bar) do { unsigned _sp = 0; while (cond) { __builtin_amdgcn_s_sleep(1); \
    if ((++_sp & 255u) == 0u) { if (xb_ld(&(bar)[XB_TMO])) break; if (_sp > XB_SPIN_CAP) { atomicAdd(&(bar)[XB_TMO], 1u); break; } } } } while (0)

struct XcdBarrier {
    unsigned* bar; unsigned x;
    volatile LAS unsigned* st;
};

__device__ __forceinline__ XcdBarrier xcd_barrier_post(unsigned* bar, volatile LAS unsigned* st) {
    XcdBarrier b; b.bar = bar; b.x = xb_xcc_id(); b.st = st;
    if (threadIdx.x == 0) st[2] = xb_add(&bar[XB_XCNT(b.x)], 1u);
    return b;
}
__device__ __forceinline__ void xcd_barrier_complete(unsigned* bar, unsigned x, unsigned& nloc, unsigned& nx) {
    const unsigned G = gridDim.x * gridDim.y * gridDim.z;
    unsigned sum, cnt, mine, sp = 0u;
    for (;;) {
        sum = 0u; cnt = 0u; mine = 0u;
#pragma unroll
        for (unsigned j = 0; j < 16; ++j) { const unsigned c = xb_ld(&bar[XB_XCNT(j)]); sum += c; cnt += (c > 0u) ? 1u : 0u; mine = (j == x) ? c : mine; }
        if (sum == G) break;
        __builtin_amdgcn_s_sleep(1);
        if ((++sp & 255u) == 0u) { if (xb_ld(&bar[XB_TMO])) break; if (sp > XB_SPIN_CAP) { atomicAdd(&bar[XB_TMO], 1u); break; } }
    }
    nloc = mine > 0u ? mine : 1u; nx = cnt > 0u ? cnt : 1u;
}

__device__ __forceinline__ void xcd_barrier(const XcdBarrier& b) {
    asm volatile("s_waitcnt vmcnt(0)" ::: "memory");
    __syncthreads();
    if (threadIdx.x == 0) {
        unsigned* bar = b.bar;
        __builtin_amdgcn_s_waitcnt(0);
        unsigned nloc = b.st[0], nx = b.st[1];
        if (nloc == 0u) { xcd_barrier_complete(bar, b.x, nloc, nx); b.st[0] = nloc; b.st[1] = nx;
            unsigned uni = (nx == 8u && gridDim.x == 256u) ? 1u : 0u;
#pragma unroll
            for (unsigned j = 0; j < 16; ++j) { const unsigned cj = xb_ld(&bar[XB_XCNT(j)]); if (cj != (j < 8u ? 32u : 0u)) uni = 0u; }
            b.st[3] = uni; }
        const unsigned old = xb_add(&bar[XB_XSUB(b.x)], 1u);
        const unsigned gen = old / nloc;
        if (old + 1u == (gen + 1u) * nloc) {
            __builtin_amdgcn_fence(__ATOMIC_RELEASE, "agent");
            asm volatile("s_waitcnt vmcnt(0)" ::: "memory");
            const unsigned og = xb_add(&bar[XB_TOP], 1u);
            const unsigned tg = og / nx;
            if (og + 1u == (tg + 1u) * nx) xb_add(&bar[XB_TOPGEN], 1u);
            else XB_SPIN(xb_ld(&bar[XB_TOPGEN]) == tg, bar);
            __builtin_amdgcn_fence(__ATOMIC_ACQUIRE, "agent");
            xb_add(&bar[XB_XGEN(b.x)], 1u);
            asm volatile("s_waitcnt vmcnt(0)" ::: "memory");
        } else {
            XB_SPIN(xb_ld(&bar[XB_XGEN(b.x)]) == gen, bar);
            __builtin_amdgcn_fence(__ATOMIC_ACQUIRE, "agent");
            asm volatile("s_waitcnt vmcnt(0)" ::: "memory");
        }
    }
    __syncthreads();
}


__device__ __forceinline__ float wave_sum(float v) {
#pragma unroll
    for (int o = 1; o < 64; o <<= 1) v += __shfl_xor(v, o);
    return v;
}

#define XB_LSUB(j)  (3456 + 64 * (j))
#define XB_LGEN(j)  (4480 + 64 * (j))
__device__ __forceinline__ void xcc_local_barrier(const XcdBarrier& b) {
    asm volatile("s_waitcnt vmcnt(0)" ::: "memory");
    __syncthreads();
    if (threadIdx.x == 0) {
        unsigned* bar = b.bar;
        const unsigned old = xb_add(&bar[XB_LSUB(b.x)], 1u), gen = old / 32u;
        if (old + 1u == (gen + 1u) * 32u) xb_add(&bar[XB_LGEN(b.x)], 1u);
        else XB_SPIN(xb_ld(&bar[XB_LGEN(b.x)]) == gen, bar);
        __builtin_amdgcn_fence(__ATOMIC_ACQUIRE, "agent");
        asm volatile("s_waitcnt vmcnt(0)" ::: "memory");
    }
    __syncthreads();
}

__device__ __forceinline__ void transpose_item(const float* W, int K, int N, bfraw* WT, int vrow0, int n0, int k0, LAS float* scr, int lane) {
#pragma unroll 8
    for (int i = 0; i < 32; ++i) { const int kk = 2 * i + (lane >> 5); scr[kk * 33 + (lane & 31)] = W[(size_t)(k0 + kk) * N + n0 + (lane & 31)]; }
    asm volatile("s_waitcnt lgkmcnt(0)" ::: "memory");
    const int cch = lane & 7;
#pragma unroll
    for (int j = 0; j < 4; ++j) { const int n = (lane >> 3) + 8 * j; const LAS float* s = scr + (8 * cch) * 33 + n;
        u32x4_t o; o.x = pk2(s[0 * 33], s[1 * 33]); o.y = pk2(s[2 * 33], s[3 * 33]); o.z = pk2(s[4 * 33], s[5 * 33]); o.w = pk2(s[6 * 33], s[7 * 33]);
        *(u32x4_t*)(WT + (size_t)(vrow0 + n) * K + k0 + 8 * cch) = o; }
    asm volatile("s_waitcnt lgkmcnt(0)" ::: "memory");
}
__device__ __forceinline__ int vcol_map(int vb) {
    const int tile = vb >> 3, sub = vb & 7, bj = sub >> 2, wc = sub & 3;
    if (tile < 6 || tile >= 13) return vb * 32;
    if (tile < 8) return 1536 + (4 * (tile - 6) + wc) * 64 + 32 * bj;
    if (tile == 8) return 2048 + wc * 64 + 32 * bj;
    return (bj ? 2816 : 2304) + 128 * (tile - 9) + 32 * wc;
}
__device__ __forceinline__ void sincos_small(float x, float& s, float& c) {
    const float k = __builtin_rintf(x * 0.15915494309189535f);
    float r = __builtin_fmaf(-k, 6.2831854820251465f, x); r = __builtin_fmaf(-k, -1.7484555e-07f, r);
    const float y = r * 0.25f, y2 = y * y;
    float sp = __builtin_fmaf(y2, 2.7557319e-06f, -1.9841270e-04f); sp = __builtin_fmaf(sp, y2, 8.3333333e-03f); sp = __builtin_fmaf(sp, y2, -1.6666667e-01f); sp = __builtin_fmaf(sp * y2, y, y);
    float cp = __builtin_fmaf(y2, -2.7557319e-07f, 2.4801587e-05f); cp = __builtin_fmaf(cp, y2, -1.3888889e-03f); cp = __builtin_fmaf(cp, y2, 4.1666667e-02f); cp = __builtin_fmaf(cp, y2, -0.5f); cp = __builtin_fmaf(cp, y2, 1.0f);
    const float s2 = 2.f * sp * cp, c2 = cp * cp - sp * sp;
    s = 2.f * s2 * c2; c = c2 * c2 - s2 * s2;
}
__device__ __forceinline__ void modnorm_row(const float* xrow, const float* addrow, float* xcopy, bfraw* orow, const float* nw, const float* shift, const float* scale, int lane) {
    const f32x4_t* xr = (const f32x4_t*)xrow + lane;
    f32x4_t v[4]; float s = 0.f;
#pragma unroll
    for (int j = 0; j < 4; ++j) { v[j] = xr[64 * j]; if (addrow) v[j] += ((const f32x4_t*)addrow + lane)[64 * j]; s += dot4(v[j]); }
    const float r = __builtin_amdgcn_rsqf(wave_sum(s) * (1.0f / DM) + NEPS);
#pragma unroll
    for (int j = 0; j < 4; ++j) {
        const int cidx = 4 * lane + 256 * j;
        if (xcopy) *((f32x4_t*)xcopy + lane + 64 * j) = v[j];
        const f32x4_t w = *(const f32x4_t*)(nw + cidx), sh = *(const f32x4_t*)(shift + cidx), sc = *(const f32x4_t*)(scale + cidx);
        const f32x4_t h = v[j] * r * w * (1.0f + sc) + sh;
        st_bf4(orow + cidx, h);
    }
}
__device__ __forceinline__ void finalnorm_row(float* xrow, const float* addrow, const float* nw, int lane) {
    f32x4_t* xr = (f32x4_t*)xrow + lane;
    f32x4_t v[4]; float s = 0.f;
#pragma unroll
    for (int j = 0; j < 4; ++j) { v[j] = xr[64 * j]; if (addrow) v[j] += ((const f32x4_t*)addrow + lane)[64 * j]; s += dot4(v[j]); }
    const float r = __builtin_amdgcn_rsqf(wave_sum(s) * (1.0f / DM) + NEPS);
#pragma unroll
    for (int j = 0; j < 4; ++j) { const f32x4_t w = *(const f32x4_t*)(nw + 4 * lane + 256 * j); xr[64 * j] = v[j] * r * w; }
}

template <bool FINAL>
__device__ __forceinline__ void norm_rows4(int m0, int stride, const float* in_ctx, const float* in_lat, float* X, const float* PARTX, bfraw* HB,
                                           const float* nw, const float* modl, int sh_off, int sc_off, int lane, bool copy_in = true) {
    f32x4_t v[4][4];
#pragma unroll
    for (int r = 0; r < 4; ++r) {
        const int m = m0 + r * stride; if (m >= NTOK) break;
        const float* src = in_ctx ? (m < NCTX ? in_ctx + (size_t)m * DM : in_lat + (size_t)(m - NCTX) * DM) : X + (size_t)m * DM;
#pragma unroll
        for (int j = 0; j < 4; ++j) v[r][j] = ((const f32x4_t*)src + lane)[64 * j];
    }
    if (PARTX) {
        u32x2_t pv[4][4], pw[4][4];
#pragma unroll
        for (int r = 0; r < 4; ++r) { const int m = m0 + r * stride; if (m >= NTOK) break;
#pragma unroll
            for (int j = 0; j < 4; ++j) { pv[r][j] = ((const u32x2_t*)((const bfraw*)PARTX + (size_t)m * DM) + lane)[64 * j]; pw[r][j] = ((const u32x2_t*)((const bfraw*)PARTX + (size_t)(NTOK + m) * DM) + lane)[64 * j]; } }
#pragma unroll
        for (int r = 0; r < 4; ++r) { const int m = m0 + r * stride; if (m >= NTOK) break;
#pragma unroll
            for (int j = 0; j < 4; ++j) { const u32x2_t q = pv[r][j], q2 = pw[r][j];
                v[r][j][0] += __builtin_bit_cast(float, q.x << 16) + __builtin_bit_cast(float, q2.x << 16); v[r][j][1] += __builtin_bit_cast(float, q.x & 0xffff0000u) + __builtin_bit_cast(float, q2.x & 0xffff0000u);
                v[r][j][2] += __builtin_bit_cast(float, q.y << 16) + __builtin_bit_cast(float, q2.y << 16); v[r][j][3] += __builtin_bit_cast(float, q.y & 0xffff0000u) + __builtin_bit_cast(float, q2.y & 0xffff0000u); } }
    }
#pragma unroll
    for (int r = 0; r < 4; ++r) {
        const int m = m0 + r * stride; if (m >= NTOK) break;
        float s = 0.f;
#pragma unroll
        for (int j = 0; j < 4; ++j) s += dot4(v[r][j]);
        const float rr = __builtin_amdgcn_rsqf(wave_sum(s) * (1.0f / DM) + NEPS);
        const int cond = m < NCTX ? 0 : 1 + ((m - NCTX) >> 11);
        const float* md = modl + (size_t)cond * 6144;
#pragma unroll
        for (int j = 0; j < 4; ++j) {
            const int cidx = 4 * lane + 256 * j;
            const f32x4_t w = *(const f32x4_t*)(nw + cidx);
            if (FINAL) { ((f32x4_t*)(X + (size_t)m * DM) + lane)[64 * j] = v[r][j] * rr * w; }
            else {
                if ((in_ctx && copy_in) || PARTX) ((f32x4_t*)(X + (size_t)m * DM) + lane)[64 * j] = v[r][j];
                const f32x4_t sh = *(const f32x4_t*)(md + sh_off + cidx), sc = *(const f32x4_t*)(md + sc_off + cidx);
                st_bf4(HB + (size_t)m * DM + cidx, v[r][j] * rr * w * (1.0f + sc) + sh);
            }
        }
    }
}

struct AttnArgs {
    const bfraw* Q; int qcol0, qcol1;
    const bfraw* Kown; const bfraw* Kc; int kstride;
    int nOwn, nTot;
    const bfraw* Vown; int vsOwn; const bfraw* Vc; int vsC;
    bfraw* O; int ocol0, ocol1;
    float lam, postscale; const float* subln;
};
constexpr int ATT_VOFF = 17408, ATT_BUF = 36864, ATT_XOFF = 0;
template <int KROWB, bool QLDS>
__device__ __forceinline__ void att_s(const LAS unsigned char* cur, int koff, const s16x8_t (&qf)[4], const LAS s16x8_t* qlds, const f32x16_t& negm, f32x16_t& p0, f32x16_t& p1) {
#pragma unroll
    for (int d0 = 0; d0 < 4; ++d0) {
        const s16x8_t k0 = *(const LAS s16x8_t*)(cur + koff + d0 * 32);
        const s16x8_t k1 = *(const LAS s16x8_t*)(cur + koff + 32 * KROWB + d0 * 32);
        const s16x8_t q = QLDS ? qlds[d0 * 512] : qf[d0];
        if (d0 == 0) { p0 = __builtin_amdgcn_mfma_f32_32x32x16_bf16(k0, q, negm, 0, 0, 0); p1 = __builtin_amdgcn_mfma_f32_32x32x16_bf16(k1, q, negm, 0, 0, 0); }
        else { p0 = __builtin_amdgcn_mfma_f32_32x32x16_bf16(k0, q, p0, 0, 0, 0); p1 = __builtin_amdgcn_mfma_f32_32x32x16_bf16(k1, q, p1, 0, 0, 0); }
    }
}
__device__ __forceinline__ float vmax3(float a, float b, float c) { float r; asm("v_max3_f32 %0, %1, %2, %3" : "=v"(r) : "v"(a), "v"(b), "v"(c)); return r; }
template <bool FIRST>
__device__ __forceinline__ float att_softmax(f32x16_t& p0, f32x16_t& p1, float& m_run, float& l_run, f32x16_t& negm, u32x4_t (&pf)[4]) {
    asm volatile("s_nop 15\n\ts_nop 7" : "+v"(p0), "+v"(p1));
    float mx = vmax3(p0[0], p0[1], p1[0]);
    mx = vmax3(mx, p1[1], p0[2]);
#pragma unroll
    for (int r = 2; r < 16; r += 2) { if (r > 2) mx = vmax3(mx, p0[r], p1[r]); else mx = vmax3(mx, p1[2], p1[2]); mx = vmax3(mx, p0[r + 1], p1[r + 1]); }
    mx = __builtin_fmaxf(mx, __shfl_xor(mx, 32));
    float alpha = 1.0f;
    if (FIRST || __any(mx > 0.f)) {
        const float dl = FIRST ? mx : __builtin_fmaxf(mx, 0.f);
        m_run += dl; alpha = __builtin_amdgcn_exp2f(-dl);
#pragma unroll
        for (int r = 0; r < 16; ++r) { p0[r] -= dl; p1[r] -= dl; negm[r] = -m_run; }
    }
    float rs = 0.f;
#pragma unroll
    for (int r = 0; r < 16; ++r) { p0[r] = __builtin_amdgcn_exp2f(p0[r]); p1[r] = __builtin_amdgcn_exp2f(p1[r]); rs += p0[r] + p1[r]; }
    l_run = FIRST ? rs : l_run * alpha + rs;
#pragma unroll
    for (int s2 = 0; s2 < 2; ++s2) {
        pf[s2].x = pk2(p0[8 * s2 + 0], p0[8 * s2 + 1]); pf[s2].y = pk2(p0[8 * s2 + 2], p0[8 * s2 + 3]); pf[s2].z = pk2(p0[8 * s2 + 4], p0[8 * s2 + 5]); pf[s2].w = pk2(p0[8 * s2 + 6], p0[8 * s2 + 7]);
        pf[2 + s2].x = pk2(p1[8 * s2 + 0], p1[8 * s2 + 1]); pf[2 + s2].y = pk2(p1[8 * s2 + 2], p1[8 * s2 + 3]); pf[2 + s2].z = pk2(p1[8 * s2 + 4], p1[8 * s2 + 5]); pf[2 + s2].w = pk2(p1[8 * s2 + 6], p1[8 * s2 + 7]);
    }
    return alpha;
}
template <int NDB>
__device__ __forceinline__ void att_pv(const LAS unsigned char* vt, int voff, const u32x4_t (&pf)[4], f32x16_t (&o)[NDB]) {
#pragma unroll
    for (int js = 0; js < 4; ++js) {
        const s16x8_t pfr = __builtin_bit_cast(s16x8_t, pf[js]);
#pragma unroll
        for (int db = 0; db < NDB; ++db) {
            const LAS unsigned char* vp = vt + voff + db * (32 * 144) + js * 32;
            const u32x2_t lo = *(const LAS u32x2_t*)vp, hh = *(const LAS u32x2_t*)(vp + 16);
            u32x4_t vw; vw.x = lo.x; vw.y = lo.y; vw.z = hh.x; vw.w = hh.y;
            o[db] = __builtin_amdgcn_mfma_f32_32x32x16_bf16(__builtin_bit_cast(s16x8_t, vw), pfr, o[db], 0, 0, 0);
        }
    }
}
template <int DV, int KROW, bool DIFF>
__device__ __forceinline__ void attn_unit(LAS unsigned char* lds, const AttnArgs& a) {
    constexpr int KROWB = KROW * 2 + 16, NKC = KROW / 64, NVC = DV / 64, NDB = DV / 32, KPR = KROW / 8;
    int tid_ = threadIdx.x; asm volatile("" : "+v"(tid_));
    const int tid = tid_, lane = tid & 63, r32 = lane & 31, hi = lane >> 5;
    const int wid = __builtin_amdgcn_readfirstlane(tid >> 6), g = wid >> 2, wq = wid & 3;
    const int kcol = (KROW == 128) ? g * 64 : 0;
    const int koff = r32 * KROWB + (kcol + hi * 8) * 2;
    const int voff = ATT_VOFF + r32 * 144 + hi * 8;
    constexpr bool QLDS = false;
    s16x8_t qf[4];
    LAS s16x8_t* const qlds = (LAS s16x8_t*)(lds + 3 * ATT_BUF) + tid;
    { const bfraw* qp = a.Q + (size_t)(wq * 32 + r32) * 512 + (g ? a.qcol1 : a.qcol0) + hi * 8;
#pragma unroll
      for (int d0 = 0; d0 < 4; ++d0) { qf[d0] = *(const s16x8_t*)(qp + d0 * 16); if (QLDS) qlds[d0 * 512] = qf[d0]; } }
    f32x16_t o[NDB];
#pragma unroll
    for (int db = 0; db < NDB; ++db)
#pragma unroll
        for (int r = 0; r < 16; ++r) o[db][r] = 0.f;
    float m_run = 0.f, l_run = 0.f;
    f32x16_t negm;
#pragma unroll
    for (int r = 0; r < 16; ++r) negm[r] = 0.f;
    u32x4_t kreg[NKC], vreg[NVC];
#define ATT_GLOAD(tn_) do { const int tn = (tn_); const bool own = tn < a.nOwn; \
            const bfraw* kb = own ? a.Kown + (size_t)tn * 64 * a.kstride : a.Kc + (size_t)(tn - a.nOwn) * 64 * a.kstride; \
            const bfraw* vb = own ? a.Vown + tn * 64 : a.Vc + (tn - a.nOwn) * 64; const int vs = own ? a.vsOwn : a.vsC; \
            _Pragma("unroll") for (int i = 0; i < NKC; ++i) { const int ch = tid + 512 * i, key = ch / KPR, part = ch % KPR; kreg[i] = *(const u32x4_t*)(kb + (size_t)key * a.kstride + part * 8); } \
            _Pragma("unroll") for (int i = 0; i < NVC; ++i) { const int ch = tid + 512 * i, d = ch >> 3, part = ch & 7; vreg[i] = *(const u32x4_t*)(vb + (size_t)d * vs + part * 8); } } while (0)
#define ATT_LSTORE(buf_) do { LAS unsigned char* const nb_ = (buf_); \
            _Pragma("unroll") for (int i = 0; i < NKC; ++i) { const int ch = tid + 512 * i, key = ch / KPR, part = ch % KPR; *(LAS u32x4_t*)(nb_ + key * KROWB + part * 16) = kreg[i]; } \
            _Pragma("unroll") for (int i = 0; i < NVC; ++i) { const int ch = tid + 512 * i, d = ch >> 3, part = ch & 7; *(LAS u32x4_t*)(nb_ + ATT_VOFF + d * 144 + part * 16) = vreg[i]; } } while (0)
    ATT_GLOAD(0);
    ATT_LSTORE(lds);
    __syncthreads();
    ATT_GLOAD(1);
    u32x4_t pf[4];
    {
        f32x16_t p0, p1;
        att_s<KROWB, QLDS>(lds, koff, qf, qlds, negm, p0, p1);
        (void)att_softmax<true>(p0, p1, m_run, l_run, negm, pf);
        ATT_LSTORE(lds + ATT_BUF);
        __syncthreads();
        if (a.nTot > 2) ATT_GLOAD(2);
    }
    int ic = 1, ip = 0, in = 2;
    for (int t = 1; t < a.nTot; ++t) {
        const LAS unsigned char* const cur = lds + ic * ATT_BUF; const LAS unsigned char* const prv = lds + ip * ATT_BUF;
        f32x16_t p0, p1;
        att_s<KROWB, QLDS>(cur, koff, qf, qlds, negm, p0, p1);
        att_pv<NDB>(prv, voff, pf, o);
        u32x4_t pn[4];
        const float alpha = att_softmax<false>(p0, p1, m_run, l_run, negm, pn);
        if (__any(alpha != 1.0f)) {
#pragma unroll
            for (int db = 0; db < NDB; ++db)
#pragma unroll
                for (int r = 0; r < 16; ++r) o[db][r] *= alpha;
        }
#pragma unroll
        for (int i = 0; i < 4; ++i) pf[i] = pn[i];
        if (t + 1 < a.nTot) ATT_LSTORE(lds + in * ATT_BUF);
        __syncthreads();
        if (t + 2 < a.nTot) ATT_GLOAD(t + 2);
        const int tmp = ip; ip = ic; ic = in; in = tmp;
    }
    att_pv<NDB>(lds + ip * ATT_BUF, voff, pf, o);
    __syncthreads();
#undef ATT_GLOAD
#undef ATT_LSTORE
    const float ltot = l_run + __shfl_xor(l_run, 32);
    const float inv = 1.0f / ltot;
    const int qrow = wq * 32 + r32;
    if (DIFF) {
        LAS float* xch = (LAS float*)(lds + ATT_XOFF) + wq * 64 * 64 + lane;
        if (g == 1) {
            const float sc = inv * a.lam;
#pragma unroll
            for (int db = 0; db < NDB; ++db)
#pragma unroll
                for (int r = 0; r < 16; ++r) xch[(db * 16 + r) * 64] = o[db][r] * sc;
        }
        __syncthreads();
        if (g == 0) {
            float ss = 0.f;
#pragma unroll
            for (int db = 0; db < NDB; ++db)
#pragma unroll
                for (int r = 0; r < 16; ++r) { const float v = o[db][r] * inv - xch[(db * 16 + r) * 64]; o[db][r] = v; ss += v * v; }
            ss += __shfl_xor(ss, 32);
            const float rn = __builtin_amdgcn_rsqf(ss * (1.0f / 128.0f) + NEPS) * a.postscale;
            bfraw* op = a.O + (size_t)qrow * 512 + a.ocol0 + 4 * hi;
#pragma unroll
            for (int db = 0; db < NDB; ++db)
#pragma unroll
                for (int rr = 0; rr < 4; ++rr) {
                    const int d = 32 * db + 8 * rr;
                    const f32x4_t w = *(const f32x4_t*)(a.subln + d + 4 * hi);
                    f32x4_t v; v[0] = o[db][4 * rr] * rn * w[0]; v[1] = o[db][4 * rr + 1] * rn * w[1]; v[2] = o[db][4 * rr + 2] * rn * w[2]; v[3] = o[db][4 * rr + 3] * rn * w[3];
                    st_bf4(op + d, v);
                }
        }
    } else {
        bfraw* op = a.O + (size_t)qrow * 512 + (g ? a.ocol1 : a.ocol0) + 4 * hi;
#pragma unroll
        for (int db = 0; db < NDB; ++db)
#pragma unroll
            for (int rr = 0; rr < 4; ++rr) {
                f32x4_t v; v[0] = o[db][4 * rr] * inv; v[1] = o[db][4 * rr + 1] * inv; v[2] = o[db][4 * rr + 2] * inv; v[3] = o[db][4 * rr + 3] * inv;
                st_bf4(op + 32 * db + 8 * rr, v);
            }
    }
    __syncthreads();
}

__device__ __forceinline__ void conv_unit(LAS unsigned char* lds, int unit, const bfraw* U, bfraw* UC, const float* cw, const float* cb, const float* lg, const float* lbeta) {
    int tid_ = threadIdx.x; asm volatile("" : "+v"(tid_));
    const int tid = tid_, lane = tid & 63, wid = tid >> 6, c = tid;
    const int m0 = unit * 32;
    int lo, hi_;
    if (m0 < NCTX) { lo = (m0 / CSEQ) * CSEQ; hi_ = lo + CSEQ; } else { lo = NCTX + ((m0 - NCTX) / LSEQ) * LSEQ; hi_ = lo + LSEQ; }
    LAS bfraw* sin_ = (LAS bfraw*)lds;
    LAS float* sm = (LAS float*)(lds + 65536);
    LAS float* st = (LAS float*)(lds + 131072);
#pragma unroll
    for (int k = 0; k < 8; ++k) {
        const int ch = tid + 512 * k, i = ch >> 6, part = ch & 63; int tok = m0 - 15 + i;
        const bool ok = tok >= lo && tok < hi_ && i < 62;
        tok = tok < lo ? lo : (tok >= hi_ ? hi_ - 1 : tok);
        u32x4_t v = *(const u32x4_t*)(U + (size_t)tok * 512 + part * 8);
        if (!ok) v = (u32x4_t){0u, 0u, 0u, 0u};
        if (i < 62) *(LAS u32x4_t*)(sin_ + i * 512 + part * 8) = v;
    }
    float w[31];
#pragma unroll
    for (int j = 0; j < 31; ++j) w[j] = cw[j * 512 + c];
    const float bias = cb[c];
    __syncthreads();
#pragma unroll 1
    for (int g = 0; g < 4; ++g) {
        float acc[8];
#pragma unroll
        for (int o = 0; o < 8; ++o) acc[o] = bias;
        const LAS bfraw* sp = sin_ + (8 * g) * 512 + c;
#pragma unroll
        for (int i = 0; i < 38; ++i) {
            const float v = bf2f(sp[i * 512]);
#pragma unroll
            for (int o = 0; o < 8; ++o) { const int j = i - o; if (j >= 0 && j < 31) acc[o] += v * w[j]; }
        }
#pragma unroll
        for (int o = 0; o < 8; ++o) sm[(8 * g + o) * 512 + c] = acc[o];
    }
    __syncthreads();
#pragma unroll
    for (int tt = 0; tt < 4; ++tt) {
        const int tok = wid * 4 + tt; float s = 0.f, q = 0.f;
#pragma unroll
        for (int k = 0; k < 8; ++k) { const float x = sm[tok * 512 + lane + 64 * k]; s += x; q += x * x; }
        s = wave_sum(s); q = wave_sum(q);
        const float mu = s * (1.0f / 512.0f), var = __builtin_fmaxf(q * (1.0f / 512.0f) - mu * mu, 0.f);
        if (lane == 0) { st[tok * 2] = mu; st[tok * 2 + 1] = __builtin_amdgcn_rsqf(var + NEPS); }
    }
    __syncthreads();
    const float gg = lg[c], bb = lbeta[c];
#pragma unroll 8
    for (int o = 0; o < 32; ++o) {
        const float y = (sm[o * 512 + c] - st[o * 2]) * st[o * 2 + 1] * gg + bb;
        UC[(size_t)(m0 + o) * 512 + c] = f2bf(y * sigmoidf_(y));
    }
    __syncthreads();
}

template <bool PERMIN>
__device__ __forceinline__ void convert_item(const float* W, int K, int N, bfraw* WT, int vrow0, int n0, int k0, LAS float* scr, int tid) {
    const int lane = tid & 63, wave = tid >> 6;
    float v[16][4];
#pragma unroll
    for (int g4 = 0; g4 < 4; ++g4) {
        const int vc = g4 * 64 + lane;
        const int col = PERMIN ? vcol_map((vrow0 + vc) >> 5) + (vc & 31) : n0 + vc;
#pragma unroll
        for (int r = 0; r < 16; ++r) v[r][g4] = W[(size_t)(k0 + wave * 16 + r) * N + col];
    }
#pragma unroll
    for (int r = 0; r < 16; ++r)
#pragma unroll
        for (int g4 = 0; g4 < 4; ++g4) scr[(wave * 16 + r) * 257 + g4 * 64 + lane] = v[r][g4];
    __syncthreads();
#pragma unroll
    for (int it = 0; it < 8; ++it) {
        const int ch = it * 512 + tid, n = ch >> 4, kc = ch & 15;
        const LAS float* s = scr + (8 * kc) * 257 + n;
        u32x4_t o; o.x = pk2(s[0], s[257]); o.y = pk2(s[2 * 257], s[3 * 257]); o.z = pk2(s[4 * 257], s[5 * 257]); o.w = pk2(s[6 * 257], s[7 * 257]);
        *(u32x4_t*)(WT + (size_t)(vrow0 + n) * K + k0 + 8 * kc) = o;
    }
    __syncthreads();
}
#define CONVERT_RANGE(IT0, ITEND, STEP) { \
        LAS float* scr = (LAS float*)lds; \
        constexpr int I_IN = 8 * 25, I_BR = 3 * 16, I_O = 32, I_1 = 128, I_2 = 128, I_L = I_IN + I_BR + I_O + I_1 + I_2; \
        for (int it = (IT0); it < (ITEND); it += (STEP)) { \
            const int l = it / I_L; int r = it % I_L; \
            if (r < I_IN) { const int kb = r / 25, nt = r % 25; convert_item<true>(a.in[12] + (size_t)l * DM * INW, DM, INW, (bfraw*)(ws + WS_WIN + l * WIN_L), nt * 256, 0, kb * 128, scr, tid); continue; } r -= I_IN; \
            if (r < I_BR) { const int br = r >> 4, rr = r & 15, kb = rr >> 2, nt = rr & 3; const float* W = (br == 0 ? a.in[18] : br == 1 ? a.in[21] : a.in[26]) + (size_t)l * 512 * 1024; \
                convert_item<false>(W, 512, 1024, (bfraw*)(ws + WS_WBR + l * WBR_L) + (size_t)br * 1024 * 512, nt * 256, nt * 256, kb * 128, scr, tid); continue; } r -= I_BR; \
            if (r < I_O) { const int kb = r >> 2, nt = r & 3; convert_item<false>(a.in[27] + (size_t)l * 1024 * 1024, 1024, 1024, (bfraw*)(ws + WS_WO + l * WO_L), nt * 256, nt * 256, kb * 128, scr, tid); continue; } r -= I_O; \
            if (r < I_1) { const int kb = r >> 4, nt = r & 15; convert_item<false>(a.in[28] + (size_t)l * 1024 * 4096, 1024, 4096, (bfraw*)(ws + WS_W1 + l * W1_L), nt * 256, nt * 256, kb * 128, scr, tid); continue; } r -= I_1; \
            { const int kb = r >> 2, nt = r & 3; convert_item<false>(a.in[29] + (size_t)l * 4096 * 1024, 4096, 1024, (bfraw*)(ws + WS_W2 + l * W2_L), nt * 256, nt * 256, kb * 128, scr, tid); } \
        } }
#define P0_CONVERT { if (G == 256) CONVERT_RANGE(G - 1 - bid, 200, G) else CONVERT_RANGE(G - 1 - bid, 1072, G) }
#define CONV_PHASE \
            for (int u0 = bid; u0 < NTOK / 32; u0 += G) { const int u = (G == 256) ? 32 * (u0 & 7) + (u0 >> 3) : u0;     \
                conv_unit(lds, u, (const bfraw*)(P_PROJ + P_U), P_ABR + (size_t)2 * NTOK * 512, a.in[22] + l * 31 * 512, a.in[23] + l * 512, a.in[24] + l * 512, a.in[25] + l * 512); }
#define PH_BEGIN const CAS_ KArgs* ap_ = (const CAS_ KArgs*)__builtin_amdgcn_kernarg_segment_ptr(); asm volatile("" : "+s"(ap_)); const CAS_ KArgs& a = *ap_; \
    GAS_ unsigned char* wsg_ = (GAS_ unsigned char*)a.ws; asm volatile("" : "+s"(wsg_)); unsigned char* ws = (unsigned char*)wsg_; int tid = threadIdx.x; asm volatile("" : "+v"(tid)); \
    const int lane = tid & 63, wave = __builtin_amdgcn_readfirstlane(tid >> 6), gw = bid * 8 + wave, NGW = G * 8; (void)lane; (void)gw; (void)NGW; (void)wave;
#define GAS_ __attribute__((address_space(1)))
#define CAS_ __attribute__((address_space(4)))
#ifdef TPROBE
#ifndef TP_BLK
#define TP_BLK 0
#endif
#define STAMP(k) do { if (bid == TP_BLK && threadIdx.x == 0) ((volatile LAS unsigned long long*)(lds + 146880))[(k)] = __builtin_amdgcn_s_memrealtime(); } while (0)
#else
#define STAMP(k) do {} while (0)
#endif
#ifndef SPLITK
#define SPLITK 1
#endif
#ifndef PATAIL
#define PATAIL 1
#endif
#ifndef LOCALBAR
#define LOCALBAR 1
#endif
#ifndef NOCG
#define NOCG 1
#endif
#ifndef C2SPLIT
#define C2SPLIT 1
#endif
#ifndef GALIGN
#define GALIGN true
#endif
#ifndef C1HALFN
#define C1HALFN 1
#endif
#ifndef C1PAIR
#define C1PAIR 0
#endif
#ifdef XPROBE
#define XP_OFF(x) 0
#define XPROBE_KL(full) (full)
#else
#define XP_OFF(x) (x)
#define XPROBE_KL(full) kh
#endif
#define NR_XCD (G == 256)
#define NR_M0 (NR_XCD ? 1024 * (bid & 7) + (((bid >> 3) * 8 + wave) * 4) : gw)
#define NR_END (NR_XCD ? NR_M0 + 1 : NTOK)
#define NR_STEP (NR_XCD ? 4 : 4 * NGW)
#define NR_STRIDE (NR_XCD ? 1 : NGW)
#define P_MOD ((float*)(ws + WS_MOD))
#define P_HB ((bfraw*)(ws + WS_HB))
#define P_ABR ((bfraw*)(ws + WS_ABR))
#define P_PROJ (ws + WS_PROJ)
#define P_X (a.out + O_X)
__global__ void __launch_bounds__(512, 2) fwd_kernel(KArgs a_) {
    extern __shared__ __attribute__((aligned(16))) unsigned char lds_raw[];
    LAS unsigned char* lds = (LAS unsigned char*)lds_raw;
    cg::grid_group grid = cg::this_grid();
    int bid = blockIdx.x; const int G = gridDim.x;
    volatile LAS unsigned* bst = (volatile LAS unsigned*)(lds + 147392);
    STAMP(0);
    {
        PH_BEGIN
        unsigned* barw = (unsigned*)(ws + WS_BAR);
        if (tid == 0) { bst[0] = 0u; bst[1] = 0u; bst[2] = 0u; bst[3] = 0u; }
#if !NOCG
        if (bid == 0) for (int i = tid; i < 6656; i += 512) __hip_atomic_store(barw + i, 0u, __ATOMIC_RELAXED, __HIP_MEMORY_SCOPE_AGENT);
#else
        (void)barw;
#endif
        __syncthreads();
    }
#if NOCG
    const XcdBarrier bar = xcd_barrier_post((unsigned*)(a_.ws + WS_BAR), bst);
#endif
#pragma unroll 1
    for (int rep_ = 0; rep_ < REP_P0; ++rep_) {
        PH_BEGIN
        LAS float* sil = (LAS float*)lds;
        for (int i = tid; i < 3072; i += 512) { const int cond = i >> 10, k = i & 1023; const float v = cond == 0 ? a.in[7][k] : a.in[6][(cond - 1) * 1024 + k]; sil[i] = v * sigmoidf_(v); }
        __syncthreads();
        LAS float* part = (LAS float*)(lds + 16384);
        for (int item = bid; item < 192; item += G) {
            const int l = item / 96, nb = (item % 96) * 64;
            const float* W = a.in[8] + (size_t)l * 1024 * 6144 + nb + lane;
            const int k0 = wave * 128;
            float a0 = 0.f, a1 = 0.f, a2 = 0.f;
#pragma unroll 32
            for (int kk = 0; kk < 128; ++kk) { const float wv = W[(size_t)(k0 + kk) * 6144]; a0 += sil[k0 + kk] * wv; a1 += sil[1024 + k0 + kk] * wv; a2 += sil[2048 + k0 + kk] * wv; }
            part[(wave * 3 + 0) * 64 + lane] = a0; part[(wave * 3 + 1) * 64 + lane] = a1; part[(wave * 3 + 2) * 64 + lane] = a2;
            __syncthreads();
            if (tid < 192) { const int cnd = tid >> 6, ln = tid & 63; float s = 0.f;
#pragma unroll
                for (int wv = 0; wv < 8; ++wv) s += part[(wv * 3 + cnd) * 64 + ln];
                P_MOD[(size_t)(l * 3 + cnd) * 6144 + nb + ln] = s + a.in[9][l * 6144 + nb + ln]; }
            __syncthreads();
        }
        if ((bid == G - 3 || G < 3) && tid < 2) {
            float d1 = 0.f, d2 = 0.f;
            for (int i = 0; i < 64; ++i) { d1 += a.in[13][tid * 64 + i] * a.in[14][tid * 64 + i]; d2 += a.in[15][tid * 64 + i] * a.in[16][tid * 64 + i]; }
            ((float*)(ws + WS_LAM))[tid] = __builtin_amdgcn_exp2f(d1 * 1.4426950408889634f) - __builtin_amdgcn_exp2f(d2 * 1.4426950408889634f) + (tid == 0 ? 0.2f : 0.35550907f);
        }
        if (bid == G - 2 || G == 1) { float* QKN = (float*)(ws + WS_QKN); if (tid < 256) { const int l_ = tid >> 7, w_ = (tid >> 6) & 1, d_ = tid & 63; QKN[tid] = (w_ ? a.in[20] : a.in[19])[l_ * 64 + d_]; } }
        if (bid == G - 1) {
            float* ROPEC = (float*)(ws + WS_ROPEC); float* ROPES = (float*)(ws + WS_ROPES);
            for (int i = tid; i < 1024; i += 512) { const int pos = i >> 4, j = i & 15; const float freq = __builtin_amdgcn_exp2f(-(float)j * 0.8304820237218406f);
                float s, c; sincos_small((float)pos * freq, s, c); ROPEC[i] = c; ROPES[i] = s; }
        }
        __syncthreads();
        P0_CONVERT
        const int gt = bid * 512 + tid, GT = G * 512;
        bfraw* CDK = (bfraw*)(ws + WS_CDK); bfraw* CDVT = (bfraw*)(ws + WS_CDVT); bfraw* CGK = (bfraw*)(ws + WS_CGK); bfraw* CGVT = (bfraw*)(ws + WS_CGVT);
        for (int i = gt; i < 2 * 2 * 256 * 512; i += GT) { const int col = i & 511, s = (i >> 9) & 255, l = (i >> 17) & 1, lb = i >> 18;
            CDK[((size_t)(l * 2 + lb) * 256 + s) * 512 + col] = f2bf(a.in[2][i]); CDVT[((size_t)(l * 2 + lb) * 512 + col) * 256 + s] = f2bf(a.in[3][i]); }
        for (int i = gt; i < 2 * 2 * 256 * 128; i += GT) { const int col = i & 127, s = (i >> 7) & 255, l = (i >> 15) & 1, lb = i >> 16;
            CGK[((size_t)(l * 2 + lb) * 256 + s) * 128 + col] = f2bf(a.in[4][i]); CGVT[((size_t)(l * 2 + lb) * 128 + col) * 256 + s] = f2bf(a.in[5][i]); }
    }
#if !NOCG
    grid.sync();
    const XcdBarrier bar = xcd_barrier_post((unsigned*)(a_.ws + WS_BAR), bst);
#else
    if (G == 0x7fffffff) grid.sync();
    xcd_barrier(bar);
#endif
    STAMP(1);
    for (int rep_ = 0; rep_ < REP_SYNC; ++rep_) xcd_barrier(bar);
#if NOCG
    const bool lbar = LOCALBAR && bst[3] != 0u;
    if (lbar) bid = (int)(bst[2] * 8u + bar.x);
#endif
    {
        PH_BEGIN
        for (int mb = NR_M0; mb < NR_END; mb += NR_STEP) norm_rows4<false>(mb, NR_STRIDE, a.in[0], a.in[1], P_X, nullptr, P_HB, a.in[10], P_MOD, M_SH1, M_SC1, lane, !((G == 256) && SPLITK && C2SPLIT));
    }
#if NOCG
    if (lbar) xcc_local_barrier(bar); else xcd_barrier(bar);
#else
    xcd_barrier(bar);
#endif
    STAMP(2);
#if !NOCG
    const bool lbar = LOCALBAR && bst[3] != 0u;
    if (lbar) bid = (int)(bst[2] * 8u + bar.x);
#endif
#define SEAM_LOCAL() do { if (lbar) xcc_local_barrier(bar); else xcd_barrier(bar); } while (0)

#pragma unroll 1
    for (int l = 0; l < 2; ++l) {
#pragma unroll 1
        for (int rep_ = 0; rep_ < REP_PA; ++rep_) {
            PH_BEGIN
            EpiCtx ec; ec.l = l; ec.out = a.out; ec.ws = ws;
            pg8::Gemm g{P_HB, (const bfraw*)(ws + WS_WIN + l * WIN_L), NTOK, INW, DM, DM, -1};
            const bool tail = (G == 256) && PATAIL;
            { pg8::EpiIn E{ec, -1}; pg8::StaticOrder S; S.init(NTOK, tail ? 24 * 256 : INW, G, bid); pg8::gemm_phase<pg8::EpiIn, pg8::StaticOrder, GALIGN, true>(lds, g, S, E); }
            if (tail) { pg8::Gemm g2{P_HB, (const bfraw*)(ws + WS_WIN + l * WIN_L), NTOK, INW, DM, DM, (bid >> 3) & 1}; pg8::EpiIn E2{ec, (bid >> 3) & 1}; pg8::QuarterOrder S{bid}; pg8::gemm_phase<pg8::EpiIn, pg8::QuarterOrder, true, true>(lds, g2, S, E2); }
            if (l == 0 && rep_ == 0 && G == 256 && bid >= 64) { __syncthreads(); CONVERT_RANGE(200 + (bid - 64), 584, 192) }
        }
        xcd_barrier(bar);
        STAMP(3 + l * 8 + 0);
#pragma unroll 1
        for (int rep_ = 0; rep_ < REP_ATT; ++rep_) {
            PH_BEGIN
            const float lam_init = l == 0 ? 0.2f : 0.35550907f;
            const float lam = ((const float*)(ws + WS_LAM))[l];
            const bfraw* CDK = (const bfraw*)(ws + WS_CDK); const bfraw* CDVT = (const bfraw*)(ws + WS_CDVT); const bfraw* CGK = (const bfraw*)(ws + WS_CGK); const bfraw* CGVT = (const bfraw*)(ws + WS_CGVT);
            bfraw* const DQ = (bfraw*)(P_PROJ + P_DQ); bfraw* const DK = (bfraw*)(P_PROJ + P_DK); bfraw* const DVtC = (bfraw*)(P_PROJ + P_DVTC); bfraw* const DVtL = (bfraw*)(P_PROJ + P_DVTL);
            bfraw* const GQ = (bfraw*)(P_PROJ + P_GQ); bfraw* const GK = (bfraw*)(P_PROJ + P_GK); bfraw* const GVtC = (bfraw*)(P_PROJ + P_GVTC); bfraw* const GVtL = (bfraw*)(P_PROJ + P_GVTL);
            bfraw* const ABR = P_ABR;
            for (int k = 0; ; ++k) {
                int u;
                if (G == 256) { if (bid < 128) { if (k > 0) break; u = bid; } else { if (k > 2) break; u = 128 * (k + 1) + (bid - 128); } }
                else { u = bid + k * G; if (u >= 512) break; }
                const int cls = u >> 7, j_ = u & 127, i = (G == 256) ? (j_ & 7) * 16 + (j_ >> 3) : j_;
                AttnArgs t;
                t.lam = lam; t.postscale = 1.0f - lam_init; t.subln = a.in[17] + l * 128;
                if (cls == 0) {
                    const int lb = i >> 6, h = (i >> 4) & 3, qb = i & 15; const int row0 = NCTX + lb * LSEQ;
                    t.Q = DQ + (size_t)(row0 + qb * 128) * 512; t.qcol0 = h * 128; t.qcol1 = h * 128 + 64;
                    t.Kown = DK + (size_t)row0 * 512 + h * 128; t.Kc = CDK + (size_t)(l * 2 + lb) * 256 * 512 + h * 128; t.kstride = 512; t.nOwn = 32; t.nTot = 36;
                    t.Vown = DVtL + ((size_t)lb * 512 + h * 128) * 2048; t.vsOwn = 2048; t.Vc = CDVT + ((size_t)(l * 2 + lb) * 512 + h * 128) * 256; t.vsC = 256;
                    t.O = ABR + (size_t)(row0 + qb * 128) * 512; t.ocol0 = h * 128; t.ocol1 = 0;
                    attn_unit<128, 128, true>(lds, t);
                } else if (cls == 2) {
                    const int cb = i >> 3, h = (i >> 1) & 3, qb = i & 1; const int row0 = cb * CSEQ;
                    t.Q = DQ + (size_t)(row0 + qb * 128) * 512; t.qcol0 = h * 128; t.qcol1 = h * 128 + 64;
                    t.Kown = DK + (size_t)row0 * 512 + h * 128; t.Kc = t.Kown; t.kstride = 512; t.nOwn = 4; t.nTot = 4;
                    t.Vown = DVtC + ((size_t)cb * 512 + h * 128) * 256; t.vsOwn = 256; t.Vc = t.Vown; t.vsC = 256;
                    t.O = ABR + (size_t)(row0 + qb * 128) * 512; t.ocol0 = h * 128; t.ocol1 = 0;
                    attn_unit<128, 128, true>(lds, t);
                } else if (cls == 1) {
                    const int lb = i >> 6, pr = (i >> 4) & 3, qb = i & 15, kvh = pr >> 1, h0 = kvh * 4 + (pr & 1) * 2; const int row0 = NCTX + lb * LSEQ;
                    t.Q = GQ + (size_t)(row0 + qb * 128) * 512; t.qcol0 = h0 * 64; t.qcol1 = h0 * 64 + 64;
                    t.Kown = GK + (size_t)row0 * 128 + kvh * 64; t.Kc = CGK + (size_t)(l * 2 + lb) * 256 * 128 + kvh * 64; t.kstride = 128; t.nOwn = 32; t.nTot = 36;
                    t.Vown = GVtL + ((size_t)lb * 128 + kvh * 64) * 2048; t.vsOwn = 2048; t.Vc = CGVT + ((size_t)(l * 2 + lb) * 128 + kvh * 64) * 256; t.vsC = 256;
                    t.O = ABR + (size_t)NTOK * 512 + (size_t)(row0 + qb * 128) * 512; t.ocol0 = h0 * 64; t.ocol1 = h0 * 64 + 64;
                    attn_unit<64, 64, false>(lds, t);
                } else {
                    const int cb = i >> 3, pr = (i >> 1) & 3, qb = i & 1, kvh = pr >> 1, h0 = kvh * 4 + (pr & 1) * 2; const int row0 = cb * CSEQ;
                    t.Q = GQ + (size_t)(row0 + qb * 128) * 512; t.qcol0 = h0 * 64; t.qcol1 = h0 * 64 + 64;
                    t.Kown = GK + (size_t)row0 * 128 + kvh * 64; t.Kc = t.Kown; t.kstride = 128; t.nOwn = 4; t.nTot = 4;
                    t.Vown = GVtC + ((size_t)cb * 128 + kvh * 64) * 256; t.vsOwn = 256; t.Vc = t.Vown; t.vsC = 256;
                    t.O = ABR + (size_t)NTOK * 512 + (size_t)(row0 + qb * 128) * 512; t.ocol0 = h0 * 64; t.ocol1 = h0 * 64 + 64;
                    attn_unit<64, 64, false>(lds, t);
                }
            }
        }
        STAMP(20 + l * 2);
#pragma unroll 1
        for (int rep_ = 0; rep_ < REP_CONV; ++rep_) {
            PH_BEGIN
            CONV_PHASE
        }
        STAMP(21 + l * 2);
        xcd_barrier(bar);
        STAMP(3 + l * 8 + 1);
#pragma unroll 1
        for (int rep_ = 0; rep_ < REP_C1; ++rep_) {
            PH_BEGIN
            EpiCtx ec; ec.l = l; ec.out = a.out; ec.ws = ws;
            const bool sp = (G == 256) && SPLITK && C1HALFN; const int pairm = (lbar && C1PAIR) ? 1 : 0; const int bjs = pairm ? -1 : (sp ? (bid >> 7) : -1);
            pg8::Gemm g{P_ABR, (const bfraw*)(ws + WS_WBR + l * WBR_L), 3 * NTOK, 3 * 1024, 512, 512, bjs}; pg8::BranchOrder S{(sp || pairm) ? (bid & 127) : bid, bid >> 7, pairm};
            pg8::EpiBranch E{ec, bjs, pairm, (unsigned)(l + 1)};
            pg8::gemm_phase<pg8::EpiBranch, pg8::BranchOrder, true, true>(lds, g, S, E);
            if (l == 0 && rep_ == 0 && G == 256) { __syncthreads(); if (C1HALFN) { CONVERT_RANGE(584 + bid, 1072, 256) } else if (bid >= 128) { CONVERT_RANGE(584 + (bid - 128), 1072, 128) } }
        }
        SEAM_LOCAL();
        STAMP(3 + l * 8 + 2);
#pragma unroll 1
        for (int rep_ = 0; rep_ < REP_C2; ++rep_) {
            PH_BEGIN
            EpiCtx ec; ec.l = l; ec.out = a.out; ec.ws = ws;
            const bool sp = (G == 256) && SPLITK && C2SPLIT; const int half = sp ? (bid >> 7) : 0, kh = sp ? DM / 2 : DM;
            pg8::Gemm g{P_HB + half * kh, (const bfraw*)(ws + WS_WO + l * WO_L) + half * kh, NTOK, DM, DM, kh, -1}; pg8::StaticOrder S; S.init(NTOK, DM, sp ? 128 : G, sp ? (bid & 127) : bid);
            pg8::EpiRes E{ec, M_G1, sp ? (half ? 1 : 2) : 0};
            pg8::gemm_phase<pg8::EpiRes, pg8::StaticOrder, false, true>(lds, g, S, E);
        }
        SEAM_LOCAL();
        STAMP(3 + l * 8 + 3);
        {
            PH_BEGIN
            for (int mb = NR_M0; mb < NR_END; mb += NR_STEP) norm_rows4<false>(mb, NR_STRIDE, (l == 0 && (G == 256) && SPLITK && C2SPLIT) ? a.in[0] : nullptr, a.in[1], P_X, ((G == 256) && SPLITK && C2SPLIT) ? (const float*)(ws + WS_PART) : nullptr, P_HB, a.in[11] + l * DM, P_MOD + (size_t)(l * 3) * 6144, M_SH2, M_SC2, lane);
        }
        SEAM_LOCAL();
        STAMP(3 + l * 8 + 4);
#pragma unroll 1
        for (int rep_ = 0; rep_ < REP_M1; ++rep_) {
            PH_BEGIN
            EpiCtx ec; ec.l = l; ec.out = a.out; ec.ws = ws;
            pg8::Gemm g{P_HB, (const bfraw*)(ws + WS_W1 + l * W1_L), NTOK, FF, DM, DM, -1}; pg8::StaticOrder S; S.init(NTOK, FF, G, bid);
            pg8::EpiRelu2 E{ec};
            pg8::gemm_phase<pg8::EpiRelu2, pg8::StaticOrder, GALIGN, true>(lds, g, S, E);
        }
        SEAM_LOCAL();
        STAMP(3 + l * 8 + 5);
#pragma unroll 1
        for (int rep_ = 0; rep_ < REP_M2; ++rep_) {
            PH_BEGIN
            EpiCtx ec; ec.l = l; ec.out = a.out; ec.ws = ws;
            const bool sp = (G == 256) && SPLITK; const int half = sp ? (bid >> 7) : 0, kh = sp ? FF / 2 : FF;
            pg8::Gemm g{(const bfraw*)P_PROJ + half * kh, (const bfraw*)(ws + WS_W2 + l * W2_L) + half * kh, NTOK, DM, FF, kh, -1}; pg8::StaticOrder S; S.init(NTOK, DM, sp ? 128 : G, sp ? (bid & 127) : bid);
            pg8::EpiRes E{ec, M_G2, sp ? (half ? 1 : 2) : 0};
            pg8::gemm_phase<pg8::EpiRes, pg8::StaticOrder, false, true>(lds, g, S, E);
        }
        SEAM_LOCAL();
        STAMP(3 + l * 8 + 6);
        {
            PH_BEGIN
            const float* px = ((G == 256) && SPLITK) ? (const float*)(ws + WS_PART) : nullptr;
            if (l == 0) { for (int mb = NR_M0; mb < NR_END; mb += NR_STEP) norm_rows4<false>(mb, NR_STRIDE, nullptr, nullptr, P_X, px, P_HB, a.in[10] + DM, P_MOD + (size_t)3 * 6144, M_SH1, M_SC1, lane); }
            else { for (int mb = NR_M0; mb < NR_END; mb += NR_STEP) norm_rows4<true>(mb, NR_STRIDE, nullptr, nullptr, P_X, px, nullptr, a.in[30], nullptr, 0, 0, lane); }
        }
        if (l == 0) xcd_barrier(bar);
        STAMP(3 + l * 8 + 7);
    }
#ifdef TPROBE
    if (bid == TP_BLK && threadIdx.x == 0) {
        volatile LAS unsigned long long* ts_ = (volatile LAS unsigned long long*)(lds + 146880);
        const unsigned long long T_ = ts_[TP_B] - ts_[TP_A], end_ = __builtin_amdgcn_s_memrealtime() + TP_MULT * T_;
        while (__builtin_amdgcn_s_memrealtime() < end_) __builtin_amdgcn_s_sleep(8);
    }
#endif
}

extern "C" void kernel_launch(void* const* d_in, const int* in_sizes, int n_in, void* d_out, int out_size, void* d_ws, size_t ws_size, hipStream_t stream) {
    static int grid_blocks = 0;
    if (grid_blocks == 0) {
        if (n_in != 31 || ws_size < WS_END) { fprintf(stderr, "kernel_launch: unexpected n_in %d / ws_size %zu\n", n_in, ws_size); grid_blocks = -1; return; }
        int dev = 0, cus = 0, per_cu = 0;
        hipGetDevice(&dev);
        hipDeviceGetAttribute(&cus, hipDeviceAttributeMultiprocessorCount, dev);
        if (hipFuncSetAttribute((const void*)fwd_kernel, hipFuncAttributeMaxDynamicSharedMemorySize, LDS_BYTES) != hipSuccess) { fprintf(stderr, "kernel_launch: hipFuncSetAttribute failed\n"); grid_blocks = -1; return; }
        if (hipOccupancyMaxActiveBlocksPerMultiprocessor(&per_cu, (const void*)fwd_kernel, 512, LDS_BYTES) != hipSuccess || per_cu < 1) { fprintf(stderr, "kernel_launch: occupancy query gave %d\n", per_cu); (void)hipGetLastError(); per_cu = 1; }
        grid_blocks = cus * 1;
    }
    if (grid_blocks < 0) return;
#if NOCG
    if (hipMemsetAsync((char*)d_ws + WS_BAR, 0, 6656 * 4, stream) != hipSuccess) { fprintf(stderr, "kernel_launch: hipMemsetAsync of the barrier words failed\n"); return; }
#endif
    KArgs a{};
    for (int i = 0; i < 31; ++i) a.in[i] = (const float*)d_in[i];
    a.out = (float*)d_out; a.ws = (unsigned char*)d_ws;
    void* args[] = {&a};
    hipError_t e = hipLaunchCooperativeKernel((const void*)fwd_kernel, dim3(grid_blocks), dim3(512), args, LDS_BYTES, stream);
    if (e != hipSuccess) fprintf(stderr, "cooperative launch failed: %s (grid %d)\n", hipGetErrorString(e), grid_blocks);
}
```

```cpp
#include <hip/hip_runtime.h>
#include <hip/hip_cooperative_groups.h>
#include <cstdio>
#include <cstdint>
namespace cg = cooperative_groups;

typedef float f32x4_t __attribute__((ext_vector_type(4)));
typedef float f32x2_t __attribute__((ext_vector_type(2)));
typedef float f32x16_t __attribute__((ext_vector_type(16)));
typedef unsigned u32x4_t __attribute__((ext_vector_type(4)));
typedef unsigned u32x2_t __attribute__((ext_vector_type(2)));
typedef short s16x8_t __attribute__((ext_vector_type(8)));
typedef __bf16 bf16x2_t __attribute__((ext_vector_type(2)));
typedef unsigned short bfraw;

__device__ __forceinline__ unsigned pk2(float lo, float hi) { f32x2_t v = {lo, hi}; bf16x2_t b = __builtin_convertvector(v, bf16x2_t); return __builtin_bit_cast(unsigned, b); }
__device__ __forceinline__ bfraw f2bf(float x) { return (bfraw)(pk2(x, 0.f) & 0xffffu); }
__device__ __forceinline__ float bf2f(bfraw x) { return __builtin_bit_cast(float, (unsigned)x << 16); }
__device__ __forceinline__ float sigmoidf_(float x) { return __builtin_amdgcn_rcpf(1.0f + __builtin_amdgcn_exp2f(-1.4426950408889634f * x)); }

constexpr int DM = 1024, NTOK = 8192, NCTX = 4096, CSEQ = 256, LSEQ = 2048, PAST = 256, INW = 6400, FF = 4096;
constexpr float NEPS = 1e-6f;
constexpr float QSCALE = 0.125f * 1.4426950408889634f;
constexpr size_t O_X = 0, O_NDK = 8388608, O_NDV = 12582912, O_NGK = 16777216, O_NGV = 17825792;
constexpr int M_SH1 = 0, M_SC1 = 1024, M_G1 = 2048, M_SH2 = 3072, M_SC2 = 4096, M_G2 = 5120;

struct EpiCtx { int l; float* out; unsigned char* ws; };
#define LAS __attribute__((address_space(3)))
constexpr size_t MiB = 1u << 20;
constexpr size_t WS_MOD = 0, WS_ROPEC = 160 * 1024, WS_ROPES = 164 * 1024, WS_BAR = 192 * 1024, WS_FLAG = WS_BAR + 16384, WS_FLAG2 = WS_BAR + 5632 * 4, WS_QKN = 176 * 1024, WS_LAM = 180 * 1024;
constexpr size_t WS_CDK = 1 * MiB, WS_CDVT = 2 * MiB, WS_CGK = 3 * MiB, WS_CGVT = 3 * MiB + 256 * 1024;
constexpr size_t WS_WIN = 4 * MiB, WIN_L = (size_t)INW * DM * 2;
constexpr size_t WS_WBR = 29 * MiB, WBR_L = 3 * MiB;
constexpr size_t WS_WO = 35 * MiB, WO_L = 2 * MiB;
constexpr size_t WS_W1 = 39 * MiB, W1_L = 8 * MiB;
constexpr size_t WS_W2 = 55 * MiB, W2_L = 8 * MiB;
constexpr size_t WS_HB = 72 * MiB;
constexpr size_t WS_ABR = 88 * MiB;
constexpr size_t WS_PROJ = 112 * MiB;
constexpr size_t P_DQ = 0, P_DK = 8 * MiB, P_DVTC = 16 * MiB, P_DVTL = 20 * MiB, P_GQ = 24 * MiB, P_GK = 32 * MiB, P_GVTC = 34 * MiB, P_GVTL = 35 * MiB, P_U = 36 * MiB, P_G = 44 * MiB;
constexpr size_t WS_PART = 204 * MiB;
constexpr size_t WS_END = 236 * MiB;
constexpr int LDS_BYTES = 147456;

__device__ __forceinline__ void st_bf4(bfraw* p, f32x4_t v) { u32x2_t w; w.x = pk2(v[0], v[1]); w.y = pk2(v[2], v[3]); *(u32x2_t*)p = w; }
__device__ __forceinline__ float dot4(f32x4_t v) { return (v[0] * v[0] + v[1] * v[1]) + (v[2] * v[2] + v[3] * v[3]); }
namespace pg8 {
#define PG8_LAS __attribute__((address_space(3)))
typedef unsigned short bf16_t;
typedef short bf16x8 __attribute__((ext_vector_type(8)));
typedef float f32x4 __attribute__((ext_vector_type(4)));
typedef unsigned u32x4 __attribute__((ext_vector_type(4)));
constexpr int BM = 256, BK = 64, HALF = 128, HTB = HALF * BK * 2  , STAGE_BYTES = 8 * HTB, NXCD = 8, WGM = 4;

__host__ __device__ __forceinline__ int lds_byte(int r, int c) { const int st = (r >> 4) * 2 + (c >> 5), rr = r & 15, cc = c & 31, ob = rr * 64 + cc * 2; return st * 1024 + (ob ^ (((ob >> 9) & 1) << 5)); }
__host__ __device__ __forceinline__ void stage_rc(int b, int& R, int& C) { const int st = b / 1024, sb = b % 1024, swz = sb ^ (((sb >> 9) & 1) << 5); R = (st >> 1) * 16 + swz / 64; C = (st & 1) * 32 + (swz % 64) / 2; }
__host__ __device__ __forceinline__ int perm32(int rho) { const int n = rho >> 4, i = rho & 15; return 8 * (i >> 2) + 4 * n + (i & 3); }

struct Unit { int pm, pn; };
struct Gemm { const bf16_t* A; const bf16_t* Bt; int M, N, K, Kloop, bjsel; };

struct StaticOrder {
    int nM, nN, nwg, G, c;
    __host__ __device__ void init(int M, int N, int G_, int c_) { nM = M / BM; nN = N / BM; nwg = nM * nN; G = G_; c = c_; }
    __host__ __device__ bool next(int i, Unit& u) const {
        const long L = (long)i * G + c; if (L >= nwg) return false;
        int wgid = (int)L; { const int q = nwg / NXCD, r = nwg % NXCD, xcd = wgid % NXCD, off = wgid / NXCD; wgid = (xcd < r ? xcd * (q + 1) : r * (q + 1) + (xcd - r) * q) + off; }
        const int nig = WGM * nN, gid = wgid / nig, fm = gid * WGM, gsz = (nM - fm) < WGM ? (nM - fm) : WGM;
        u.pm = fm + ((wgid % nig) % gsz); u.pn = (wgid % nig) / gsz; return true;
    }
    __device__ __forceinline__ void a_ready(const Unit&) const {}
    __device__ __forceinline__ void done(const Unit&) const {}
};

__device__ __forceinline__ unsigned cvt_pk_bf16(float lo, float hi) { unsigned r; asm volatile("v_cvt_pk_bf16_f32 %0, %1, %2" : "=v"(r) : "v"(lo), "v"(hi)); return r; }
typedef float f32x2 __attribute__((ext_vector_type(2)));
#define EC_DQ ((bfraw*)(c.ws + WS_PROJ + P_DQ))
#define EC_DK ((bfraw*)(c.ws + WS_PROJ + P_DK))
#define EC_DVtC ((bfraw*)(c.ws + WS_PROJ + P_DVTC))
#define EC_DVtL ((bfraw*)(c.ws + WS_PROJ + P_DVTL))
#define EC_GQ ((bfraw*)(c.ws + WS_PROJ + P_GQ))
#define EC_GK ((bfraw*)(c.ws + WS_PROJ + P_GK))
#define EC_GVtC ((bfraw*)(c.ws + WS_PROJ + P_GVTC))
#define EC_GVtL ((bfraw*)(c.ws + WS_PROJ + P_GVTL))
#define EC_U ((bfraw*)(c.ws + WS_PROJ + P_U))
#define EC_G ((bfraw*)(c.ws + WS_PROJ + P_G))
#define EC_TMP ((float*)(c.ws + WS_PROJ))
#define EC_HB ((bfraw*)(c.ws + WS_HB))
#define EC_HID ((bfraw*)(c.ws + WS_PROJ))
#define EC_mod ((const float*)(c.ws + WS_MOD))
#define EC_ropec ((const float*)(c.ws + WS_ROPEC))
#define EC_ropes ((const float*)(c.ws + WS_ROPES))

struct EpiIn {
    static constexpr bool PERM = false, AFTER_DRAIN = false;
    EpiCtx c; int q;
    __device__ __forceinline__ void operator()(const f32x4 (&acc)[2][2][4][2], const Unit& u, int wr, int wc, int fr_, int fq_) const {
        int fr = fr_, fq = fq_; asm volatile("" : "+v"(fr), "+v"(fq));
        const int pn = u.pn, pm = u.pm, l = c.l;
        const bool ctx = pm < 16;
        const int rbase = pm * 256 + wr * 64 + fr;
        const int lb = (pm - 16) >> 3;
        if (pn < 2) {
#pragma unroll
            for (int ai = 0; ai < 2; ++ai)
#pragma unroll
                for (int m = 0; m < 4; ++m) {
                    const int row = rbase + ai * 128 + m * 16; const int t = (row - NCTX) & (LSEQ - 1);
                    f32x4 cs = {1.f, 1.f, 1.f, 1.f}, sn = {0.f, 0.f, 0.f, 0.f};
                    if (!ctx) { const int pos = (wc & 1) ? (t & 63) : (t >> 6); cs = *(const f32x4*)(EC_ropec + pos * 16 + 4 * fq); sn = *(const f32x4*)(EC_ropes + pos * 16 + 4 * fq); }
#pragma unroll
                    for (int bj = 0; bj < 2; ++bj) {
                        const f32x4 x1 = acc[ai][bj][m][0], x2 = acc[ai][bj][m][1];
                        const f32x4 o1 = (x1 * cs - x2 * sn) * QSCALE, o2 = (x2 * cs + x1 * sn) * QSCALE;
                        bfraw* p = EC_DQ + (size_t)row * 512 + pn * 256 + bj * 128 + wc * 32 + 4 * fq;
                        st_bf4(p, o1); st_bf4(p + 16, o2);
                    }
                }
        } else if (pn < 4) {
#pragma unroll
            for (int ai = 0; ai < 2; ++ai)
#pragma unroll
                for (int m = 0; m < 4; ++m) {
                    const int row = rbase + ai * 128 + m * 16; const int t = (row - NCTX) & (LSEQ - 1);
                    f32x4 cs = {1.f, 1.f, 1.f, 1.f}, sn = {0.f, 0.f, 0.f, 0.f};
                    if (!ctx) { const int pos = (wc & 1) ? (t & 63) : (t >> 6); cs = *(const f32x4*)(EC_ropec + pos * 16 + 4 * fq); sn = *(const f32x4*)(EC_ropes + pos * 16 + 4 * fq); }
#pragma unroll
                    for (int bj = 0; bj < 2; ++bj) {
                        const f32x4 x1 = acc[ai][bj][m][0], x2 = acc[ai][bj][m][1];
                        const f32x4 o1 = x1 * cs - x2 * sn, o2 = x2 * cs + x1 * sn;
                        const int colb = (pn - 2) * 256 + bj * 128 + wc * 32 + 4 * fq;
                        if (ctx) { float* op = c.out + O_NDK + ((size_t)(pm * 2 + l) * 256 + (row & 255)) * 512 + colb; *(f32x4*)op = x1; *(f32x4*)(op + 16) = x2; }
                        bfraw* p = EC_DK + (size_t)row * 512 + colb;
                        st_bf4(p, o1); st_bf4(p + 16, o2);
                    }
                }
        } else if (pn < 6) {
#pragma unroll
            for (int ai = 0; ai < 2; ++ai)
#pragma unroll
                for (int m = 0; m < 4; ++m) {
                    const int row = rbase + ai * 128 + m * 16; const int t = (row - NCTX) & (LSEQ - 1); const int s = row & 255;
#pragma unroll
                    for (int bj = 0; bj < 2; ++bj)
#pragma unroll
                        for (int n = 0; n < 2; ++n) {
                            const f32x4 x = acc[ai][bj][m][n];
                            const int colb = (pn - 4) * 256 + bj * 128 + wc * 32 + 16 * n + 4 * fq;
                            if (ctx) { *(f32x4*)(c.out + O_NDV + ((size_t)(pm * 2 + l) * 256 + s) * 512 + colb) = x;
#pragma unroll
                                for (int j = 0; j < 4; ++j) EC_DVtC[((size_t)pm * 512 + colb + j) * 256 + s] = f2bf(x[j]); }
                            else {
#pragma unroll
                                for (int j = 0; j < 4; ++j) EC_DVtL[((size_t)lb * 512 + colb + j) * 2048 + t] = f2bf(x[j]);
#ifdef DUPV
                                asm volatile("" ::: "memory");
#pragma unroll
                                for (int j = 0; j < 4; ++j) EC_DVtL[((size_t)lb * 512 + colb + j) * 2048 + t] = f2bf(x[j]);
#endif
                            }
                        }
                }
        } else if (pn < 8 || (pn == 8 && wc < 2)) {
            const bool isq = pn < 8;
            const float* nw = (const float*)(c.ws + WS_QKN) + l * 128 + (isq ? 0 : 64);
            const int head = isq ? 4 * (pn - 6) + wc : wc;
            const float osc = isq ? QSCALE : 1.0f;
#pragma unroll
            for (int ai = 0; ai < 2; ++ai)
#pragma unroll
                for (int m = 0; m < 4; ++m) {
                    const int row = rbase + ai * 128 + m * 16; const int t = (row - NCTX) & (LSEQ - 1);
                    float ss = (dot4(acc[ai][0][m][0]) + dot4(acc[ai][0][m][1])) + (dot4(acc[ai][1][m][0]) + dot4(acc[ai][1][m][1]));
                    ss += __shfl_xor(ss, 16); ss += __shfl_xor(ss, 32);
                    const float r = __builtin_amdgcn_rsqf(ss * (1.0f / 64.0f) + NEPS);
#pragma unroll
                    for (int bj = 0; bj < 2; ++bj) {
                        const f32x4 wa = *(const f32x4*)(nw + 32 * bj + 4 * fq), wb = *(const f32x4*)(nw + 32 * bj + 16 + 4 * fq);
                        const f32x4 x1 = acc[ai][bj][m][0] * r * wa, x2 = acc[ai][bj][m][1] * r * wb;
                        f32x4 cs = {1.f, 1.f, 1.f, 1.f}, sn = {0.f, 0.f, 0.f, 0.f};
                        if (!ctx) { const int pos = bj ? (t & 63) : (t >> 6); cs = *(const f32x4*)(EC_ropec + pos * 16 + 4 * fq); sn = *(const f32x4*)(EC_ropes + pos * 16 + 4 * fq); }
                        const f32x4 o1 = (x1 * cs - x2 * sn) * osc, o2 = (x2 * cs + x1 * sn) * osc;
                        const int d0 = head * 64 + 32 * bj + 4 * fq;
                        if (isq) { bfraw* p = EC_GQ + (size_t)row * 512 + d0; st_bf4(p, o1); st_bf4(p + 16, o2); }
                        else {
                            if (ctx) { float* op = c.out + O_NGK + ((size_t)(pm * 2 + l) * 256 + (row & 255)) * 128 + d0; *(f32x4*)op = x1; *(f32x4*)(op + 16) = x2; }
                            bfraw* p = EC_GK + (size_t)row * 128 + d0; st_bf4(p, o1); st_bf4(p + 16, o2);
                        }
                    }
                    asm volatile("" ::: "memory");
                }
        } else if (pn == 8) {
            const int kvh = wc - 2;
#pragma unroll
            for (int ai = 0; ai < 2; ++ai)
#pragma unroll
                for (int m = 0; m < 4; ++m) {
                    const int row = rbase + ai * 128 + m * 16; const int t = (row - NCTX) & (LSEQ - 1); const int s = row & 255;
#pragma unroll
                    for (int bj = 0; bj < 2; ++bj)
#pragma unroll
                        for (int n = 0; n < 2; ++n) {
                            const f32x4 x = acc[ai][bj][m][n];
                            const int d0 = kvh * 64 + 32 * bj + 16 * n + 4 * fq;
                            if (ctx) { *(f32x4*)(c.out + O_NGV + ((size_t)(pm * 2 + l) * 256 + s) * 128 + d0) = x;
#pragma unroll
                                for (int j = 0; j < 4; ++j) EC_GVtC[((size_t)pm * 128 + d0 + j) * 256 + s] = f2bf(x[j]); }
                            else {
#pragma unroll
                                for (int j = 0; j < 4; ++j) EC_GVtL[((size_t)lb * 128 + d0 + j) * 2048 + t] = f2bf(x[j]); }
                        }
                }
        } else if (pn < 13) {
            const int q = pn - 9;
#pragma unroll
            for (int ai = 0; ai < 2; ++ai)
#pragma unroll
                for (int m = 0; m < 4; ++m) {
                    const int row = rbase + ai * 128 + m * 16;
#pragma unroll
                    for (int n = 0; n < 2; ++n) {
                        const f32x4 a = acc[ai][0][m][n], g = acc[ai][1][m][n];
                        f32x4 o; o[0] = a[0] * sigmoidf_(g[0]); o[1] = a[1] * sigmoidf_(g[1]); o[2] = a[2] * sigmoidf_(g[2]); o[3] = a[3] * sigmoidf_(g[3]);
                        st_bf4(EC_U + (size_t)row * 512 + q * 128 + wc * 32 + 16 * n + 4 * fq, o);
                    }
                }
        } else {
#pragma unroll
            for (int ai = 0; ai < 2; ++ai) {
#pragma unroll
                for (int m = 0; m < 4; ++m) {
                    const int row = rbase + ai * 128 + m * 16;
#pragma unroll
                    for (int bj = 0; bj < 2; ++bj) {
                        if (q >= 0 && bj != q) continue;
#pragma unroll
                        for (int n = 0; n < 2; ++n) {
                            const f32x4 g = acc[ai][bj][m][n];
                            f32x4 o; o[0] = sigmoidf_(g[0]); o[1] = sigmoidf_(g[1]); o[2] = sigmoidf_(g[2]); o[3] = sigmoidf_(g[3]);
                            st_bf4(EC_G + (size_t)row * 3072 + (pn - 13) * 256 + bj * 128 + wc * 32 + 16 * n + 4 * fq, o);
                        }
                    }
                }
            }
        }
    }
};

struct EpiBranch {
    static constexpr bool PERM = true, AFTER_DRAIN = false;
    EpiCtx c; int bjsel; int pair; unsigned epoch;
    __device__ __forceinline__ void operator()(const f32x4 (&acc)[2][2][4][2], const Unit& u, int wr, int wc, int fr_, int fq_) const {
        int fr = fr_, fq = fq_; asm volatile("" : "+v"(fr), "+v"(fq));
        const int br = u.pm >> 5, pm = u.pm & 31, pn = u.pn & 3;
        unsigned* const flag = (unsigned*)(c.ws + WS_FLAG2) + (pm * 4 + pn) * 8 + wr * 4 + wc;
        const bool last = pair ? (br == 1) : (br == 2);
        if (pair && br == 1) {
            unsigned spins = 0;
            while (__hip_atomic_load(flag, __ATOMIC_RELAXED, __HIP_MEMORY_SCOPE_AGENT) != epoch) { __builtin_amdgcn_s_sleep(1); if (++spins > (1u << 22)) break; }
            __builtin_amdgcn_fence(__ATOMIC_ACQUIRE, "agent");
        }
#pragma unroll
        for (int ai = 0; ai < 2; ++ai)
#pragma unroll
            for (int m = 0; m < 4; ++m) {
                const int row = pm * 256 + ai * 128 + wr * 64 + m * 16 + fr;
#pragma unroll
                for (int bj = 0; bj < 2; ++bj) {
                    if (bjsel >= 0 && bj != bjsel) continue;
                    const int col8 = pn * 256 + bj * 128 + wc * 32 + 8 * fq;
                    const u32x4 gw = *(const u32x4*)(EC_G + (size_t)row * 3072 + br * 1024 + col8);
                    f32x4 g0, g1;
                    g0[0] = __builtin_bit_cast(float, gw.x << 16); g0[1] = __builtin_bit_cast(float, gw.x & 0xffff0000u);
                    g0[2] = __builtin_bit_cast(float, gw.y << 16); g0[3] = __builtin_bit_cast(float, gw.y & 0xffff0000u);
                    g1[0] = __builtin_bit_cast(float, gw.z << 16); g1[1] = __builtin_bit_cast(float, gw.z & 0xffff0000u);
                    g1[2] = __builtin_bit_cast(float, gw.w << 16); g1[3] = __builtin_bit_cast(float, gw.w & 0xffff0000u);
                    f32x4 v0 = acc[ai][bj][m][0] * g0, v1 = acc[ai][bj][m][1] * g1;
                    bfraw* tp = (bfraw*)EC_TMP + (size_t)row * 1024 + col8;
                    float* t2 = (float*)(c.ws + WS_PART) + (size_t)row * 1024 + col8;
                    if (pair && br == 2) { *(f32x4*)t2 = v0; *(f32x4*)(t2 + 4) = v1; }
                    else {
                        if (br != 0) { const u32x4 tw = *(const u32x4*)tp;
                            v0[0] += __builtin_bit_cast(float, tw.x << 16); v0[1] += __builtin_bit_cast(float, tw.x & 0xffff0000u); v0[2] += __builtin_bit_cast(float, tw.y << 16); v0[3] += __builtin_bit_cast(float, tw.y & 0xffff0000u);
                            v1[0] += __builtin_bit_cast(float, tw.z << 16); v1[1] += __builtin_bit_cast(float, tw.z & 0xffff0000u); v1[2] += __builtin_bit_cast(float, tw.w << 16); v1[3] += __builtin_bit_cast(float, tw.w & 0xffff0000u); }
                        if (last && pair) { v0 += *(const f32x4*)t2; v1 += *(const f32x4*)(t2 + 4); }
                        u32x4 w; w.x = pk2(v0[0], v0[1]); w.y = pk2(v0[2], v0[3]); w.z = pk2(v1[0], v1[1]); w.w = pk2(v1[2], v1[3]);
                        if (last) *(u32x4*)(EC_HB + (size_t)row * 1024 + col8) = w; else *(u32x4*)tp = w;
                    }
                }
            }
        if (pair && br == 2) {
            asm volatile("s_waitcnt vmcnt(0)" ::: "memory");
            if (fr + 16 * fq == 0) __hip_atomic_store(flag, epoch, __ATOMIC_RELAXED, __HIP_MEMORY_SCOPE_AGENT);
        }
    }
};
struct QuarterOrder {
    int c;
    __device__ bool next(int i, Unit& u) const { if (i > 0 || c >= 64) return false; u.pm = 4 * (c & 7) + (c >> 4); u.pn = 24; return true; }
    __device__ __forceinline__ void a_ready(const Unit&) const {}
    __device__ __forceinline__ void done(const Unit&) const {}
};
struct BranchOrder {
    int c, role, pair;
    __device__ bool next(int i, Unit& u) const {
        if (c >= 128) return false;
        int br = i;
        if (pair) { if (role == 0) { if (i >= 2) return false; } else { if (i >= 1) return false; br = 2; } }
        else if (i >= 3) return false;
        const int x = c & 7, j = c >> 3; u.pm = br * 32 + 4 * x + (j >> 2); u.pn = br * 4 + (j & 3); return true;
    }
    __device__ __forceinline__ void a_ready(const Unit&) const {}
    __device__ __forceinline__ void done(const Unit&) const {}
};

struct EpiRes {
    static constexpr bool PERM = false, AFTER_DRAIN = true;
    EpiCtx c; int goff; int part;
    __device__ __forceinline__ void fused(f32x4 (&acc)[2][2][4][2], const Unit& u, int wr, int wc, int fr_, int fq_, PG8_LAS unsigned char* lds, int wid, int lane_) const {
        int fr = fr_, fq = fq_, lane = lane_; asm volatile("" : "+v"(fr), "+v"(fq), "+v"(lane));
        const int pm = u.pm, pn = u.pn;
        const int cond = pm < 16 ? 0 : 1 + ((pm - 16) >> 3);
        const float* gp = EC_mod + (size_t)(c.l * 3 + cond) * 6144 + goff + pn * 256;
        float* const dst = c.out + O_X + (size_t)(pm * 256) * 1024 + pn * 256 + 4 * lane;
        bfraw* const dstp = (bfraw*)(c.ws + WS_PART) + (part == 2 ? (size_t)NTOK * 1024 : 0) + (size_t)(pm * 256) * 1024 + pn * 256 + 4 * lane;
        PG8_LAS float* const lf = (PG8_LAS float*)lds;
#pragma unroll
        for (int ai = 0; ai < 2; ++ai) {
#pragma unroll
            for (int bj = 0; bj < 2; ++bj)
#pragma unroll
                for (int n = 0; n < 2; ++n) {
                    const int col = bj * 128 + wc * 32 + 16 * n + 4 * fq;
                    const f32x4 gv = *(const f32x4*)(gp + col);
#pragma unroll
                    for (int m = 0; m < 4; ++m) *(PG8_LAS f32x4*)(lf + (wr * 64 + m * 16 + fr) * 260 + col) = gv * acc[ai][bj][m][n];
                }
            asm volatile("s_waitcnt lgkmcnt(0)" ::: "memory"); __builtin_amdgcn_s_barrier(); asm volatile("" ::: "memory");
#pragma unroll 4
            for (int r = 0; r < 16; ++r) {
                const int rl = wid * 16 + r;
                const f32x4 v = *(const PG8_LAS f32x4*)(lf + rl * 260 + 4 * lane);
                float* xp = dst + (size_t)(ai * 128 + rl) * 1024;
                if (part) st_bf4(dstp + (size_t)(ai * 128 + rl) * 1024, v); else *(f32x4*)xp = *(const f32x4*)xp + v;
            }
            asm volatile("s_waitcnt lgkmcnt(0)" ::: "memory"); __builtin_amdgcn_s_barrier(); asm volatile("" ::: "memory");
        }
    }
};

struct EpiRelu2 {
    static constexpr bool PERM = true, AFTER_DRAIN = false;
    EpiCtx c;
    __device__ __forceinline__ void operator()(const f32x4 (&acc)[2][2][4][2], const Unit& u, int wr, int wc, int fr_, int fq_) const {
        int fr = fr_, fq = fq_; asm volatile("" : "+v"(fr), "+v"(fq));
#pragma unroll
        for (int ai = 0; ai < 2; ++ai)
#pragma unroll
            for (int m = 0; m < 4; ++m) {
                const int row = u.pm * 256 + ai * 128 + wr * 64 + m * 16 + fr;
#pragma unroll
                for (int bj = 0; bj < 2; ++bj) {
                    f32x4 v0 = acc[ai][bj][m][0], v1 = acc[ai][bj][m][1];
#pragma unroll
                    for (int j = 0; j < 4; ++j) { v0[j] = __builtin_fmaxf(v0[j], 0.f); v1[j] = __builtin_fmaxf(v1[j], 0.f); }
                    v0 = v0 * v0; v1 = v1 * v1;
                    u32x4 w; w.x = pk2(v0[0], v0[1]); w.y = pk2(v0[2], v0[3]); w.z = pk2(v1[0], v1[1]); w.w = pk2(v1[2], v1[3]);
                    *(u32x4*)(EC_HID + (size_t)row * 4096 + u.pn * 256 + bj * 128 + wc * 32 + 8 * fq) = w;
                }
            }
    }
};
template <class Epi, class Sched, bool ALIGN_EPI = false, bool SP2 = false>
__device__ __forceinline__ void gemm_phase(PG8_LAS unsigned char* lds, const Gemm g, const Sched& S, const Epi& E) {
    int tid_ = threadIdx.x; asm volatile("" : "+v"(tid_));
    const int tid = tid_, wid = __builtin_amdgcn_readfirstlane(tid >> 6), lane = tid & 63, wr = wid >> 2, wc = wid & 3, fr = lane & 15, fq = lane >> 4;
    const int K = g.K, nt = g.Kloop / BK, bjs = g.bjsel;
    unsigned voffA[2], voffB[2];
#pragma unroll
    for (int i = 0; i < 2; ++i) { int R, C; stage_rc(tid * 16 + i * 8192, R, C); const int Rb = Epi::PERM ? ((R & ~31) + perm32(R & 31)) : R;
        voffA[i] = (unsigned)(R * K + C) * 2u; voffB[i] = (unsigned)(Rb * K + C) * 2u; }
    const size_t kstep = (size_t)(BK * 2);
    const size_t hstep = (size_t)HALF * K * 2;
    const size_t tstep = 2 * hstep;
    const unsigned ldsw = (unsigned)wid * 1024u;
    const int aoff = lds_byte(wr * 64 + fr, fq * 8), boff = lds_byte(wc * 32 + fr, fq * 8);
#define PG8_SA(b, h) (((b) * 2 + (h)) * HTB)
#define PG8_SB(b, h) ((4 + (b) * 2 + (h)) * HTB)
#define PG8_STAGE(bufoff, gbase, voff) do { _Pragma("unroll") for (int _i = 0; _i < 2; ++_i) \
        __builtin_amdgcn_global_load_lds((const unsigned*)((const char*)(gbase) + (voff)[_i]), (PG8_LAS unsigned*)(lds + (bufoff) + ldsw + _i * 8192), 16, 0, 0); } while (0)
#define PG8_LDA(dst, b, h) do { _Pragma("unroll") for (int m = 0; m < 4; ++m) _Pragma("unroll") for (int k = 0; k < 2; ++k) dst[m][k] = *(const PG8_LAS bf16x8*)(lds + PG8_SA(b, h) + aoff + m * 2048 + k * 1024); } while (0)
#define PG8_LDB(dst, b, h) do { _Pragma("unroll") for (int n = 0; n < 2; ++n) _Pragma("unroll") for (int k = 0; k < 2; ++k) dst[n][k] = *(const PG8_LAS bf16x8*)(lds + PG8_SB(b, h) + boff + n * 2048 + k * 1024); } while (0)
#define PG8_MMA(ai, bj, At, Bt) do { __builtin_amdgcn_s_setprio(1); _Pragma("unroll") for (int m = 0; m < 4; ++m) _Pragma("unroll") for (int n = 0; n < 2; ++n) _Pragma("unroll") for (int k = 0; k < 2; ++k) \
        acc[ai][bj][m][n] = __builtin_amdgcn_mfma_f32_16x16x32_bf16(Bt[n][k], At[m][k], acc[ai][bj][m][n], 0, 0, 0); __builtin_amdgcn_s_setprio(0); } while (0)
#define PG8_WAIT_V(n) asm volatile("s_waitcnt vmcnt(" #n ")" ::: "memory")
#define PG8_WAIT_L(n) asm volatile("s_waitcnt lgkmcnt(" #n ")" ::: "memory")
#define PG8_BAR __builtin_amdgcn_s_barrier()
#define PG8_SCHED __builtin_amdgcn_sched_barrier(0)
    Unit cur, nxt; int ui = 0;
    if (!S.next(0, cur)) return;
    f32x4 acc[2][2][4][2];
#pragma unroll
    for (int a = 0; a < 2; ++a)
#pragma unroll
        for (int b = 0; b < 2; ++b)
#pragma unroll
            for (int m = 0; m < 4; ++m)
#pragma unroll
                for (int n = 0; n < 2; ++n) acc[a][b][m][n] = (f32x4){0.f, 0.f, 0.f, 0.f};
    bf16x8 At[4][2], B0[2][2], B1[2][2];
    const char* cA = (const char*)g.A + (size_t)cur.pm * tstep; const char* cB = (const char*)g.Bt + (size_t)cur.pn * tstep;
    S.a_ready(cur);
    if constexpr (SP2) {
        PG8_STAGE(PG8_SB(0, 0), cB, voffB); PG8_STAGE(PG8_SB(0, 1), cB + hstep, voffB); PG8_STAGE(PG8_SA(0, 0), cA, voffA); PG8_STAGE(PG8_SA(0, 1), cA + hstep, voffA);
        if (wr == 1) PG8_BAR;
        PG8_WAIT_V(2); PG8_BAR;
        PG8_STAGE(PG8_SB(1, 0), cB + kstep, voffB); PG8_STAGE(PG8_SA(1, 0), cA + kstep, voffA); PG8_STAGE(PG8_SB(1, 1), cB + hstep + kstep, voffB);
        PG8_WAIT_V(6); PG8_BAR;
    } else {
        PG8_STAGE(PG8_SB(0, 0), cB, voffB); PG8_STAGE(PG8_SA(0, 0), cA, voffA); PG8_STAGE(PG8_SB(0, 1), cB + hstep, voffB); PG8_STAGE(PG8_SA(0, 1), cA + hstep, voffA);
        if (wr == 1) PG8_BAR;
        PG8_WAIT_V(4); PG8_BAR;
        PG8_STAGE(PG8_SB(1, 0), cB + kstep, voffB); PG8_STAGE(PG8_SA(1, 0), cA + kstep, voffA); PG8_STAGE(PG8_SB(1, 1), cB + hstep + kstep, voffB);
        PG8_WAIT_V(6); PG8_BAR;
    }
    for (;;) {
        const bool has_next = S.next(ui + 1, nxt);
        const char* nA = has_next ? (const char*)g.A + (size_t)nxt.pm * tstep : cA; const char* nB = has_next ? (const char*)g.Bt + (size_t)nxt.pn * tstep : cB;
        for (int t = 0; t < nt; t += 2) {
            const bool last = (t == nt - 2);
            const char* a1 = cA + (size_t)(t + 1) * kstep;
            const char* a2 = last ? nA : cA + (size_t)(t + 2) * kstep; const char* b2 = last ? nB : cB + (size_t)(t + 2) * kstep;
            const char* a3 = a2 + kstep; const char* b3 = b2 + kstep;
            if (last && has_next) S.a_ready(nxt);
            if constexpr (SP2) {
            PG8_LDB(B0, 0, 0); PG8_LDB(B1, 0, 1); PG8_SCHED; PG8_LDA(At, 0, 0); PG8_STAGE(PG8_SA(1, 1), a1 + hstep, voffA);
            PG8_WAIT_V(8); PG8_WAIT_L(0); PG8_BAR; if (bjs != 1) PG8_MMA(0, 0, At, B0); if (bjs != 0) PG8_MMA(0, 1, At, B1); PG8_BAR; PG8_SCHED;
            PG8_LDA(At, 0, 1); PG8_STAGE(PG8_SB(0, 0), b2, voffB); PG8_STAGE(PG8_SB(0, 1), b2 + hstep, voffB); PG8_STAGE(PG8_SA(0, 0), a2, voffA);
            PG8_WAIT_V(8); PG8_WAIT_L(0); PG8_BAR; if (bjs != 1) PG8_MMA(1, 0, At, B0); if (bjs != 0) PG8_MMA(1, 1, At, B1); PG8_BAR; PG8_SCHED;
            PG8_LDB(B0, 1, 0); PG8_LDB(B1, 1, 1); PG8_SCHED; PG8_LDA(At, 1, 0); PG8_STAGE(PG8_SA(0, 1), a2 + hstep, voffA);
            PG8_WAIT_V(8); PG8_WAIT_L(0); PG8_BAR; if (bjs != 1) PG8_MMA(0, 0, At, B0); if (bjs != 0) PG8_MMA(0, 1, At, B1); PG8_BAR; PG8_SCHED;
            PG8_LDA(At, 1, 1); PG8_STAGE(PG8_SB(1, 0), b3, voffB); PG8_STAGE(PG8_SB(1, 1), b3 + hstep, voffB); PG8_STAGE(PG8_SA(1, 0), a3, voffA);
            PG8_WAIT_V(8); PG8_WAIT_L(0); PG8_BAR; if (bjs != 1) PG8_MMA(1, 0, At, B0); if (bjs != 0) PG8_MMA(1, 1, At, B1); PG8_BAR; PG8_SCHED;
            } else {
            PG8_LDB(B0, 0, 0); PG8_SCHED; PG8_LDA(At, 0, 0); PG8_STAGE(PG8_SA(1, 1), a1 + hstep, voffA);
            PG8_WAIT_L(8); PG8_BAR; PG8_WAIT_L(0); PG8_MMA(0, 0, At, B0); PG8_BAR; PG8_SCHED;
            PG8_LDB(B1, 0, 1); PG8_STAGE(PG8_SB(0, 0), b2, voffB);
            PG8_BAR; PG8_WAIT_L(0); PG8_MMA(0, 1, At, B1); PG8_BAR;
            PG8_LDA(At, 0, 1); PG8_STAGE(PG8_SA(0, 0), a2, voffA);
            PG8_BAR; PG8_WAIT_L(0); PG8_MMA(1, 0, At, B0); PG8_BAR; PG8_SCHED;
            PG8_STAGE(PG8_SB(0, 1), b2 + hstep, voffB);
            PG8_WAIT_V(6); PG8_BAR; PG8_MMA(1, 1, At, B1); PG8_BAR;
            PG8_LDB(B0, 1, 0); PG8_SCHED; PG8_LDA(At, 1, 0); PG8_STAGE(PG8_SA(0, 1), a2 + hstep, voffA);
            PG8_WAIT_L(8); PG8_BAR; PG8_WAIT_L(0); PG8_MMA(0, 0, At, B0); PG8_BAR; PG8_SCHED;
            PG8_LDB(B1, 1, 1); PG8_STAGE(PG8_SB(1, 0), b3, voffB);
            PG8_BAR; PG8_WAIT_L(0); PG8_MMA(0, 1, At, B1); PG8_BAR;
            PG8_LDA(At, 1, 1); PG8_STAGE(PG8_SA(1, 0), a3, voffA);
            PG8_BAR; PG8_WAIT_L(0); PG8_MMA(1, 0, At, B0); PG8_BAR; PG8_SCHED;
            PG8_STAGE(PG8_SB(1, 1), b3 + hstep, voffB);
            PG8_WAIT_V(6); PG8_BAR; PG8_MMA(1, 1, At, B1); PG8_BAR;
            }
        }
        if constexpr (ALIGN_EPI) { if (wr == 0) PG8_BAR; }
        if constexpr (!Epi::AFTER_DRAIN) { E(acc, cur, wr, wc, fr, fq); S.done(cur); }
        if (!has_next) break;
#pragma unroll
        for (int a = 0; a < 2; ++a)
#pragma unroll
            for (int b = 0; b < 2; ++b)
#pragma unroll
                for (int m = 0; m < 4; ++m)
#pragma unroll
                    for (int n = 0; n < 2; ++n) acc[a][b][m][n] = (f32x4){0.f, 0.f, 0.f, 0.f};
        cur = nxt; cA = nA; cB = nB; ++ui;
        if constexpr (ALIGN_EPI) { if (wr == 1) PG8_BAR; }
    }
    PG8_WAIT_V(0);
    if constexpr (!ALIGN_EPI) { if (wr == 0) PG8_BAR; }
    PG8_BAR;
    if constexpr (Epi::AFTER_DRAIN) { E.fused(acc, cur, wr, wc, fr, fq, lds, wid, lane); S.done(cur); }
#undef PG8_SA
#undef PG8_SB
#undef PG8_STAGE
#undef PG8_LDA
#undef PG8_LDB
#undef PG8_MMA
#undef PG8_WAIT_V
#undef PG8_WAIT_L
#undef PG8_BAR
#undef PG8_SCHED
}
}
#ifndef REP_P0
#define REP_P0 1
#endif
#ifndef REP_PA
#define REP_PA 1
#endif
#ifndef REP_ATT
#define REP_ATT 1
#endif
#ifndef REP_CONV
#define REP_CONV 1
#endif
#ifndef REP_C1
#define REP_C1 1
#endif
#ifndef REP_C2
#define REP_C2 1
#endif
#ifndef REP_M1
#define REP_M1 1
#endif
#ifndef REP_M2
#define REP_M2 1
#endif
#ifndef REP_SYNC
#define REP_SYNC 0
#endif

struct KArgs { const float* in[31]; float* out; unsigned char* ws; };
#define XB_TMO      128
#define XB_XCNT(j)  (256  + 64 * (j))
#define XB_XSUB(j)  (1280 + 64 * (j))
#define XB_XGEN(j)  (2304 + 64 * (j))
#define XB_TOP      3328
#define XB_TOPGEN   3392
#define XCD_BAR_WORDS 3456
#define XB_SPIN_CAP (1u << 18)

__device__ __forceinline__ unsigned xb_ld(unsigned* p)              { return __hip_atomic_load(p, __ATOMIC_RELAXED, __HIP_MEMORY_SCOPE_AGENT); }
__device__ __forceinline__ unsigned xb_add(unsigned* p, unsigned v) { return __hip_atomic_fetch_add(p, v, __ATOMIC_RELAXED, __HIP_MEMORY_SCOPE_AGENT); }
__device__ __forceinline__ unsigned xb_xcc_id() { return (unsigned)__builtin_amdgcn_s_getreg((3 << 11) | 20) & 0xFu; }
#define XB_SPIN(cond, bar) do { unsigned _sp = 0; while (cond) { __builtin_amdgcn_s_sleep(1); \
    if ((++_sp & 255u) == 0u) { if (xb_ld(&(bar)[XB_TMO])) break; if (_sp > XB_SPIN_CAP) { atomicAdd(&(bar)[XB_TMO], 1u); break; } } } } while (0)

struct XcdBarrier {
    unsigned* bar; unsigned x;
    volatile LAS unsigned* st;
};

__device__ __forceinline__ XcdBarrier xcd_barrier_post(unsigned* bar, volatile LAS unsigned* st) {
    XcdBarrier b; b.bar = bar; b.x = xb_xcc_id(); b.st = st;
    if (threadIdx.x == 0) st[2] = xb_add(&bar[XB_XCNT(b.x)], 1u);
    return b;
}
__device__ __forceinline__ void xcd_barrier_complete(unsigned* bar, unsigned x, unsigned& nloc, unsigned& nx) {
    const unsigned G = gridDim.x * gridDim.y * gridDim.z;
    unsigned sum, cnt, mine, sp = 0u;
    for (;;) {
        sum = 0u; cnt = 0u; mine = 0u;
#pragma unroll
        for (unsigned j = 0; j < 16; ++j) { const unsigned c = xb_ld(&bar[XB_XCNT(j)]); sum += c; cnt += (c > 0u) ? 1u : 0u; mine = (j == x) ? c : mine; }
        if (sum == G) break;
        __builtin_amdgcn_s_sleep(1);
        if ((++sp & 255u) == 0u) { if (xb_ld(&bar[XB_TMO])) break; if (sp > XB_SPIN_CAP) { atomicAdd(&bar[XB_TMO], 1u); break; } }
    }
    nloc = mine > 0u ? mine : 1u; nx = cnt > 0u ? cnt : 1u;
}

__device__ __forceinline__ void xcd_barrier(const XcdBarrier& b) {
    asm volatile("s_waitcnt vmcnt(0)" ::: "memory");
    __syncthreads();
    if (threadIdx.x == 0) {
        unsigned* bar = b.bar;
        __builtin_amdgcn_s_waitcnt(0);
        unsigned nloc = b.st[0], nx = b.st[1];
        if (nloc == 0u) { xcd_barrier_complete(bar, b.x, nloc, nx); b.st[0] = nloc; b.st[1] = nx;
            unsigned uni = (nx == 8u && gridDim.x == 256u) ? 1u : 0u;
#pragma unroll
            for (unsigned j = 0; j < 16; ++j) { const unsigned cj = xb_ld(&bar[XB_XCNT(j)]); if (cj != (j < 8u ? 32u : 0u)) uni = 0u; }
            b.st[3] = uni; }
        const unsigned old = xb_add(&bar[XB_XSUB(b.x)], 1u);
        const unsigned gen = old / nloc;
        if (old + 1u == (gen + 1u) * nloc) {
            __builtin_amdgcn_fence(__ATOMIC_RELEASE, "agent");
            asm volatile("s_waitcnt vmcnt(0)" ::: "memory");
            const unsigned og = xb_add(&bar[XB_TOP], 1u);
            const unsigned tg = og / nx;
            if (og + 1u == (tg + 1u) * nx) xb_add(&bar[XB_TOPGEN], 1u);
            else XB_SPIN(xb_ld(&bar[XB_TOPGEN]) == tg, bar);
            __builtin_amdgcn_fence(__ATOMIC_ACQUIRE, "agent");
            xb_add(&bar[XB_XGEN(b.x)], 1u);
            asm volatile("s_waitcnt vmcnt(0)" ::: "memory");
        } else {
            XB_SPIN(xb_ld(&bar[XB_XGEN(b.x)]) == gen, bar);
            __builtin_amdgcn_fence(__ATOMIC_ACQUIRE, "agent");
            asm volatile("s_waitcnt vmcnt(0)" ::: "memory");
        }
    }
    __syncthreads();
}


__device__ __forceinline__ float wave_sum(float v) {
#pragma unroll
    for (int o = 1; o < 64; o <<= 1) v += __shfl_xor(v, o);
    return v;
}

#define XB_LSUB(j)  (3456 + 64 * (j))
#define XB_LGEN(j)  (4480 + 64 * (j))
__device__ __forceinline__ void xcc_local_barrier(const XcdBarrier& b) {
    asm volatile("s_waitcnt vmcnt(0)" ::: "memory");
    __syncthreads();
    if (threadIdx.x == 0) {
        unsigned* bar = b.bar;
        const unsigned old = xb_add(&bar[XB_LSUB(b.x)], 1u), gen = old / 32u;
        if (old + 1u == (gen + 1u) * 32u) xb_add(&bar[XB_LGEN(b.x)], 1u);
        else XB_SPIN(xb_ld(&bar[XB_LGEN(b.x)]) == gen, bar);
        __builtin_amdgcn_fence(__ATOMIC_ACQUIRE, "agent");
        asm volatile("s_waitcnt vmcnt(0)" ::: "memory");
    }
    __syncthreads();
}

__device__ __forceinline__ void transpose_item(const float* W, int K, int N, bfraw* WT, int vrow0, int n0, int k0, LAS float* scr, int lane) {
#pragma unroll 8
    for (int i = 0; i < 32; ++i) { const int kk = 2 * i + (lane >> 5); scr[kk * 33 + (lane & 31)] = W[(size_t)(k0 + kk) * N + n0 + (lane & 31)]; }
    asm volatile("s_waitcnt lgkmcnt(0)" ::: "memory");
    const int cch = lane & 7;
#pragma unroll
    for (int j = 0; j < 4; ++j) { const int n = (lane >> 3) + 8 * j; const LAS float* s = scr + (8 * cch) * 33 + n;
        u32x4_t o; o.x = pk2(s[0 * 33], s[1 * 33]); o.y = pk2(s[2 * 33], s[3 * 33]); o.z = pk2(s[4 * 33], s[5 * 33]); o.w = pk2(s[6 * 33], s[7 * 33]);
        *(u32x4_t*)(WT + (size_t)(vrow0 + n) * K + k0 + 8 * cch) = o; }
    asm volatile("s_waitcnt lgkmcnt(0)" ::: "memory");
}
__device__ __forceinline__ int vcol_map(int vb) {
    const int tile = vb >> 3, sub = vb & 7, bj = sub >> 2, wc = sub & 3;
    if (tile < 6 || tile >= 13) return vb * 32;
    if (tile < 8) return 1536 + (4 * (tile - 6) + wc) * 64 + 32 * bj;
    if (tile == 8) return 2048 + wc * 64 + 32 * bj;
    return (bj ? 2816 : 2304) + 128 * (tile - 9) + 32 * wc;
}
__device__ __forceinline__ void sincos_small(float x, float& s, float& c) {
    const float k = __builtin_rintf(x * 0.15915494309189535f);
    float r = __builtin_fmaf(-k, 6.2831854820251465f, x); r = __builtin_fmaf(-k, -1.7484555e-07f, r);
    const float y = r * 0.25f, y2 = y * y;
    float sp = __builtin_fmaf(y2, 2.7557319e-06f, -1.9841270e-04f); sp = __builtin_fmaf(sp, y2, 8.3333333e-03f); sp = __builtin_fmaf(sp, y2, -1.6666667e-01f); sp = __builtin_fmaf(sp * y2, y, y);
    float cp = __builtin_fmaf(y2, -2.7557319e-07f, 2.4801587e-05f); cp = __builtin_fmaf(cp, y2, -1.3888889e-03f); cp = __builtin_fmaf(cp, y2, 4.1666667e-02f); cp = __builtin_fmaf(cp, y2, -0.5f); cp = __builtin_fmaf(cp, y2, 1.0f);
    const float s2 = 2.f * sp * cp, c2 = cp * cp - sp * sp;
    s = 2.f * s2 * c2; c = c2 * c2 - s2 * s2;
}
__device__ __forceinline__ void modnorm_row(const float* xrow, const float* addrow, float* xcopy, bfraw* orow, const float* nw, const float* shift, const float* scale, int lane) {
    const f32x4_t* xr = (const f32x4_t*)xrow + lane;
    f32x4_t v[4]; float s = 0.f;
#pragma unroll
    for (int j = 0; j < 4; ++j) { v[j] = xr[64 * j]; if (addrow) v[j] += ((const f32x4_t*)addrow + lane)[64 * j]; s += dot4(v[j]); }
    const float r = __builtin_amdgcn_rsqf(wave_sum(s) * (1.0f / DM) + NEPS);
#pragma unroll
    for (int j = 0; j < 4; ++j) {
        const int cidx = 4 * lane + 256 * j;
        if (xcopy) *((f32x4_t*)xcopy + lane + 64 * j) = v[j];
        const f32x4_t w = *(const f32x4_t*)(nw + cidx), sh = *(const f32x4_t*)(shift + cidx), sc = *(const f32x4_t*)(scale + cidx);
        const f32x4_t h = v[j] * r * w * (1.0f + sc) + sh;
        st_bf4(orow + cidx, h);
    }
}
__device__ __forceinline__ void finalnorm_row(float* xrow, const float* addrow, const float* nw, int lane) {
    f32x4_t* xr = (f32x4_t*)xrow + lane;
    f32x4_t v[4]; float s = 0.f;
#pragma unroll
    for (int j = 0; j < 4; ++j) { v[j] = xr[64 * j]; if (addrow) v[j] += ((const f32x4_t*)addrow + lane)[64 * j]; s += dot4(v[j]); }
    const float r = __builtin_amdgcn_rsqf(wave_sum(s) * (1.0f / DM) + NEPS);
#pragma unroll
    for (int j = 0; j < 4; ++j) { const f32x4_t w = *(const f32x4_t*)(nw + 4 * lane + 256 * j); xr[64 * j] = v[j] * r * w; }
}

template <bool FINAL>
__device__ __forceinline__ void norm_rows4(int m0, int stride, const float* in_ctx, const float* in_lat, float* X, const float* PARTX, bfraw* HB,
                                           const float* nw, const float* modl, int sh_off, int sc_off, int lane) {
    f32x4_t v[4][4];
#pragma unroll
    for (int r = 0; r < 4; ++r) {
        const int m = m0 + r * stride; if (m >= NTOK) break;
        const float* src = in_ctx ? (m < NCTX ? in_ctx + (size_t)m * DM : in_lat + (size_t)(m - NCTX) * DM) : X + (size_t)m * DM;
#pragma unroll
        for (int j = 0; j < 4; ++j) v[r][j] = ((const f32x4_t*)src + lane)[64 * j];
    }
    if (PARTX) {
        u32x2_t pv[4][4], pw[4][4];
#pragma unroll
        for (int r = 0; r < 4; ++r) { const int m = m0 + r * stride; if (m >= NTOK) break;
#pragma unroll
            for (int j = 0; j < 4; ++j) { pv[r][j] = ((const u32x2_t*)((const bfraw*)PARTX + (size_t)m * DM) + lane)[64 * j]; pw[r][j] = ((const u32x2_t*)((const bfraw*)PARTX + (size_t)(NTOK + m) * DM) + lane)[64 * j]; } }
#pragma unroll
        for (int r = 0; r < 4; ++r) { const int m = m0 + r * stride; if (m >= NTOK) break;
#pragma unroll
            for (int j = 0; j < 4; ++j) { const u32x2_t q = pv[r][j], q2 = pw[r][j];
                v[r][j][0] += __builtin_bit_cast(float, q.x << 16) + __builtin_bit_cast(float, q2.x << 16); v[r][j][1] += __builtin_bit_cast(float, q.x & 0xffff0000u) + __builtin_bit_cast(float, q2.x & 0xffff0000u);
                v[r][j][2] += __builtin_bit_cast(float, q.y << 16) + __builtin_bit_cast(float, q2.y << 16); v[r][j][3] += __builtin_bit_cast(float, q.y & 0xffff0000u) + __builtin_bit_cast(float, q2.y & 0xffff0000u); } }
    }
#pragma unroll
    for (int r = 0; r < 4; ++r) {
        const int m = m0 + r * stride; if (m >= NTOK) break;
        float s = 0.f;
#pragma unroll
        for (int j = 0; j < 4; ++j) s += dot4(v[r][j]);
        const float rr = __builtin_amdgcn_rsqf(wave_sum(s) * (1.0f / DM) + NEPS);
        const int cond = m < NCTX ? 0 : 1 + ((m - NCTX) >> 11);
        const float* md = modl + (size_t)cond * 6144;
#pragma unroll
        for (int j = 0; j < 4; ++j) {
            const int cidx = 4 * lane + 256 * j;
            const f32x4_t w = *(const f32x4_t*)(nw + cidx);
            if (FINAL) { ((f32x4_t*)(X + (size_t)m * DM) + lane)[64 * j] = v[r][j] * rr * w; }
            else {
                if (in_ctx || PARTX) ((f32x4_t*)(X + (size_t)m * DM) + lane)[64 * j] = v[r][j];
                const f32x4_t sh = *(const f32x4_t*)(md + sh_off + cidx), sc = *(const f32x4_t*)(md + sc_off + cidx);
                st_bf4(HB + (size_t)m * DM + cidx, v[r][j] * rr * w * (1.0f + sc) + sh);
            }
        }
    }
}

struct AttnArgs {
    const bfraw* Q; int qcol0, qcol1;
    const bfraw* Kown; const bfraw* Kc; int kstride;
    int nOwn, nTot;
    const bfraw* Vown; int vsOwn; const bfraw* Vc; int vsC;
    bfraw* O; int ocol0, ocol1;
    float lam, postscale; const float* subln;
};
constexpr int ATT_VOFF = 17408, ATT_BUF = 36864, ATT_XOFF = 0;
template <int KROWB, bool QLDS>
__device__ __forceinline__ void att_s(const LAS unsigned char* cur, int koff, const s16x8_t (&qf)[4], const LAS s16x8_t* qlds, const f32x16_t& negm, f32x16_t& p0, f32x16_t& p1) {
#pragma unroll
    for (int d0 = 0; d0 < 4; ++d0) {
        const s16x8_t k0 = *(const LAS s16x8_t*)(cur + koff + d0 * 32);
        const s16x8_t k1 = *(const LAS s16x8_t*)(cur + koff + 32 * KROWB + d0 * 32);
        const s16x8_t q = QLDS ? qlds[d0 * 512] : qf[d0];
        if (d0 == 0) { p0 = __builtin_amdgcn_mfma_f32_32x32x16_bf16(k0, q, negm, 0, 0, 0); p1 = __builtin_amdgcn_mfma_f32_32x32x16_bf16(k1, q, negm, 0, 0, 0); }
        else { p0 = __builtin_amdgcn_mfma_f32_32x32x16_bf16(k0, q, p0, 0, 0, 0); p1 = __builtin_amdgcn_mfma_f32_32x32x16_bf16(k1, q, p1, 0, 0, 0); }
    }
}
__device__ __forceinline__ float vmax3(float a, float b, float c) { float r; asm("v_max3_f32 %0, %1, %2, %3" : "=v"(r) : "v"(a), "v"(b), "v"(c)); return r; }
template <bool FIRST>
__device__ __forceinline__ float att_softmax(f32x16_t& p0, f32x16_t& p1, float& m_run, float& l_run, f32x16_t& negm, u32x4_t (&pf)[4]) {
    asm volatile("s_nop 15\n\ts_nop 7" : "+v"(p0), "+v"(p1));
    float mx = vmax3(p0[0], p0[1], p1[0]);
    mx = vmax3(mx, p1[1], p0[2]);
#pragma unroll
    for (int r = 2; r < 16; r += 2) { if (r > 2) mx = vmax3(mx, p0[r], p1[r]); else mx = vmax3(mx, p1[2], p1[2]); mx = vmax3(mx, p0[r + 1], p1[r + 1]); }
    mx = __builtin_fmaxf(mx, __shfl_xor(mx, 32));
    float alpha = 1.0f;
    if (FIRST || __any(mx > 0.f)) {
        const float dl = FIRST ? mx : __builtin_fmaxf(mx, 0.f);
        m_run += dl; alpha = __builtin_amdgcn_exp2f(-dl);
#pragma unroll
        for (int r = 0; r < 16; ++r) { p0[r] -= dl; p1[r] -= dl; negm[r] = -m_run; }
    }
    float rs = 0.f;
#pragma unroll
    for (int r = 0; r < 16; ++r) { p0[r] = __builtin_amdgcn_exp2f(p0[r]); p1[r] = __builtin_amdgcn_exp2f(p1[r]); rs += p0[r] + p1[r]; }
    l_run = FIRST ? rs : l_run * alpha + rs;
#pragma unroll
    for (int s2 = 0; s2 < 2; ++s2) {
        pf[s2].x = pk2(p0[8 * s2 + 0], p0[8 * s2 + 1]); pf[s2].y = pk2(p0[8 * s2 + 2], p0[8 * s2 + 3]); pf[s2].z = pk2(p0[8 * s2 + 4], p0[8 * s2 + 5]); pf[s2].w = pk2(p0[8 * s2 + 6], p0[8 * s2 + 7]);
        pf[2 + s2].x = pk2(p1[8 * s2 + 0], p1[8 * s2 + 1]); pf[2 + s2].y = pk2(p1[8 * s2 + 2], p1[8 * s2 + 3]); pf[2 + s2].z = pk2(p1[8 * s2 + 4], p1[8 * s2 + 5]); pf[2 + s2].w = pk2(p1[8 * s2 + 6], p1[8 * s2 + 7]);
    }
    return alpha;
}
template <int NDB>
__device__ __forceinline__ void att_pv(const LAS unsigned char* vt, int voff, const u32x4_t (&pf)[4], f32x16_t (&o)[NDB]) {
#pragma unroll
    for (int js = 0; js < 4; ++js) {
        const s16x8_t pfr = __builtin_bit_cast(s16x8_t, pf[js]);
#pragma unroll
        for (int db = 0; db < NDB; ++db) {
            const LAS unsigned char* vp = vt + voff + db * (32 * 144) + js * 32;
            const u32x2_t lo = *(const LAS u32x2_t*)vp, hh = *(const LAS u32x2_t*)(vp + 16);
            u32x4_t vw; vw.x = lo.x; vw.y = lo.y; vw.z = hh.x; vw.w = hh.y;
            o[db] = __builtin_amdgcn_mfma_f32_32x32x16_bf16(__builtin_bit_cast(s16x8_t, vw), pfr, o[db], 0, 0, 0);
        }
    }
}
template <int DV, int KROW, bool DIFF>
__device__ __forceinline__ void attn_unit(LAS unsigned char* lds, const AttnArgs& a) {
    constexpr int KROWB = KROW * 2 + 16, NKC = KROW / 64, NVC = DV / 64, NDB = DV / 32, KPR = KROW / 8;
    int tid_ = threadIdx.x; asm volatile("" : "+v"(tid_));
    const int tid = tid_, lane = tid & 63, r32 = lane & 31, hi = lane >> 5;
    const int wid = __builtin_amdgcn_readfirstlane(tid >> 6), g = wid >> 2, wq = wid & 3;
    const int kcol = (KROW == 128) ? g * 64 : 0;
    const int koff = r32 * KROWB + (kcol + hi * 8) * 2;
    const int voff = ATT_VOFF + r32 * 144 + hi * 8;
    constexpr bool QLDS = false;
    s16x8_t qf[4];
    LAS s16x8_t* const qlds = (LAS s16x8_t*)(lds + 3 * ATT_BUF) + tid;
    { const bfraw* qp = a.Q + (size_t)(wq * 32 + r32) * 512 + (g ? a.qcol1 : a.qcol0) + hi * 8;
#pragma unroll
      for (int d0 = 0; d0 < 4; ++d0) { qf[d0] = *(const s16x8_t*)(qp + d0 * 16); if (QLDS) qlds[d0 * 512] = qf[d0]; } }
    f32x16_t o[NDB];
#pragma unroll
    for (int db = 0; db < NDB; ++db)
#pragma unroll
        for (int r = 0; r < 16; ++r) o[db][r] = 0.f;
    float m_run = 0.f, l_run = 0.f;
    f32x16_t negm;
#pragma unroll
    for (int r = 0; r < 16; ++r) negm[r] = 0.f;
    u32x4_t kreg[NKC], vreg[NVC];
#define ATT_GLOAD(tn_) do { const int tn = (tn_); const bool own = tn < a.nOwn; \
            const bfraw* kb = own ? a.Kown + (size_t)tn * 64 * a.kstride : a.Kc + (size_t)(tn - a.nOwn) * 64 * a.kstride; \
            const bfraw* vb = own ? a.Vown + tn * 64 : a.Vc + (tn - a.nOwn) * 64; const int vs = own ? a.vsOwn : a.vsC; \
            _Pragma("unroll") for (int i = 0; i < NKC; ++i) { const int ch = tid + 512 * i, key = ch / KPR, part = ch % KPR; kreg[i] = *(const u32x4_t*)(kb + (size_t)key * a.kstride + part * 8); } \
            _Pragma("unroll") for (int i = 0; i < NVC; ++i) { const int ch = tid + 512 * i, d = ch >> 3, part = ch & 7; vreg[i] = *(const u32x4_t*)(vb + (size_t)d * vs + part * 8); } } while (0)
#define ATT_LSTORE(buf_) do { LAS unsigned char* const nb_ = (buf_); \
            _Pragma("unroll") for (int i = 0; i < NKC; ++i) { const int ch = tid + 512 * i, key = ch / KPR, part = ch % KPR; *(LAS u32x4_t*)(nb_ + key * KROWB + part * 16) = kreg[i]; } \
            _Pragma("unroll") for (int i = 0; i < NVC; ++i) { const int ch = tid + 512 * i, d = ch >> 3, part = ch & 7; *(LAS u32x4_t*)(nb_ + ATT_VOFF + d * 144 + part * 16) = vreg[i]; } } while (0)
    ATT_GLOAD(0);
    ATT_LSTORE(lds);
    __syncthreads();
    ATT_GLOAD(1);
    u32x4_t pf[4];
    {
        f32x16_t p0, p1;
        att_s<KROWB, QLDS>(lds, koff, qf, qlds, negm, p0, p1);
        (void)att_softmax<true>(p0, p1, m_run, l_run, negm, pf);
        ATT_LSTORE(lds + ATT_BUF);
        __syncthreads();
        if (a.nTot > 2) ATT_GLOAD(2);
    }
    int ic = 1, ip = 0, in = 2;
    for (int t = 1; t < a.nTot; ++t) {
        const LAS unsigned char* const cur = lds + ic * ATT_BUF; const LAS unsigned char* const prv = lds + ip * ATT_BUF;
        f32x16_t p0, p1;
        att_s<KROWB, QLDS>(cur, koff, qf, qlds, negm, p0, p1);
        att_pv<NDB>(prv, voff, pf, o);
        u32x4_t pn[4];
        const float alpha = att_softmax<false>(p0, p1, m_run, l_run, negm, pn);
        if (__any(alpha != 1.0f)) {
#pragma unroll
            for (int db = 0; db < NDB; ++db)
#pragma unroll
                for (int r = 0; r < 16; ++r) o[db][r] *= alpha;
        }
#pragma unroll
        for (int i = 0; i < 4; ++i) pf[i] = pn[i];
        if (t + 1 < a.nTot) ATT_LSTORE(lds + in * ATT_BUF);
        __syncthreads();
        if (t + 2 < a.nTot) ATT_GLOAD(t + 2);
        const int tmp = ip; ip = ic; ic = in; in = tmp;
    }
    att_pv<NDB>(lds + ip * ATT_BUF, voff, pf, o);
    __syncthreads();
#undef ATT_GLOAD
#undef ATT_LSTORE
    const float ltot = l_run + __shfl_xor(l_run, 32);
    const float inv = 1.0f / ltot;
    const int qrow = wq * 32 + r32;
    if (DIFF) {
        LAS float* xch = (LAS float*)(lds + ATT_XOFF) + wq * 64 * 64 + lane;
        if (g == 1) {
            const float sc = inv * a.lam;
#pragma unroll
            for (int db = 0; db < NDB; ++db)
#pragma unroll
                for (int r = 0; r < 16; ++r) xch[(db * 16 + r) * 64] = o[db][r] * sc;
        }
        __syncthreads();
        if (g == 0) {
            float ss = 0.f;
#pragma unroll
            for (int db = 0; db < NDB; ++db)
#pragma unroll
                for (int r = 0; r < 16; ++r) { const float v = o[db][r] * inv - xch[(db * 16 + r) * 64]; o[db][r] = v; ss += v * v; }
            ss += __shfl_xor(ss, 32);
            const float rn = __builtin_amdgcn_rsqf(ss * (1.0f / 128.0f) + NEPS) * a.postscale;
            bfraw* op = a.O + (size_t)qrow * 512 + a.ocol0 + 4 * hi;
#pragma unroll
            for (int db = 0; db < NDB; ++db)
#pragma unroll
                for (int rr = 0; rr < 4; ++rr) {
                    const int d = 32 * db + 8 * rr;
                    const f32x4_t w = *(const f32x4_t*)(a.subln + d + 4 * hi);
                    f32x4_t v; v[0] = o[db][4 * rr] * rn * w[0]; v[1] = o[db][4 * rr + 1] * rn * w[1]; v[2] = o[db][4 * rr + 2] * rn * w[2]; v[3] = o[db][4 * rr + 3] * rn * w[3];
                    st_bf4(op + d, v);
                }
        }
    } else {
        bfraw* op = a.O + (size_t)qrow * 512 + (g ? a.ocol1 : a.ocol0) + 4 * hi;
#pragma unroll
        for (int db = 0; db < NDB; ++db)
#pragma unroll
            for (int rr = 0; rr < 4; ++rr) {
                f32x4_t v; v[0] = o[db][4 * rr] * inv; v[1] = o[db][4 * rr + 1] * inv; v[2] = o[db][4 * rr + 2] * inv; v[3] = o[db][4 * rr + 3] * inv;
                st_bf4(op + 32 * db + 8 * rr, v);
            }
    }
    __syncthreads();
}

__device__ __forceinline__ void conv_unit(LAS unsigned char* lds, int unit, const bfraw* U, bfraw* UC, const float* cw, const float* cb, const float* lg, const float* lbeta) {
    int tid_ = threadIdx.x; asm volatile("" : "+v"(tid_));
    const int tid = tid_, lane = tid & 63, wid = tid >> 6, c = tid;
    const int m0 = unit * 32;
    int lo, hi_;
    if (m0 < NCTX) { lo = (m0 / CSEQ) * CSEQ; hi_ = lo + CSEQ; } else { lo = NCTX + ((m0 - NCTX) / LSEQ) * LSEQ; hi_ = lo + LSEQ; }
    LAS bfraw* sin_ = (LAS bfraw*)lds;
    LAS float* sm = (LAS float*)(lds + 65536);
    LAS float* st = (LAS float*)(lds + 131072);
#pragma unroll
    for (int k = 0; k < 8; ++k) {
        const int ch = tid + 512 * k, i = ch >> 6, part = ch & 63; int tok = m0 - 15 + i;
        const bool ok = tok >= lo && tok < hi_ && i < 62;
        tok = tok < lo ? lo : (tok >= hi_ ? hi_ - 1 : tok);
        u32x4_t v = *(const u32x4_t*)(U + (size_t)tok * 512 + part * 8);
        if (!ok) v = (u32x4_t){0u, 0u, 0u, 0u};
        if (i < 62) *(LAS u32x4_t*)(sin_ + i * 512 + part * 8) = v;
    }
    float w[31];
#pragma unroll
    for (int j = 0; j < 31; ++j) w[j] = cw[j * 512 + c];
    const float bias = cb[c];
    __syncthreads();
#pragma unroll 1
    for (int g = 0; g < 4; ++g) {
        float acc[8];
#pragma unroll
        for (int o = 0; o < 8; ++o) acc[o] = bias;
        const LAS bfraw* sp = sin_ + (8 * g) * 512 + c;
#pragma unroll
        for (int i = 0; i < 38; ++i) {
            const float v = bf2f(sp[i * 512]);
#pragma unroll
            for (int o = 0; o < 8; ++o) { const int j = i - o; if (j >= 0 && j < 31) acc[o] += v * w[j]; }
        }
#pragma unroll
        for (int o = 0; o < 8; ++o) sm[(8 * g + o) * 512 + c] = acc[o];
    }
    __syncthreads();
#pragma unroll
    for (int tt = 0; tt < 4; ++tt) {
        const int tok = wid * 4 + tt; float s = 0.f, q = 0.f;
#pragma unroll
        for (int k = 0; k < 8; ++k) { const float x = sm[tok * 512 + lane + 64 * k]; s += x; q += x * x; }
        s = wave_sum(s); q = wave_sum(q);
        const float mu = s * (1.0f / 512.0f), var = __builtin_fmaxf(q * (1.0f / 512.0f) - mu * mu, 0.f);
        if (lane == 0) { st[tok * 2] = mu; st[tok * 2 + 1] = __builtin_amdgcn_rsqf(var + NEPS); }
    }
    __syncthreads();
    const float gg = lg[c], bb = lbeta[c];
#pragma unroll 8
    for (int o = 0; o < 32; ++o) {
        const float y = (sm[o * 512 + c] - st[o * 2]) * st[o * 2 + 1] * gg + bb;
        UC[(size_t)(m0 + o) * 512 + c] = f2bf(y * sigmoidf_(y));
    }
    __syncthreads();
}

template <bool PERMIN>
__device__ __forceinline__ void convert_item(const float* W, int K, int N, bfraw* WT, int vrow0, int n0, int k0, LAS float* scr, int tid) {
    const int lane = tid & 63, wave = tid >> 6;
    float v[16][4];
#pragma unroll
    for (int g4 = 0; g4 < 4; ++g4) {
        const int vc = g4 * 64 + lane;
        const int col = PERMIN ? vcol_map((vrow0 + vc) >> 5) + (vc & 31) : n0 + vc;
#pragma unroll
        for (int r = 0; r < 16; ++r) v[r][g4] = W[(size_t)(k0 + wave * 16 + r) * N + col];
    }
#pragma unroll
    for (int r = 0; r < 16; ++r)
#pragma unroll
        for (int g4 = 0; g4 < 4; ++g4) scr[(wave * 16 + r) * 257 + g4 * 64 + lane] = v[r][g4];
    __syncthreads();
#pragma unroll
    for (int it = 0; it < 8; ++it) {
        const int ch = it * 512 + tid, n = ch >> 4, kc = ch & 15;
        const LAS float* s = scr + (8 * kc) * 257 + n;
        u32x4_t o; o.x = pk2(s[0], s[257]); o.y = pk2(s[2 * 257], s[3 * 257]); o.z = pk2(s[4 * 257], s[5 * 257]); o.w = pk2(s[6 * 257], s[7 * 257]);
        *(u32x4_t*)(WT + (size_t)(vrow0 + n) * K + k0 + 8 * kc) = o;
    }
    __syncthreads();
}
#define CONVERT_RANGE(IT0, ITEND, STEP) { \
        LAS float* scr = (LAS float*)lds; \
        constexpr int I_IN = 8 * 25, I_BR = 3 * 16, I_O = 32, I_1 = 128, I_2 = 128, I_L = I_IN + I_BR + I_O + I_1 + I_2; \
        for (int it = (IT0); it < (ITEND); it += (STEP)) { \
            const int l = it / I_L; int r = it % I_L; \
            if (r < I_IN) { const int kb = r / 25, nt = r % 25; convert_item<true>(a.in[12] + (size_t)l * DM * INW, DM, INW, (bfraw*)(ws + WS_WIN + l * WIN_L), nt * 256, 0, kb * 128, scr, tid); continue; } r -= I_IN; \
            if (r < I_BR) { const int br = r >> 4, rr = r & 15, kb = rr >> 2, nt = rr & 3; const float* W = (br == 0 ? a.in[18] : br == 1 ? a.in[21] : a.in[26]) + (size_t)l * 512 * 1024; \
                convert_item<false>(W, 512, 1024, (bfraw*)(ws + WS_WBR + l * WBR_L) + (size_t)br * 1024 * 512, nt * 256, nt * 256, kb * 128, scr, tid); continue; } r -= I_BR; \
            if (r < I_O) { const int kb = r >> 2, nt = r & 3; convert_item<false>(a.in[27] + (size_t)l * 1024 * 1024, 1024, 1024, (bfraw*)(ws + WS_WO + l * WO_L), nt * 256, nt * 256, kb * 128, scr, tid); continue; } r -= I_O; \
            if (r < I_1) { const int kb = r >> 4, nt = r & 15; convert_item<false>(a.in[28] + (size_t)l * 1024 * 4096, 1024, 4096, (bfraw*)(ws + WS_W1 + l * W1_L), nt * 256, nt * 256, kb * 128, scr, tid); continue; } r -= I_1; \
            { const int kb = r >> 2, nt = r & 3; convert_item<false>(a.in[29] + (size_t)l * 4096 * 1024, 4096, 1024, (bfraw*)(ws + WS_W2 + l * W2_L), nt * 256, nt * 256, kb * 128, scr, tid); } \
        } }
#define P0_CONVERT { if (G == 256) CONVERT_RANGE(G - 1 - bid, 200, G) else CONVERT_RANGE(G - 1 - bid, 1072, G) }
#define CONV_PHASE \
            for (int u0 = bid; u0 < NTOK / 32; u0 += G) { const int u = (G == 256) ? 32 * (u0 & 7) + (u0 >> 3) : u0;     \
                conv_unit(lds, u, (const bfraw*)(P_PROJ + P_U), P_ABR + (size_t)2 * NTOK * 512, a.in[22] + l * 31 * 512, a.in[23] + l * 512, a.in[24] + l * 512, a.in[25] + l * 512); }
#define PH_BEGIN const CAS_ KArgs* ap_ = (const CAS_ KArgs*)__builtin_amdgcn_kernarg_segment_ptr(); asm volatile("" : "+s"(ap_)); const CAS_ KArgs& a = *ap_; \
    GAS_ unsigned char* wsg_ = (GAS_ unsigned char*)a.ws; asm volatile("" : "+s"(wsg_)); unsigned char* ws = (unsigned char*)wsg_; int tid = threadIdx.x; asm volatile("" : "+v"(tid)); \
    const int lane = tid & 63, wave = __builtin_amdgcn_readfirstlane(tid >> 6), gw = bid * 8 + wave, NGW = G * 8; (void)lane; (void)gw; (void)NGW; (void)wave;
#define GAS_ __attribute__((address_space(1)))
#define CAS_ __attribute__((address_space(4)))
#ifdef TPROBE
#ifndef TP_BLK
#define TP_BLK 0
#endif
#define STAMP(k) do { if (bid == TP_BLK && threadIdx.x == 0) ((volatile LAS unsigned long long*)(lds + 146880))[(k)] = __builtin_amdgcn_s_memrealtime(); } while (0)
#else
#define STAMP(k) do {} while (0)
#endif
#ifndef SPLITK
#define SPLITK 1
#endif
#ifndef PATAIL
#define PATAIL 1
#endif
#ifndef LOCALBAR
#define LOCALBAR 1
#endif
#ifndef NOCG
#define NOCG 1
#endif
#ifndef C2SPLIT
#define C2SPLIT 1
#endif
#ifndef GALIGN
#define GALIGN true
#endif
#ifndef C1HALFN
#define C1HALFN 1
#endif
#ifndef C1PAIR
#define C1PAIR 0
#endif
#ifdef XPROBE
#define XP_OFF(x) 0
#define XPROBE_KL(full) (full)
#else
#define XP_OFF(x) (x)
#define XPROBE_KL(full) kh
#endif
#define NR_XCD (G == 256)
#define NR_M0 (NR_XCD ? 1024 * (bid & 7) + (((bid >> 3) * 8 + wave) * 4) : gw)
#define NR_END (NR_XCD ? NR_M0 + 1 : NTOK)
#define NR_STEP (NR_XCD ? 4 : 4 * NGW)
#define NR_STRIDE (NR_XCD ? 1 : NGW)
#define P_MOD ((float*)(ws + WS_MOD))
#define P_HB ((bfraw*)(ws + WS_HB))
#define P_ABR ((bfraw*)(ws + WS_ABR))
#define P_PROJ (ws + WS_PROJ)
#define P_X (a.out + O_X)
__global__ void __launch_bounds__(512, 2) fwd_kernel(KArgs a_) {
    extern __shared__ __attribute__((aligned(16))) unsigned char lds_raw[];
    LAS unsigned char* lds = (LAS unsigned char*)lds_raw;
    cg::grid_group grid = cg::this_grid();
    int bid = blockIdx.x; const int G = gridDim.x;
    volatile LAS unsigned* bst = (volatile LAS unsigned*)(lds + 147392);
    STAMP(0);
    {
        PH_BEGIN
        unsigned* barw = (unsigned*)(ws + WS_BAR);
        if (tid == 0) { bst[0] = 0u; bst[1] = 0u; bst[2] = 0u; bst[3] = 0u; }
#if !NOCG
        if (bid == 0) for (int i = tid; i < 6656; i += 512) __hip_atomic_store(barw + i, 0u, __ATOMIC_RELAXED, __HIP_MEMORY_SCOPE_AGENT);
#else
        (void)barw;
#endif
        __syncthreads();
    }
#if NOCG
    const XcdBarrier bar = xcd_barrier_post((unsigned*)(a_.ws + WS_BAR), bst);
#endif
#pragma unroll 1
    for (int rep_ = 0; rep_ < REP_P0; ++rep_) {
        PH_BEGIN
        LAS float* sil = (LAS float*)lds;
        for (int i = tid; i < 3072; i += 512) { const int cond = i >> 10, k = i & 1023; const float v = cond == 0 ? a.in[7][k] : a.in[6][(cond - 1) * 1024 + k]; sil[i] = v * sigmoidf_(v); }
        __syncthreads();
        LAS float* part = (LAS float*)(lds + 16384);
        for (int item = bid; item < 192; item += G) {
            const int l = item / 96, nb = (item % 96) * 64;
            const float* W = a.in[8] + (size_t)l * 1024 * 6144 + nb + lane;
            const int k0 = wave * 128;
            float a0 = 0.f, a1 = 0.f, a2 = 0.f;
#pragma unroll 32
            for (int kk = 0; kk < 128; ++kk) { const float wv = W[(size_t)(k0 + kk) * 6144]; a0 += sil[k0 + kk] * wv; a1 += sil[1024 + k0 + kk] * wv; a2 += sil[2048 + k0 + kk] * wv; }
            part[(wave * 3 + 0) * 64 + lane] = a0; part[(wave * 3 + 1) * 64 + lane] = a1; part[(wave * 3 + 2) * 64 + lane] = a2;
            __syncthreads();
            if (tid < 192) { const int cnd = tid >> 6, ln = tid & 63; float s = 0.f;
#pragma unroll
                for (int wv = 0; wv < 8; ++wv) s += part[(wv * 3 + cnd) * 64 + ln];
                P_MOD[(size_t)(l * 3 + cnd) * 6144 + nb + ln] = s + a.in[9][l * 6144 + nb + ln]; }
            __syncthreads();
        }
        if ((bid == G - 3 || G < 3) && tid < 2) {
            float d1 = 0.f, d2 = 0.f;
            for (int i = 0; i < 64; ++i) { d1 += a.in[13][tid * 64 + i] * a.in[14][tid * 64 + i]; d2 += a.in[15][tid * 64 + i] * a.in[16][tid * 64 + i]; }
            ((float*)(ws + WS_LAM))[tid] = __builtin_amdgcn_exp2f(d1 * 1.4426950408889634f) - __builtin_amdgcn_exp2f(d2 * 1.4426950408889634f) + (tid == 0 ? 0.2f : 0.35550907f);
        }
        if (bid == G - 2 || G == 1) { float* QKN = (float*)(ws + WS_QKN); if (tid < 256) { const int l_ = tid >> 7, w_ = (tid >> 6) & 1, d_ = tid & 63; QKN[tid] = (w_ ? a.in[20] : a.in[19])[l_ * 64 + d_]; } }
        if (bid == G - 1) {
            float* ROPEC = (float*)(ws + WS_ROPEC); float* ROPES = (float*)(ws + WS_ROPES);
            for (int i = tid; i < 1024; i += 512) { const int pos = i >> 4, j = i & 15; const float freq = __builtin_amdgcn_exp2f(-(float)j * 0.8304820237218406f);
                float s, c; sincos_small((float)pos * freq, s, c); ROPEC[i] = c; ROPES[i] = s; }
        }
        __syncthreads();
        P0_CONVERT
        const int gt = bid * 512 + tid, GT = G * 512;
        bfraw* CDK = (bfraw*)(ws + WS_CDK); bfraw* CDVT = (bfraw*)(ws + WS_CDVT); bfraw* CGK = (bfraw*)(ws + WS_CGK); bfraw* CGVT = (bfraw*)(ws + WS_CGVT);
        {
            constexpr int ND = 2 * 2 * 256 * 512, NG = 2 * 2 * 256 * 128;
            for (int i = gt; i < NG; i += GT) { const int col = i & 127, s = (i >> 7) & 255, l = (i >> 15) & 1, lb = i >> 16;
                CGK[((size_t)(l * 2 + lb) * 256 + s) * 128 + col] = f2bf(a.in[4][i]); CGVT[((size_t)(l * 2 + lb) * 128 + col) * 256 + s] = f2bf(a.in[5][i]); }
            for (int i0 = gt; i0 < ND; i0 += 4 * GT) {
                float vk[4], vv[4];
#pragma unroll
                for (int k = 0; k < 4; ++k) { const int i = i0 + k * GT; const bool ok = i < ND; vk[k] = ok ? a.in[2][ok ? i : 0] : 0.f; vv[k] = ok ? a.in[3][ok ? i : 0] : 0.f; }
#pragma unroll
                for (int k = 0; k < 4; ++k) { const int i = i0 + k * GT; if (i < ND) { const int col = i & 511, s = (i >> 9) & 255, l = (i >> 17) & 1, lb = i >> 18;
                    CDK[((size_t)(l * 2 + lb) * 256 + s) * 512 + col] = f2bf(vk[k]); CDVT[((size_t)(l * 2 + lb) * 512 + col) * 256 + s] = f2bf(vv[k]); } }
            }
        }
    }
#if !NOCG
    grid.sync();
    const XcdBarrier bar = xcd_barrier_post((unsigned*)(a_.ws + WS_BAR), bst);
#else
    if (G == 0x7fffffff) grid.sync();
    xcd_barrier(bar);
#endif
    STAMP(1);
    for (int rep_ = 0; rep_ < REP_SYNC; ++rep_) xcd_barrier(bar);
#if NOCG
    const bool lbar = LOCALBAR && bst[3] != 0u;
    if (lbar) bid = (int)(bst[2] * 8u + bar.x);
#endif
    {
        PH_BEGIN
        for (int mb = NR_M0; mb < NR_END; mb += NR_STEP) norm_rows4<false>(mb, NR_STRIDE, a.in[0], a.in[1], P_X, nullptr, P_HB, a.in[10], P_MOD, M_SH1, M_SC1, lane);
    }
#if NOCG
    if (lbar) xcc_local_barrier(bar); else xcd_barrier(bar);
#else
    xcd_barrier(bar);
#endif
    STAMP(2);
#if !NOCG
    const bool lbar = LOCALBAR && bst[3] != 0u;
    if (lbar) bid = (int)(bst[2] * 8u + bar.x);
#endif
#define SEAM_LOCAL() do { if (lbar) xcc_local_barrier(bar); else xcd_barrier(bar); } while (0)

#pragma unroll 1
    for (int l = 0; l < 2; ++l) {
#pragma unroll 1
        for (int rep_ = 0; rep_ < REP_PA; ++rep_) {
            PH_BEGIN
            EpiCtx ec; ec.l = l; ec.out = a.out; ec.ws = ws;
            pg8::Gemm g{P_HB, (const bfraw*)(ws + WS_WIN + l * WIN_L), NTOK, INW, DM, DM, -1};
            const bool tail = (G == 256) && PATAIL;
            { pg8::EpiIn E{ec, -1}; pg8::StaticOrder S; S.init(NTOK, tail ? 24 * 256 : INW, G, bid); pg8::gemm_phase<pg8::EpiIn, pg8::StaticOrder, GALIGN, true>(lds, g, S, E); }
            if (tail) { pg8::Gemm g2{P_HB, (const bfraw*)(ws + WS_WIN + l * WIN_L), NTOK, INW, DM, DM, (bid >> 3) & 1}; pg8::EpiIn E2{ec, (bid >> 3) & 1}; pg8::QuarterOrder S{bid}; pg8::gemm_phase<pg8::EpiIn, pg8::QuarterOrder, true, true>(lds, g2, S, E2); }
            if (l == 0 && rep_ == 0 && G == 256 && bid >= 64) { __syncthreads(); CONVERT_RANGE(200 + (bid - 64), 584, 192) }
        }
        xcd_barrier(bar);
        STAMP(3 + l * 8 + 0);
#pragma unroll 1
        for (int rep_ = 0; rep_ < REP_ATT; ++rep_) {
            PH_BEGIN
            const float lam_init = l == 0 ? 0.2f : 0.35550907f;
            const float lam = ((const float*)(ws + WS_LAM))[l];
            const bfraw* CDK = (const bfraw*)(ws + WS_CDK); const bfraw* CDVT = (const bfraw*)(ws + WS_CDVT); const bfraw* CGK = (const bfraw*)(ws + WS_CGK); const bfraw* CGVT = (const bfraw*)(ws + WS_CGVT);
            bfraw* const DQ = (bfraw*)(P_PROJ + P_DQ); bfraw* const DK = (bfraw*)(P_PROJ + P_DK); bfraw* const DVtC = (bfraw*)(P_PROJ + P_DVTC); bfraw* const DVtL = (bfraw*)(P_PROJ + P_DVTL);
            bfraw* const GQ = (bfraw*)(P_PROJ + P_GQ); bfraw* const GK = (bfraw*)(P_PROJ + P_GK); bfraw* const GVtC = (bfraw*)(P_PROJ + P_GVTC); bfraw* const GVtL = (bfraw*)(P_PROJ + P_GVTL);
            bfraw* const ABR = P_ABR;
            for (int k = 0; ; ++k) {
                int u;
                if (G == 256) { if (bid < 128) { if (k > 0) break; u = bid; } else { if (k > 2) break; u = 128 * (k + 1) + (bid - 128); } }
                else { u = bid + k * G; if (u >= 512) break; }
                const int cls = u >> 7, j_ = u & 127, i = (G == 256) ? (j_ & 7) * 16 + (j_ >> 3) : j_;
                AttnArgs t;
                t.lam = lam; t.postscale = 1.0f - lam_init; t.subln = a.in[17] + l * 128;
                if (cls == 0) {
                    const int lb = i >> 6, h = (i >> 4) & 3, qb = i & 15; const int row0 = NCTX + lb * LSEQ;
                    t.Q = DQ + (size_t)(row0 + qb * 128) * 512; t.qcol0 = h * 128; t.qcol1 = h * 128 + 64;
                    t.Kown = DK + (size_t)row0 * 512 + h * 128; t.Kc = CDK + (size_t)(l * 2 + lb) * 256 * 512 + h * 128; t.kstride = 512; t.nOwn = 32; t.nTot = 36;
                    t.Vown = DVtL + ((size_t)lb * 512 + h * 128) * 2048; t.vsOwn = 2048; t.Vc = CDVT + ((size_t)(l * 2 + lb) * 512 + h * 128) * 256; t.vsC = 256;
                    t.O = ABR + (size_t)(row0 + qb * 128) * 512; t.ocol0 = h * 128; t.ocol1 = 0;
                    attn_unit<128, 128, true>(lds, t);
                } else if (cls == 2) {
                    const int cb = i >> 3, h = (i >> 1) & 3, qb = i & 1; const int row0 = cb * CSEQ;
                    t.Q = DQ + (size_t)(row0 + qb * 128) * 512; t.qcol0 = h * 128; t.qcol1 = h * 128 + 64;
                    t.Kown = DK + (size_t)row0 * 512 + h * 128; t.Kc = t.Kown; t.kstride = 512; t.nOwn = 4; t.nTot = 4;
                    t.Vown = DVtC + ((size_t)cb * 512 + h * 128) * 256; t.vsOwn = 256; t.Vc = t.Vown; t.vsC = 256;
                    t.O = ABR + (size_t)(row0 + qb * 128) * 512; t.ocol0 = h * 128; t.ocol1 = 0;
                    attn_unit<128, 128, true>(lds, t);
                } else if (cls == 1) {
                    const int lb = i >> 6, pr = (i >> 4) & 3, qb = i & 15, kvh = pr >> 1, h0 = kvh * 4 + (pr & 1) * 2; const int row0 = NCTX + lb * LSEQ;
                    t.Q = GQ + (size_t)(row0 + qb * 128) * 512; t.qcol0 = h0 * 64; t.qcol1 = h0 * 64 + 64;
                    t.Kown = GK + (size_t)row0 * 128 + kvh * 64; t.Kc = CGK + (size_t)(l * 2 + lb) * 256 * 128 + kvh * 64; t.kstride = 128; t.nOwn = 32; t.nTot = 36;
                    t.Vown = GVtL + ((size_t)lb * 128 + kvh * 64) * 2048; t.vsOwn = 2048; t.Vc = CGVT + ((size_t)(l * 2 + lb) * 128 + kvh * 64) * 256; t.vsC = 256;
                    t.O = ABR + (size_t)NTOK * 512 + (size_t)(row0 + qb * 128) * 512; t.ocol0 = h0 * 64; t.ocol1 = h0 * 64 + 64;
                    attn_unit<64, 64, false>(lds, t);
                } else {
                    const int cb = i >> 3, pr = (i >> 1) & 3, qb = i & 1, kvh = pr >> 1, h0 = kvh * 4 + (pr & 1) * 2; const int row0 = cb * CSEQ;
                    t.Q = GQ + (size_t)(row0 + qb * 128) * 512; t.qcol0 = h0 * 64; t.qcol1 = h0 * 64 + 64;
                    t.Kown = GK + (size_t)row0 * 128 + kvh * 64; t.Kc = t.Kown; t.kstride = 128; t.nOwn = 4; t.nTot = 4;
                    t.Vown = GVtC + ((size_t)cb * 128 + kvh * 64) * 256; t.vsOwn = 256; t.Vc = t.Vown; t.vsC = 256;
                    t.O = ABR + (size_t)NTOK * 512 + (size_t)(row0 + qb * 128) * 512; t.ocol0 = h0 * 64; t.ocol1 = h0 * 64 + 64;
                    attn_unit<64, 64, false>(lds, t);
                }
            }
        }
        STAMP(20 + l * 2);
#pragma unroll 1
        for (int rep_ = 0; rep_ < REP_CONV; ++rep_) {
            PH_BEGIN
            CONV_PHASE
        }
        STAMP(21 + l * 2);
        xcd_barrier(bar);
        STAMP(3 + l * 8 + 1);
#pragma unroll 1
        for (int rep_ = 0; rep_ < REP_C1; ++rep_) {
            PH_BEGIN
            EpiCtx ec; ec.l = l; ec.out = a.out; ec.ws = ws;
            const bool sp = (G == 256) && SPLITK && C1HALFN; const int pairm = (lbar && C1PAIR) ? 1 : 0; const int bjs = pairm ? -1 : (sp ? (bid >> 7) : -1);
            pg8::Gemm g{P_ABR, (const bfraw*)(ws + WS_WBR + l * WBR_L), 3 * NTOK, 3 * 1024, 512, 512, bjs}; pg8::BranchOrder S{(sp || pairm) ? (bid & 127) : bid, bid >> 7, pairm};
            pg8::EpiBranch E{ec, bjs, pairm, (unsigned)(l + 1)};
            pg8::gemm_phase<pg8::EpiBranch, pg8::BranchOrder, true, true>(lds, g, S, E);
            if (l == 0 && rep_ == 0 && G == 256) { __syncthreads(); if (C1HALFN) { CONVERT_RANGE(584 + bid, 1072, 256) } else if (bid >= 128) { CONVERT_RANGE(584 + (bid - 128), 1072, 128) } }
        }
        SEAM_LOCAL();
        STAMP(3 + l * 8 + 2);
#pragma unroll 1
        for (int rep_ = 0; rep_ < REP_C2; ++rep_) {
            PH_BEGIN
            EpiCtx ec; ec.l = l; ec.out = a.out; ec.ws = ws;
            const bool sp = (G == 256) && SPLITK && C2SPLIT; const int half = sp ? (bid >> 7) : 0, kh = sp ? DM / 2 : DM;
            pg8::Gemm g{P_HB + half * kh, (const bfraw*)(ws + WS_WO + l * WO_L) + half * kh, NTOK, DM, DM, kh, -1}; pg8::StaticOrder S; S.init(NTOK, DM, sp ? 128 : G, sp ? (bid & 127) : bid);
            pg8::EpiRes E{ec, M_G1, sp ? (half ? 1 : 2) : 0};
            pg8::gemm_phase<pg8::EpiRes, pg8::StaticOrder, false, true>(lds, g, S, E);
        }
        SEAM_LOCAL();
        STAMP(3 + l * 8 + 3);
        {
            PH_BEGIN
            for (int mb = NR_M0; mb < NR_END; mb += NR_STEP) norm_rows4<false>(mb, NR_STRIDE, nullptr, nullptr, P_X, ((G == 256) && SPLITK && C2SPLIT) ? (const float*)(ws + WS_PART) : nullptr, P_HB, a.in[11] + l * DM, P_MOD + (size_t)(l * 3) * 6144, M_SH2, M_SC2, lane);
        }
        SEAM_LOCAL();
        STAMP(3 + l * 8 + 4);
#pragma unroll 1
        for (int rep_ = 0; rep_ < REP_M1; ++rep_) {
            PH_BEGIN
            EpiCtx ec; ec.l = l; ec.out = a.out; ec.ws = ws;
            pg8::Gemm g{P_HB, (const bfraw*)(ws + WS_W1 + l * W1_L), NTOK, FF, DM, DM, -1}; pg8::StaticOrder S; S.init(NTOK, FF, G, bid);
            pg8::EpiRelu2 E{ec};
            pg8::gemm_phase<pg8::EpiRelu2, pg8::StaticOrder, GALIGN, true>(lds, g, S, E);
        }
        SEAM_LOCAL();
        STAMP(3 + l * 8 + 5);
#pragma unroll 1
        for (int rep_ = 0; rep_ < REP_M2; ++rep_) {
            PH_BEGIN
            EpiCtx ec; ec.l = l; ec.out = a.out; ec.ws = ws;
            const bool sp = (G == 256) && SPLITK; const int half = sp ? (bid >> 7) : 0, kh = sp ? FF / 2 : FF;
            pg8::Gemm g{(const bfraw*)P_PROJ + half * kh, (const bfraw*)(ws + WS_W2 + l * W2_L) + half * kh, NTOK, DM, FF, kh, -1}; pg8::StaticOrder S; S.init(NTOK, DM, sp ? 128 : G, sp ? (bid & 127) : bid);
            pg8::EpiRes E{ec, M_G2, sp ? (half ? 1 : 2) : 0};
            pg8::gemm_phase<pg8::EpiRes, pg8::StaticOrder, false, true>(lds, g, S, E);
        }
        SEAM_LOCAL();
        STAMP(3 + l * 8 + 6);
        {
            PH_BEGIN
            const float* px = ((G == 256) && SPLITK) ? (const float*)(ws + WS_PART) : nullptr;
            if (l == 0) { for (int mb = NR_M0; mb < NR_END; mb += NR_STEP) norm_rows4<false>(mb, NR_STRIDE, nullptr, nullptr, P_X, px, P_HB, a.in[10] + DM, P_MOD + (size_t)3 * 6144, M_SH1, M_SC1, lane); }
            else { for (int mb = NR_M0; mb < NR_END; mb += NR_STEP) norm_rows4<true>(mb, NR_STRIDE, nullptr, nullptr, P_X, px, nullptr, a.in[30], nullptr, 0, 0, lane); }
        }
        if (l == 0) xcd_barrier(bar);
        STAMP(3 + l * 8 + 7);
    }
#ifdef TPROBE
    if (bid == TP_BLK && threadIdx.x == 0) {
        volatile LAS unsigned long long* ts_ = (volatile LAS unsigned long long*)(lds + 146880);
        const unsigned long long T_ = ts_[TP_B] - ts_[TP_A], end_ = __builtin_amdgcn_s_memrealtime() + TP_MULT * T_;
        while (__builtin_amdgcn_s_memrealtime() < end_) __builtin_amdgcn_s_sleep(8);
    }
#endif
}

extern "C" void kernel_launch(void* const* d_in, const int* in_sizes, int n_in, void* d_out, int out_size, void* d_ws, size_t ws_size, hipStream_t stream) {
    static int grid_blocks = 0;
    if (grid_blocks == 0) {
        if (n_in != 31 || ws_size < WS_END) { fprintf(stderr, "kernel_launch: unexpected n_in %d / ws_size %zu\n", n_in, ws_size); grid_blocks = -1; return; }
        int dev = 0, cus = 0, per_cu = 0;
        hipGetDevice(&dev);
        hipDeviceGetAttribute(&cus, hipDeviceAttributeMultiprocessorCount, dev);
        if (hipFuncSetAttribute((const void*)fwd_kernel, hipFuncAttributeMaxDynamicSharedMemorySize, LDS_BYTES) != hipSuccess) { fprintf(stderr, "kernel_launch: hipFuncSetAttribute failed\n"); grid_blocks = -1; return; }
        if (hipOccupancyMaxActiveBlocksPerMultiprocessor(&per_cu, (const void*)fwd_kernel, 512, LDS_BYTES) != hipSuccess || per_cu < 1) { fprintf(stderr, "kernel_launch: occupancy query gave %d\n", per_cu); (void)hipGetLastError(); per_cu = 1; }
        grid_blocks = cus * 1;
    }
    if (grid_blocks < 0) return;
#if NOCG
    if (hipMemsetAsync((char*)d_ws + WS_BAR, 0, 6656 * 4, stream) != hipSuccess) { fprintf(stderr, "kernel_launch: hipMemsetAsync of the barrier words failed\n"); return; }
#endif
    KArgs a{};
    for (int i = 0; i < 31; ++i) a.in[i] = (const float*)d_in[i];
    a.out = (float*)d_out; a.ws = (unsigned char*)d_ws;
    void* args[] = {&a};
    hipError_t e = hipLaunchCooperativeKernel((const void*)fwd_kernel, dim3(grid_blocks), dim3(512), args, LDS_BYTES, stream);
    if (e != hipSuccess) fprintf(stderr, "cooperative launch failed: %s (grid %d)\n", hipGetErrorString(e), grid_blocks);
}
```

```cpp
#include <hip/hip_runtime.h>
#include <hip/hip_cooperative_groups.h>
#include <cstdio>
#include <cstdint>
namespace cg = cooperative_groups;

typedef float f32x4_t __attribute__((ext_vector_type(4)));
typedef float f32x2_t __attribute__((ext_vector_type(2)));
typedef float f32x16_t __attribute__((ext_vector_type(16)));
typedef unsigned u32x4_t __attribute__((ext_vector_type(4)));
typedef unsigned u32x2_t __attribute__((ext_vector_type(2)));
typedef short s16x8_t __attribute__((ext_vector_type(8)));
typedef __bf16 bf16x2_t __attribute__((ext_vector_type(2)));
typedef unsigned short bfraw;

__device__ __forceinline__ unsigned pk2(float lo, float hi) { f32x2_t v = {lo, hi}; bf16x2_t b = __builtin_convertvector(v, bf16x2_t); return __builtin_bit_cast(unsigned, b); }
__device__ __forceinline__ bfraw f2bf(float x) { return (bfraw)(pk2(x, 0.f) & 0xffffu); }
__device__ __forceinline__ float bf2f(bfraw x) { return __builtin_bit_cast(float, (unsigned)x << 16); }
__device__ __forceinline__ float sigmoidf_(float x) { return __builtin_amdgcn_rcpf(1.0f + __builtin_amdgcn_exp2f(-1.4426950408889634f * x)); }

constexpr int DM = 1024, NTOK = 8192, NCTX = 4096, CSEQ = 256, LSEQ = 2048, PAST = 256, INW = 6400, FF = 4096;
constexpr float NEPS = 1e-6f;
constexpr float QSCALE = 0.125f * 1.4426950408889634f;
constexpr size_t O_X = 0, O_NDK = 8388608, O_NDV = 12582912, O_NGK = 16777216, O_NGV = 17825792;
constexpr int M_SH1 = 0, M_SC1 = 1024, M_G1 = 2048, M_SH2 = 3072, M_SC2 = 4096, M_G2 = 5120;

struct EpiCtx { int l; float* out; unsigned char* ws; };
#define LAS __attribute__((address_space(3)))
constexpr size_t MiB = 1u << 20;
constexpr size_t WS_MOD = 0, WS_ROPEC = 160 * 1024, WS_ROPES = 164 * 1024, WS_BAR = 192 * 1024, WS_FLAG = WS_BAR + 16384, WS_FLAG2 = WS_BAR + 5632 * 4, WS_QKN = 176 * 1024, WS_LAM = 180 * 1024;
constexpr size_t WS_CDK = 1 * MiB, WS_CDVT = 2 * MiB, WS_CGK = 3 * MiB, WS_CGVT = 3 * MiB + 256 * 1024;
constexpr size_t WS_WIN = 4 * MiB, WIN_L = (size_t)INW * DM * 2;
constexpr size_t WS_WBR = 29 * MiB, WBR_L = 3 * MiB;
constexpr size_t WS_WO = 35 * MiB, WO_L = 2 * MiB;
constexpr size_t WS_W1 = 39 * MiB, W1_L = 8 * MiB;
constexpr size_t WS_W2 = 55 * MiB, W2_L = 8 * MiB;
constexpr size_t WS_HB = 72 * MiB;
constexpr size_t WS_ABR = 88 * MiB;
constexpr size_t WS_PROJ = 112 * MiB;
constexpr size_t P_DQ = 0, P_DK = 8 * MiB, P_DVTC = 16 * MiB, P_DVTL = 20 * MiB, P_GQ = 24 * MiB, P_GK = 32 * MiB, P_GVTC = 34 * MiB, P_GVTL = 35 * MiB, P_U = 36 * MiB, P_G = 44 * MiB;
constexpr size_t WS_PART = 204 * MiB;
constexpr size_t WS_END = 236 * MiB;
constexpr int LDS_BYTES = 147456;

__device__ __forceinline__ void st_bf4(bfraw* p, f32x4_t v) { u32x2_t w; w.x = pk2(v[0], v[1]); w.y = pk2(v[2], v[3]); *(u32x2_t*)p = w; }
__device__ __forceinline__ float dot4(f32x4_t v) { return (v[0] * v[0] + v[1] * v[1]) + (v[2] * v[2] + v[3] * v[3]); }
namespace pg8 {
#define PG8_LAS __attribute__((address_space(3)))
typedef unsigned short bf16_t;
typedef short bf16x8 __attribute__((ext_vector_type(8)));
typedef float f32x4 __attribute__((ext_vector_type(4)));
typedef unsigned u32x4 __attribute__((ext_vector_type(4)));
constexpr int BM = 256, BK = 64, HALF = 128, HTB = HALF * BK * 2  , STAGE_BYTES = 8 * HTB, NXCD = 8, WGM = 4;

__host__ __device__ __forceinline__ int lds_byte(int r, int c) { const int st = (r >> 4) * 2 + (c >> 5), rr = r & 15, cc = c & 31, ob = rr * 64 + cc * 2; return st * 1024 + (ob ^ (((ob >> 9) & 1) << 5)); }
__host__ __device__ __forceinline__ void stage_rc(int b, int& R, int& C) { const int st = b / 1024, sb = b % 1024, swz = sb ^ (((sb >> 9) & 1) << 5); R = (st >> 1) * 16 + swz / 64; C = (st & 1) * 32 + (swz % 64) / 2; }
__host__ __device__ __forceinline__ int perm32(int rho) { const int n = rho >> 4, i = rho & 15; return 8 * (i >> 2) + 4 * n + (i & 3); }

struct Unit { int pm, pn; };
struct Gemm { const bf16_t* A; const bf16_t* Bt; int M, N, K, Kloop, bjsel; };

struct StaticOrder {
    int nM, nN, nwg, G, c;
    __host__ __device__ void init(int M, int N, int G_, int c_) { nM = M / BM; nN = N / BM; nwg = nM * nN; G = G_; c = c_; }
    __host__ __device__ bool next(int i, Unit& u) const {
        const long L = (long)i * G + c; if (L >= nwg) return false;
        int wgid = (int)L; { const int q = nwg / NXCD, r = nwg % NXCD, xcd = wgid % NXCD, off = wgid / NXCD; wgid = (xcd < r ? xcd * (q + 1) : r * (q + 1) + (xcd - r) * q) + off; }
        const int nig = WGM * nN, gid = wgid / nig, fm = gid * WGM, gsz = (nM - fm) < WGM ? (nM - fm) : WGM;
        u.pm = fm + ((wgid % nig) % gsz); u.pn = (wgid % nig) / gsz; return true;
    }
    __device__ __forceinline__ void a_ready(const Unit&) const {}
    __device__ __forceinline__ void done(const Unit&) const {}
};

__device__ __forceinline__ unsigned cvt_pk_bf16(float lo, float hi) { unsigned r; asm volatile("v_cvt_pk_bf16_f32 %0, %1, %2" : "=v"(r) : "v"(lo), "v"(hi)); return r; }
typedef float f32x2 __attribute__((ext_vector_type(2)));
#define EC_DQ ((bfraw*)(c.ws + WS_PROJ + P_DQ))
#define EC_DK ((bfraw*)(c.ws + WS_PROJ + P_DK))
#define EC_DVtC ((bfraw*)(c.ws + WS_PROJ + P_DVTC))
#define EC_DVtL ((bfraw*)(c.ws + WS_PROJ + P_DVTL))
#define EC_GQ ((bfraw*)(c.ws + WS_PROJ + P_GQ))
#define EC_GK ((bfraw*)(c.ws + WS_PROJ + P_GK))
#define EC_GVtC ((bfraw*)(c.ws + WS_PROJ + P_GVTC))
#define EC_GVtL ((bfraw*)(c.ws + WS_PROJ + P_GVTL))
#define EC_U ((bfraw*)(c.ws + WS_PROJ + P_U))
#define EC_G ((bfraw*)(c.ws + WS_PROJ + P_G))
#define EC_TMP ((float*)(c.ws + WS_PROJ))
#define EC_HB ((bfraw*)(c.ws + WS_HB))
#define EC_HID ((bfraw*)(c.ws + WS_PROJ))
#define EC_mod ((const float*)(c.ws + WS_MOD))
#define EC_ropec ((const float*)(c.ws + WS_ROPEC))
#define EC_ropes ((const float*)(c.ws + WS_ROPES))

struct EpiIn {
    static constexpr bool PERM = false, AFTER_DRAIN = false;
    EpiCtx c; int q;
    __device__ __forceinline__ void operator()(const f32x4 (&acc)[2][2][4][2], const Unit& u, int wr, int wc, int fr_, int fq_) const {
        int fr = fr_, fq = fq_; asm volatile("" : "+v"(fr), "+v"(fq));
        const int pn = u.pn, pm = u.pm, l = c.l;
        const bool ctx = pm < 16;
        const int rbase = pm * 256 + wr * 64 + fr;
        const int lb = (pm - 16) >> 3;
        if (pn < 2) {
#pragma unroll
            for (int ai = 0; ai < 2; ++ai)
#pragma unroll
                for (int m = 0; m < 4; ++m) {
                    const int row = rbase + ai * 128 + m * 16; const int t = (row - NCTX) & (LSEQ - 1);
                    f32x4 cs = {1.f, 1.f, 1.f, 1.f}, sn = {0.f, 0.f, 0.f, 0.f};
                    if (!ctx) { const int pos = (wc & 1) ? (t & 63) : (t >> 6); cs = *(const f32x4*)(EC_ropec + pos * 16 + 4 * fq); sn = *(const f32x4*)(EC_ropes + pos * 16 + 4 * fq); }
#pragma unroll
                    for (int bj = 0; bj < 2; ++bj) {
                        const f32x4 x1 = acc[ai][bj][m][0], x2 = acc[ai][bj][m][1];
                        const f32x4 o1 = (x1 * cs - x2 * sn) * QSCALE, o2 = (x2 * cs + x1 * sn) * QSCALE;
                        bfraw* p = EC_DQ + (size_t)row * 512 + pn * 256 + bj * 128 + wc * 32 + 4 * fq;
                        st_bf4(p, o1); st_bf4(p + 16, o2);
                    }
                }
        } else if (pn < 4) {
#pragma unroll
            for (int ai = 0; ai < 2; ++ai)
#pragma unroll
                for (int m = 0; m < 4; ++m) {
                    const int row = rbase + ai * 128 + m * 16; const int t = (row - NCTX) & (LSEQ - 1);
                    f32x4 cs = {1.f, 1.f, 1.f, 1.f}, sn = {0.f, 0.f, 0.f, 0.f};
                    if (!ctx) { const int pos = (wc & 1) ? (t & 63) : (t >> 6); cs = *(const f32x4*)(EC_ropec + pos * 16 + 4 * fq); sn = *(const f32x4*)(EC_ropes + pos * 16 + 4 * fq); }
#pragma unroll
                    for (int bj = 0; bj < 2; ++bj) {
                        const f32x4 x1 = acc[ai][bj][m][0], x2 = acc[ai][bj][m][1];
                        const f32x4 o1 = x1 * cs - x2 * sn, o2 = x2 * cs + x1 * sn;
                        const int colb = (pn - 2) * 256 + bj * 128 + wc * 32 + 4 * fq;
                        if (ctx) { float* op = c.out + O_NDK + ((size_t)(pm * 2 + l) * 256 + (row & 255)) * 512 + colb; *(f32x4*)op = x1; *(f32x4*)(op + 16) = x2; }
                        bfraw* p = EC_DK + (size_t)row * 512 + colb;
                        st_bf4(p, o1); st_bf4(p + 16, o2);
                    }
                }
        } else if (pn < 6) {
#pragma unroll
            for (int ai = 0; ai < 2; ++ai)
#pragma unroll
                for (int m = 0; m < 4; ++m) {
                    const int row = rbase + ai * 128 + m * 16; const int t = (row - NCTX) & (LSEQ - 1); const int s = row & 255;
#pragma unroll
                    for (int bj = 0; bj < 2; ++bj)
#pragma unroll
                        for (int n = 0; n < 2; ++n) {
                            const f32x4 x = acc[ai][bj][m][n];
                            const int colb = (pn - 4) * 256 + bj * 128 + wc * 32 + 16 * n + 4 * fq;
                            if (ctx) { *(f32x4*)(c.out + O_NDV + ((size_t)(pm * 2 + l) * 256 + s) * 512 + colb) = x;
#pragma unroll
                                for (int j = 0; j < 4; ++j) EC_DVtC[((size_t)pm * 512 + colb + j) * 256 + s] = f2bf(x[j]); }
                            else {
#pragma unroll
                                for (int j = 0; j < 4; ++j) EC_DVtL[((size_t)lb * 512 + colb + j) * 2048 + t] = f2bf(x[j]);
#ifdef DUPV
                                asm volatile("" ::: "memory");
#pragma unroll
                                for (int j = 0; j < 4; ++j) EC_DVtL[((size_t)lb * 512 + colb + j) * 2048 + t] = f2bf(x[j]);
#endif
                            }
                        }
                }
        } else if (pn < 8 || (pn == 8 && wc < 2)) {
            const bool isq = pn < 8;
            const float* nw = (const float*)(c.ws + WS_QKN) + l * 128 + (isq ? 0 : 64);
            const int head = isq ? 4 * (pn - 6) + wc : wc;
            const float osc = isq ? QSCALE : 1.0f;
#pragma unroll
            for (int ai = 0; ai < 2; ++ai)
#pragma unroll
                for (int m = 0; m < 4; ++m) {
                    const int row = rbase + ai * 128 + m * 16; const int t = (row - NCTX) & (LSEQ - 1);
                    float ss = (dot4(acc[ai][0][m][0]) + dot4(acc[ai][0][m][1])) + (dot4(acc[ai][1][m][0]) + dot4(acc[ai][1][m][1]));
                    ss += __shfl_xor(ss, 16); ss += __shfl_xor(ss, 32);
                    const float r = __builtin_amdgcn_rsqf(ss * (1.0f / 64.0f) + NEPS);
#pragma unroll
                    for (int bj = 0; bj < 2; ++bj) {
                        const f32x4 wa = *(const f32x4*)(nw + 32 * bj + 4 * fq), wb = *(const f32x4*)(nw + 32 * bj + 16 + 4 * fq);
                        const f32x4 x1 = acc[ai][bj][m][0] * r * wa, x2 = acc[ai][bj][m][1] * r * wb;
                        f32x4 cs = {1.f, 1.f, 1.f, 1.f}, sn = {0.f, 0.f, 0.f, 0.f};
                        if (!ctx) { const int pos = bj ? (t & 63) : (t >> 6); cs = *(const f32x4*)(EC_ropec + pos * 16 + 4 * fq); sn = *(const f32x4*)(EC_ropes + pos * 16 + 4 * fq); }
                        const f32x4 o1 = (x1 * cs - x2 * sn) * osc, o2 = (x2 * cs + x1 * sn) * osc;
                        const int d0 = head * 64 + 32 * bj + 4 * fq;
                        if (isq) { bfraw* p = EC_GQ + (size_t)row * 512 + d0; st_bf4(p, o1); st_bf4(p + 16, o2); }
                        else {
                            if (ctx) { float* op = c.out + O_NGK + ((size_t)(pm * 2 + l) * 256 + (row & 255)) * 128 + d0; *(f32x4*)op = x1; *(f32x4*)(op + 16) = x2; }
                            bfraw* p = EC_GK + (size_t)row * 128 + d0; st_bf4(p, o1); st_bf4(p + 16, o2);
                        }
                    }
                    asm volatile("" ::: "memory");
                }
        } else if (pn == 8) {
            const int kvh = wc - 2;
#pragma unroll
            for (int ai = 0; ai < 2; ++ai)
#pragma unroll
                for (int m = 0; m < 4; ++m) {
                    const int row = rbase + ai * 128 + m * 16; const int t = (row - NCTX) & (LSEQ - 1); const int s = row & 255;
#pragma unroll
                    for (int bj = 0; bj < 2; ++bj)
#pragma unroll
                        for (int n = 0; n < 2; ++n) {
                            const f32x4 x = acc[ai][bj][m][n];
                            const int d0 = kvh * 64 + 32 * bj + 16 * n + 4 * fq;
                            if (ctx) { *(f32x4*)(c.out + O_NGV + ((size_t)(pm * 2 + l) * 256 + s) * 128 + d0) = x;
#pragma unroll
                                for (int j = 0; j < 4; ++j) EC_GVtC[((size_t)pm * 128 + d0 + j) * 256 + s] = f2bf(x[j]); }
                            else {
#pragma unroll
                                for (int j = 0; j < 4; ++j) EC_GVtL[((size_t)lb * 128 + d0 + j) * 2048 + t] = f2bf(x[j]); }
                        }
                }
        } else if (pn < 13) {
            const int q = pn - 9;
#pragma unroll
            for (int ai = 0; ai < 2; ++ai)
#pragma unroll
                for (int m = 0; m < 4; ++m) {
                    const int row = rbase + ai * 128 + m * 16;
#pragma unroll
                    for (int n = 0; n < 2; ++n) {
                        const f32x4 a = acc[ai][0][m][n], g = acc[ai][1][m][n];
                        f32x4 o; o[0] = a[0] * sigmoidf_(g[0]); o[1] = a[1] * sigmoidf_(g[1]); o[2] = a[2] * sigmoidf_(g[2]); o[3] = a[3] * sigmoidf_(g[3]);
                        st_bf4(EC_U + (size_t)row * 512 + q * 128 + wc * 32 + 16 * n + 4 * fq, o);
                    }
                }
        } else {
#pragma unroll
            for (int ai = 0; ai < 2; ++ai) {
#pragma unroll
                for (int m = 0; m < 4; ++m) {
                    const int row = rbase + ai * 128 + m * 16;
#pragma unroll
                    for (int bj = 0; bj < 2; ++bj) {
                        if (q >= 0 && bj != q) continue;
#pragma unroll
                        for (int n = 0; n < 2; ++n) {
                            const f32x4 g = acc[ai][bj][m][n];
                            f32x4 o; o[0] = sigmoidf_(g[0]); o[1] = sigmoidf_(g[1]); o[2] = sigmoidf_(g[2]); o[3] = sigmoidf_(g[3]);
                            st_bf4(EC_G + (size_t)row * 3072 + (pn - 13) * 256 + bj * 128 + wc * 32 + 16 * n + 4 * fq, o);
                        }
                    }
                }
            }
        }
    }
};

struct EpiBranch {
    static constexpr bool PERM = true, AFTER_DRAIN = false;
    EpiCtx c; int bjsel; int pair; unsigned epoch;
    __device__ __forceinline__ void operator()(const f32x4 (&acc)[2][2][4][2], const Unit& u, int wr, int wc, int fr_, int fq_) const {
        int fr = fr_, fq = fq_; asm volatile("" : "+v"(fr), "+v"(fq));
        const int br = u.pm >> 5, pm = u.pm & 31, pn = u.pn & 3;
        unsigned* const flag = (unsigned*)(c.ws + WS_FLAG2) + (pm * 4 + pn) * 8 + wr * 4 + wc;
        const bool last = pair ? (br == 1) : (br == 2);
        if (pair && br == 1) {
            unsigned spins = 0;
            while (__hip_atomic_load(flag, __ATOMIC_RELAXED, __HIP_MEMORY_SCOPE_AGENT) != epoch) { __builtin_amdgcn_s_sleep(1); if (++spins > (1u << 22)) break; }
            __builtin_amdgcn_fence(__ATOMIC_ACQUIRE, "agent");
        }
#pragma unroll
        for (int ai = 0; ai < 2; ++ai)
#pragma unroll
            for (int m = 0; m < 4; ++m) {
                const int row = pm * 256 + ai * 128 + wr * 64 + m * 16 + fr;
#pragma unroll
                for (int bj = 0; bj < 2; ++bj) {
                    if (bjsel >= 0 && bj != bjsel) continue;
                    const int col8 = pn * 256 + bj * 128 + wc * 32 + 8 * fq;
                    const u32x4 gw = *(const u32x4*)(EC_G + (size_t)row * 3072 + br * 1024 + col8);
                    f32x4 g0, g1;
                    g0[0] = __builtin_bit_cast(float, gw.x << 16); g0[1] = __builtin_bit_cast(float, gw.x & 0xffff0000u);
                    g0[2] = __builtin_bit_cast(float, gw.y << 16); g0[3] = __builtin_bit_cast(float, gw.y & 0xffff0000u);
                    g1[0] = __builtin_bit_cast(float, gw.z << 16); g1[1] = __builtin_bit_cast(float, gw.z & 0xffff0000u);
                    g1[2] = __builtin_bit_cast(float, gw.w << 16); g1[3] = __builtin_bit_cast(float, gw.w & 0xffff0000u);
                    f32x4 v0 = acc[ai][bj][m][0] * g0, v1 = acc[ai][bj][m][1] * g1;
                    bfraw* tp = (bfraw*)EC_TMP + (size_t)row * 1024 + col8;
                    float* t2 = (float*)(c.ws + WS_PART) + (size_t)row * 1024 + col8;
                    if (pair && br == 2) { *(f32x4*)t2 = v0; *(f32x4*)(t2 + 4) = v1; }
                    else {
                        if (br != 0) { const u32x4 tw = *(const u32x4*)tp;
                            v0[0] += __builtin_bit_cast(float, tw.x << 16); v0[1] += __builtin_bit_cast(float, tw.x & 0xffff0000u); v0[2] += __builtin_bit_cast(float, tw.y << 16); v0[3] += __builtin_bit_cast(float, tw.y & 0xffff0000u);
                            v1[0] += __builtin_bit_cast(float, tw.z << 16); v1[1] += __builtin_bit_cast(float, tw.z & 0xffff0000u); v1[2] += __builtin_bit_cast(float, tw.w << 16); v1[3] += __builtin_bit_cast(float, tw.w & 0xffff0000u); }
                        if (last && pair) { v0 += *(const f32x4*)t2; v1 += *(const f32x4*)(t2 + 4); }
                        u32x4 w; w.x = pk2(v0[0], v0[1]); w.y = pk2(v0[2], v0[3]); w.z = pk2(v1[0], v1[1]); w.w = pk2(v1[2], v1[3]);
                        if (last) *(u32x4*)(EC_HB + (size_t)row * 1024 + col8) = w; else *(u32x4*)tp = w;
                    }
                }
            }
        if (pair && br == 2) {
            asm volatile("s_waitcnt vmcnt(0)" ::: "memory");
            if (fr + 16 * fq == 0) __hip_atomic_store(flag, epoch, __ATOMIC_RELAXED, __HIP_MEMORY_SCOPE_AGENT);
        }
    }
};
struct QuarterOrder {
    int c;
    __device__ bool next(int i, Unit& u) const { if (i > 0 || c >= 64) return false; u.pm = 4 * (c & 7) + (c >> 4); u.pn = 24; return true; }
    __device__ __forceinline__ void a_ready(const Unit&) const {}
    __device__ __forceinline__ void done(const Unit&) const {}
};
struct BranchOrder {
    int c, role, pair;
    __device__ bool next(int i, Unit& u) const {
        if (c >= 128) return false;
        int br = i;
        if (pair) { if (role == 0) { if (i >= 2) return false; } else { if (i >= 1) return false; br = 2; } }
        else if (i >= 3) return false;
        const int x = c & 7, j = c >> 3; u.pm = br * 32 + 4 * x + (j >> 2); u.pn = br * 4 + (j & 3); return true;
    }
    __device__ __forceinline__ void a_ready(const Unit&) const {}
    __device__ __forceinline__ void done(const Unit&) const {}
};

struct EpiRes {
    static constexpr bool PERM = false, AFTER_DRAIN = true;
    EpiCtx c; int goff; int part;
    __device__ __forceinline__ void fused(f32x4 (&acc)[2][2][4][2], const Unit& u, int wr, int wc, int fr_, int fq_, PG8_LAS unsigned char* lds, int wid, int lane_) const {
        int fr = fr_, fq = fq_, lane = lane_; asm volatile("" : "+v"(fr), "+v"(fq), "+v"(lane));
        const int pm = u.pm, pn = u.pn;
        const int cond = pm < 16 ? 0 : 1 + ((pm - 16) >> 3);
        const float* gp = EC_mod + (size_t)(c.l * 3 + cond) * 6144 + goff + pn * 256;
        float* const dst = c.out + O_X + (size_t)(pm * 256) * 1024 + pn * 256 + 4 * lane;
        bfraw* const dstp = (bfraw*)(c.ws + WS_PART) + (part == 2 ? (size_t)NTOK * 1024 : 0) + (size_t)(pm * 256) * 1024 + pn * 256 + 4 * lane;
        PG8_LAS float* const lf = (PG8_LAS float*)lds;
#pragma unroll
        for (int ai = 0; ai < 2; ++ai) {
#pragma unroll
            for (int bj = 0; bj < 2; ++bj)
#pragma unroll
                for (int n = 0; n < 2; ++n) {
                    const int col = bj * 128 + wc * 32 + 16 * n + 4 * fq;
                    const f32x4 gv = *(const f32x4*)(gp + col);
#pragma unroll
                    for (int m = 0; m < 4; ++m) *(PG8_LAS f32x4*)(lf + (wr * 64 + m * 16 + fr) * 260 + col) = gv * acc[ai][bj][m][n];
                }
            asm volatile("s_waitcnt lgkmcnt(0)" ::: "memory"); __builtin_amdgcn_s_barrier(); asm volatile("" ::: "memory");
#pragma unroll 4
            for (int r = 0; r < 16; ++r) {
                const int rl = wid * 16 + r;
                const f32x4 v = *(const PG8_LAS f32x4*)(lf + rl * 260 + 4 * lane);
                float* xp = dst + (size_t)(ai * 128 + rl) * 1024;
                if (part) st_bf4(dstp + (size_t)(ai * 128 + rl) * 1024, v); else *(f32x4*)xp = *(const f32x4*)xp + v;
            }
            asm volatile("s_waitcnt lgkmcnt(0)" ::: "memory"); __builtin_amdgcn_s_barrier(); asm volatile("" ::: "memory");
        }
    }
};

struct EpiRelu2 {
    static constexpr bool PERM = true, AFTER_DRAIN = false;
    EpiCtx c;
    __device__ __forceinline__ void operator()(const f32x4 (&acc)[2][2][4][2], const Unit& u, int wr, int wc, int fr_, int fq_) const {
        int fr = fr_, fq = fq_; asm volatile("" : "+v"(fr), "+v"(fq));
#pragma unroll
        for (int ai = 0; ai < 2; ++ai)
#pragma unroll
            for (int m = 0; m < 4; ++m) {
                const int row = u.pm * 256 + ai * 128 + wr * 64 + m * 16 + fr;
#pragma unroll
                for (int bj = 0; bj < 2; ++bj) {
                    f32x4 v0 = acc[ai][bj][m][0], v1 = acc[ai][bj][m][1];
#pragma unroll
                    for (int j = 0; j < 4; ++j) { v0[j] = __builtin_fmaxf(v0[j], 0.f); v1[j] = __builtin_fmaxf(v1[j], 0.f); }
                    v0 = v0 * v0; v1 = v1 * v1;
                    u32x4 w; w.x = pk2(v0[0], v0[1]); w.y = pk2(v0[2], v0[3]); w.z = pk2(v1[0], v1[1]); w.w = pk2(v1[2], v1[3]);
                    *(u32x4*)(EC_HID + (size_t)row * 4096 + u.pn * 256 + bj * 128 + wc * 32 + 8 * fq) = w;
                }
            }
    }
};
template <class Epi, class Sched, bool ALIGN_EPI = false, bool SP2 = false>
__device__ __forceinline__ void gemm_phase(PG8_LAS unsigned char* lds, const Gemm g, const Sched& S, const Epi& E) {
    int tid_ = threadIdx.x; asm volatile("" : "+v"(tid_));
    const int tid = tid_, wid = __builtin_amdgcn_readfirstlane(tid >> 6), lane = tid & 63, wr = wid >> 2, wc = wid & 3, fr = lane & 15, fq = lane >> 4;
    const int K = g.K, nt = g.Kloop / BK, bjs = g.bjsel;
    unsigned voffA[2], voffB[2];
#pragma unroll
    for (int i = 0; i < 2; ++i) { int R, C; stage_rc(tid * 16 + i * 8192, R, C); const int Rb = Epi::PERM ? ((R & ~31) + perm32(R & 31)) : R;
        voffA[i] = (unsigned)(R * K + C) * 2u; voffB[i] = (unsigned)(Rb * K + C) * 2u; }
    const size_t kstep = (size_t)(BK * 2);
    const size_t hstep = (size_t)HALF * K * 2;
    const size_t tstep = 2 * hstep;
    const unsigned ldsw = (unsigned)wid * 1024u;
    const int aoff = lds_byte(wr * 64 + fr, fq * 8), boff = lds_byte(wc * 32 + fr, fq * 8);
#define PG8_SA(b, h) (((b) * 2 + (h)) * HTB)
#define PG8_SB(b, h) ((4 + (b) * 2 + (h)) * HTB)
#define PG8_STAGE(bufoff, gbase, voff) do { _Pragma("unroll") for (int _i = 0; _i < 2; ++_i) \
        __builtin_amdgcn_global_load_lds((const unsigned*)((const char*)(gbase) + (voff)[_i]), (PG8_LAS unsigned*)(lds + (bufoff) + ldsw + _i * 8192), 16, 0, 0); } while (0)
#define PG8_LDA(dst, b, h) do { _Pragma("unroll") for (int m = 0; m < 4; ++m) _Pragma("unroll") for (int k = 0; k < 2; ++k) dst[m][k] = *(const PG8_LAS bf16x8*)(lds + PG8_SA(b, h) + aoff + m * 2048 + k * 1024); } while (0)
#define PG8_LDB(dst, b, h) do { _Pragma("unroll") for (int n = 0; n < 2; ++n) _Pragma("unroll") for (int k = 0; k < 2; ++k) dst[n][k] = *(const PG8_LAS bf16x8*)(lds + PG8_SB(b, h) + boff + n * 2048 + k * 1024); } while (0)
#define PG8_MMA(ai, bj, At, Bt) do { __builtin_amdgcn_s_setprio(1); _Pragma("unroll") for (int m = 0; m < 4; ++m) _Pragma("unroll") for (int n = 0; n < 2; ++n) _Pragma("unroll") for (int k = 0; k < 2; ++k) \
        acc[ai][bj][m][n] = __builtin_amdgcn_mfma_f32_16x16x32_bf16(Bt[n][k], At[m][k], acc[ai][bj][m][n], 0, 0, 0); __builtin_amdgcn_s_setprio(0); } while (0)
#define PG8_WAIT_V(n) asm volatile("s_waitcnt vmcnt(" #n ")" ::: "memory")
#define PG8_WAIT_L(n) asm volatile("s_waitcnt lgkmcnt(" #n ")" ::: "memory")
#define PG8_BAR __builtin_amdgcn_s_barrier()
#define PG8_SCHED __builtin_amdgcn_sched_barrier(0)
    Unit cur, nxt; int ui = 0;
    if (!S.next(0, cur)) return;
    f32x4 acc[2][2][4][2];
#pragma unroll
    for (int a = 0; a < 2; ++a)
#pragma unroll
        for (int b = 0; b < 2; ++b)
#pragma unroll
            for (int m = 0; m < 4; ++m)
#pragma unroll
                for (int n = 0; n < 2; ++n) acc[a][b][m][n] = (f32x4){0.f, 0.f, 0.f, 0.f};
    bf16x8 At[4][2], B0[2][2], B1[2][2];
    const char* cA = (const char*)g.A + (size_t)cur.pm * tstep; const char* cB = (const char*)g.Bt + (size_t)cur.pn * tstep;
    S.a_ready(cur);
    if constexpr (SP2) {
        PG8_STAGE(PG8_SB(0, 0), cB, voffB); PG8_STAGE(PG8_SB(0, 1), cB + hstep, voffB); PG8_STAGE(PG8_SA(0, 0), cA, voffA); PG8_STAGE(PG8_SA(0, 1), cA + hstep, voffA);
        if (wr == 1) PG8_BAR;
        PG8_WAIT_V(2); PG8_BAR;
        PG8_STAGE(PG8_SB(1, 0), cB + kstep, voffB); PG8_STAGE(PG8_SA(1, 0), cA + kstep, voffA); PG8_STAGE(PG8_SB(1, 1), cB + hstep + kstep, voffB);
        PG8_WAIT_V(6); PG8_BAR;
    } else {
        PG8_STAGE(PG8_SB(0, 0), cB, voffB); PG8_STAGE(PG8_SA(0, 0), cA, voffA); PG8_STAGE(PG8_SB(0, 1), cB + hstep, voffB); PG8_STAGE(PG8_SA(0, 1), cA + hstep, voffA);
        if (wr == 1) PG8_BAR;
        PG8_WAIT_V(4); PG8_BAR;
        PG8_STAGE(PG8_SB(1, 0), cB + kstep, voffB); PG8_STAGE(PG8_SA(1, 0), cA + kstep, voffA); PG8_STAGE(PG8_SB(1, 1), cB + hstep + kstep, voffB);
        PG8_WAIT_V(6); PG8_BAR;
    }
    for (;;) {
        const bool has_next = S.next(ui + 1, nxt);
        const char* nA = has_next ? (const char*)g.A + (size_t)nxt.pm * tstep : cA; const char* nB = has_next ? (const char*)g.Bt + (size_t)nxt.pn * tstep : cB;
        for (int t = 0; t < nt; t += 2) {
            const bool last = (t == nt - 2);
            const char* a1 = cA + (size_t)(t + 1) * kstep;
            const char* a2 = last ? nA : cA + (size_t)(t + 2) * kstep; const char* b2 = last ? nB : cB + (size_t)(t + 2) * kstep;
            const char* a3 = a2 + kstep; const char* b3 = b2 + kstep;
            if (last && has_next) S.a_ready(nxt);
            if constexpr (SP2) {
            PG8_LDB(B0, 0, 0); PG8_LDB(B1, 0, 1); PG8_SCHED; PG8_LDA(At, 0, 0); PG8_STAGE(PG8_SA(1, 1), a1 + hstep, voffA);
            PG8_WAIT_V(8); PG8_WAIT_L(0); PG8_BAR; if (bjs != 1) PG8_MMA(0, 0, At, B0); if (bjs != 0) PG8_MMA(0, 1, At, B1); PG8_BAR; PG8_SCHED;
            PG8_LDA(At, 0, 1); PG8_STAGE(PG8_SB(0, 0), b2, voffB); PG8_STAGE(PG8_SB(0, 1), b2 + hstep, voffB); PG8_STAGE(PG8_SA(0, 0), a2, voffA);
            PG8_WAIT_V(8); PG8_WAIT_L(0); PG8_BAR; if (bjs != 1) PG8_MMA(1, 0, At, B0); if (bjs != 0) PG8_MMA(1, 1, At, B1); PG8_BAR; PG8_SCHED;
            PG8_LDB(B0, 1, 0); PG8_LDB(B1, 1, 1); PG8_SCHED; PG8_LDA(At, 1, 0); PG8_STAGE(PG8_SA(0, 1), a2 + hstep, voffA);
            PG8_WAIT_V(8); PG8_WAIT_L(0); PG8_BAR; if (bjs != 1) PG8_MMA(0, 0, At, B0); if (bjs != 0) PG8_MMA(0, 1, At, B1); PG8_BAR; PG8_SCHED;
            PG8_LDA(At, 1, 1); PG8_STAGE(PG8_SB(1, 0), b3, voffB); PG8_STAGE(PG8_SB(1, 1), b3 + hstep, voffB); PG8_STAGE(PG8_SA(1, 0), a3, voffA);
            PG8_WAIT_V(8); PG8_WAIT_L(0); PG8_BAR; if (bjs != 1) PG8_MMA(1, 0, At, B0); if (bjs != 0) PG8_MMA(1, 1, At, B1); PG8_BAR; PG8_SCHED;
            } else {
            PG8_LDB(B0, 0, 0); PG8_SCHED; PG8_LDA(At, 0, 0); PG8_STAGE(PG8_SA(1, 1), a1 + hstep, voffA);
            PG8_WAIT_L(8); PG8_BAR; PG8_WAIT_L(0); PG8_MMA(0, 0, At, B0); PG8_BAR; PG8_SCHED;
            PG8_LDB(B1, 0, 1); PG8_STAGE(PG8_SB(0, 0), b2, voffB);
            PG8_BAR; PG8_WAIT_L(0); PG8_MMA(0, 1, At, B1); PG8_BAR;
            PG8_LDA(At, 0, 1); PG8_STAGE(PG8_SA(0, 0), a2, voffA);
            PG8_BAR; PG8_WAIT_L(0); PG8_MMA(1, 0, At, B0); PG8_BAR; PG8_SCHED;
            PG8_STAGE(PG8_SB(0, 1), b2 + hstep, voffB);
            PG8_WAIT_V(6); PG8_BAR; PG8_MMA(1, 1, At, B1); PG8_BAR;
            PG8_LDB(B0, 1, 0); PG8_SCHED; PG8_LDA(At, 1, 0); PG8_STAGE(PG8_SA(0, 1), a2 + hstep, voffA);
            PG8_WAIT_L(8); PG8_BAR; PG8_WAIT_L(0); PG8_MMA(0, 0, At, B0); PG8_BAR; PG8_SCHED;
            PG8_LDB(B1, 1, 1); PG8_STAGE(PG8_SB(1, 0), b3, voffB);
            PG8_BAR; PG8_WAIT_L(0); PG8_MMA(0, 1, At, B1); PG8_BAR;
            PG8_LDA(At, 1, 1); PG8_STAGE(PG8_SA(1, 0), a3, voffA);
            PG8_BAR; PG8_WAIT_L(0); PG8_MMA(1, 0, At, B0); PG8_BAR; PG8_SCHED;
            PG8_STAGE(PG8_SB(1, 1), b3 + hstep, voffB);
            PG8_WAIT_V(6); PG8_BAR; PG8_MMA(1, 1, At, B1); PG8_BAR;
            }
        }
        if constexpr (ALIGN_EPI) { if (wr == 0) PG8_BAR; }
        if constexpr (!Epi::AFTER_DRAIN) { E(acc, cur, wr, wc, fr, fq); S.done(cur); }
        if (!has_next) break;
#pragma unroll
        for (int a = 0; a < 2; ++a)
#pragma unroll
            for (int b = 0; b < 2; ++b)
#pragma unroll
                for (int m = 0; m < 4; ++m)
#pragma unroll
                    for (int n = 0; n < 2; ++n) acc[a][b][m][n] = (f32x4){0.f, 0.f, 0.f, 0.f};
        cur = nxt; cA = nA; cB = nB; ++ui;
        if constexpr (ALIGN_EPI) { if (wr == 1) PG8_BAR; }
    }
    PG8_WAIT_V(0);
    if constexpr (!ALIGN_EPI) { if (wr == 0) PG8_BAR; }
    PG8_BAR;
    if constexpr (Epi::AFTER_DRAIN) { E.fused(acc, cur, wr, wc, fr, fq, lds, wid, lane); S.done(cur); }
#undef PG8_SA
#undef PG8_SB
#undef PG8_STAGE
#undef PG8_LDA
#undef PG8_LDB
#undef PG8_MMA
#undef PG8_WAIT_V
#undef PG8_WAIT_L
#undef PG8_BAR
#undef PG8_SCHED
}
}
#ifndef REP_P0
#define REP_P0 1
#endif
#ifndef REP_PA
#define REP_PA 1
#endif
#ifndef REP_ATT
#define REP_ATT 1
#endif
#ifndef REP_CONV
#define REP_CONV 1
#endif
#ifndef REP_C1
#define REP_C1 1
#endif
#ifndef REP_C2
#define REP_C2 1
#endif
#ifndef REP_M1
#define REP_M1 1
#endif
#ifndef REP_M2
#define REP_M2 1
#endif
#ifndef REP_SYNC
#define REP_SYNC 0
#endif

struct KArgs { const float* in[31]; float* out; unsigned char* ws; };
#define XB_TMO      128
#define XB_XCNT(j)  (256  + 64 * (j))
#define XB_XSUB(j)  (1280 + 64 * (j))
#define XB_XGEN(j)  (2304 + 64 * (j))
#define XB_TOP      3328
#define XB_TOPGEN   3392
#define XCD_BAR_WORDS 3456
#define XB_SPIN_CAP (1u << 18)

__device__ __forceinline__ unsigned xb_ld(unsigned* p)              { return __hip_atomic_load(p, __ATOMIC_RELAXED, __HIP_MEMORY_SCOPE_AGENT); }
__device__ __forceinline__ unsigned xb_add(unsigned* p, unsigned v) { return __hip_atomic_fetch_add(p, v, __ATOMIC_RELAXED, __HIP_MEMORY_SCOPE_AGENT); }
__device__ __forceinline__ unsigned xb_xcc_id() { return (unsigned)__builtin_amdgcn_s_getreg((3 << 11) | 20) & 0xFu; }
#define XB_SPIN(cond, bar) do { unsigned _sp = 0; while (cond) { __builtin_amdgcn_s_sleep(1); \
    if ((++_sp & 255u) == 0u) { if (xb_ld(&(bar)[XB_TMO])) break; if (_sp > XB_SPIN_CAP) { atomicAdd(&(bar)[XB_TMO], 1u); break; } } } } while (0)

struct XcdBarrier {
    unsigned* bar; unsigned x;
    volatile LAS unsigned* st;
};

__device__ __forceinline__ XcdBarrier xcd_barrier_post(unsigned* bar, volatile LAS unsigned* st) {
    XcdBarrier b; b.bar = bar; b.x = xb_xcc_id(); b.st = st;
    if (threadIdx.x == 0) st[2] = xb_add(&bar[XB_XCNT(b.x)], 1u);
    return b;
}
__device__ __forceinline__ void xcd_barrier_complete(unsigned* bar, unsigned x, unsigned& nloc, unsigned& nx) {
    const unsigned G = gridDim.x * gridDim.y * gridDim.z;
    unsigned sum, cnt, mine, sp = 0u;
    for (;;) {
        sum = 0u; cnt = 0u; mine = 0u;
#pragma unroll
        for (unsigned j = 0; j < 16; ++j) { const unsigned c = xb_ld(&bar[XB_XCNT(j)]); sum += c; cnt += (c > 0u) ? 1u : 0u; mine = (j == x) ? c : mine; }
        if (sum == G) break;
        __builtin_amdgcn_s_sleep(1);
        if ((++sp & 255u) == 0u) { if (xb_ld(&bar[XB_TMO])) break; if (sp > XB_SPIN_CAP) { atomicAdd(&bar[XB_TMO], 1u); break; } }
    }
    nloc = mine > 0u ? mine : 1u; nx = cnt > 0u ? cnt : 1u;
}

__device__ __forceinline__ void xcd_barrier(const XcdBarrier& b) {
    asm volatile("s_waitcnt vmcnt(0)" ::: "memory");
    __syncthreads();
    if (threadIdx.x == 0) {
        unsigned* bar = b.bar;
        __builtin_amdgcn_s_waitcnt(0);
        unsigned nloc = b.st[0], nx = b.st[1];
        if (nloc == 0u) { xcd_barrier_complete(bar, b.x, nloc, nx); b.st[0] = nloc; b.st[1] = nx;
            unsigned uni = (nx == 8u && gridDim.x == 256u) ? 1u : 0u;
#pragma unroll
            for (unsigned j = 0; j < 16; ++j) { const unsigned cj = xb_ld(&bar[XB_XCNT(j)]); if (cj != (j < 8u ? 32u : 0u)) uni = 0u; }
            b.st[3] = uni; }
        const unsigned old = xb_add(&bar[XB_XSUB(b.x)], 1u);
        const unsigned gen = old / nloc;
        if (old + 1u == (gen + 1u) * nloc) {
            __builtin_amdgcn_fence(__ATOMIC_RELEASE, "agent");
            asm volatile("s_waitcnt vmcnt(0)" ::: "memory");
            const unsigned og = xb_add(&bar[XB_TOP], 1u);
            const unsigned tg = og / nx;
            if (og + 1u == (tg + 1u) * nx) xb_add(&bar[XB_TOPGEN], 1u);
            else XB_SPIN(xb_ld(&bar[XB_TOPGEN]) == tg, bar);
            __builtin_amdgcn_fence(__ATOMIC_ACQUIRE, "agent");
            xb_add(&bar[XB_XGEN(b.x)], 1u);
            asm volatile("s_waitcnt vmcnt(0)" ::: "memory");
        } else {
            XB_SPIN(xb_ld(&bar[XB_XGEN(b.x)]) == gen, bar);
            __builtin_amdgcn_fence(__ATOMIC_ACQUIRE, "agent");
            asm volatile("s_waitcnt vmcnt(0)" ::: "memory");
        }
    }
    __syncthreads();
}


__device__ __forceinline__ float wave_sum(float v) {
#pragma unroll
    for (int o = 1; o < 64; o <<= 1) v += __shfl_xor(v, o);
    return v;
}

#define XB_LSUB(j)  (3456 + 64 * (j))
#define XB_LGEN(j)  (4480 + 64 * (j))
__device__ __forceinline__ void xcc_local_barrier(const XcdBarrier& b) {
    asm volatile("s_waitcnt vmcnt(0)" ::: "memory");
    __syncthreads();
    if (threadIdx.x == 0) {
        unsigned* bar = b.bar;
        const unsigned old = xb_add(&bar[XB_LSUB(b.x)], 1u), gen = old / 32u;
        if (old + 1u == (gen + 1u) * 32u) xb_add(&bar[XB_LGEN(b.x)], 1u);
        else XB_SPIN(xb_ld(&bar[XB_LGEN(b.x)]) == gen, bar);
        __builtin_amdgcn_fence(__ATOMIC_ACQUIRE, "agent");
        asm volatile("s_waitcnt vmcnt(0)" ::: "memory");
    }
    __syncthreads();
}

__device__ __forceinline__ void transpose_item(const float* W, int K, int N, bfraw* WT, int vrow0, int n0, int k0, LAS float* scr, int lane) {
#pragma unroll 8
    for (int i = 0; i < 32; ++i) { const int kk = 2 * i + (lane >> 5); scr[kk * 33 + (lane & 31)] = W[(size_t)(k0 + kk) * N + n0 + (lane & 31)]; }
    asm volatile("s_waitcnt lgkmcnt(0)" ::: "memory");
    const int cch = lane & 7;
#pragma unroll
    for (int j = 0; j < 4; ++j) { const int n = (lane >> 3) + 8 * j; const LAS float* s = scr + (8 * cch) * 33 + n;
        u32x4_t o; o.x = pk2(s[0 * 33], s[1 * 33]); o.y = pk2(s[2 * 33], s[3 * 33]); o.z = pk2(s[4 * 33], s[5 * 33]); o.w = pk2(s[6 * 33], s[7 * 33]);
        *(u32x4_t*)(WT + (size_t)(vrow0 + n) * K + k0 + 8 * cch) = o; }
    asm volatile("s_waitcnt lgkmcnt(0)" ::: "memory");
}
__device__ __forceinline__ int vcol_map(int vb) {
    const int tile = vb >> 3, sub = vb & 7, bj = sub >> 2, wc = sub & 3;
    if (tile < 6 || tile >= 13) return vb * 32;
    if (tile < 8) return 1536 + (4 * (tile - 6) + wc) * 64 + 32 * bj;
    if (tile == 8) return 2048 + wc * 64 + 32 * bj;
    return (bj ? 2816 : 2304) + 128 * (tile - 9) + 32 * wc;
}
__device__ __forceinline__ void sincos_small(float x, float& s, float& c) {
    const float k = __builtin_rintf(x * 0.15915494309189535f);
    float r = __builtin_fmaf(-k, 6.2831854820251465f, x); r = __builtin_fmaf(-k, -1.7484555e-07f, r);
    const float y = r * 0.25f, y2 = y * y;
    float sp = __builtin_fmaf(y2, 2.7557319e-06f, -1.9841270e-04f); sp = __builtin_fmaf(sp, y2, 8.3333333e-03f); sp = __builtin_fmaf(sp, y2, -1.6666667e-01f); sp = __builtin_fmaf(sp * y2, y, y);
    float cp = __builtin_fmaf(y2, -2.7557319e-07f, 2.4801587e-05f); cp = __builtin_fmaf(cp, y2, -1.3888889e-03f); cp = __builtin_fmaf(cp, y2, 4.1666667e-02f); cp = __builtin_fmaf(cp, y2, -0.5f); cp = __builtin_fmaf(cp, y2, 1.0f);
    const float s2 = 2.f * sp * cp, c2 = cp * cp - sp * sp;
    s = 2.f * s2 * c2; c = c2 * c2 - s2 * s2;
}
__device__ __forceinline__ void modnorm_row(const float* xrow, const float* addrow, float* xcopy, bfraw* orow, const float* nw, const float* shift, const float* scale, int lane) {
    const f32x4_t* xr = (const f32x4_t*)xrow + lane;
    f32x4_t v[4]; float s = 0.f;
#pragma unroll
    for (int j = 0; j < 4; ++j) { v[j] = xr[64 * j]; if (addrow) v[j] += ((const f32x4_t*)addrow + lane)[64 * j]; s += dot4(v[j]); }
    const float r = __builtin_amdgcn_rsqf(wave_sum(s) * (1.0f / DM) + NEPS);
#pragma unroll
    for (int j = 0; j < 4; ++j) {
        const int cidx = 4 * lane + 256 * j;
        if (xcopy) *((f32x4_t*)xcopy + lane + 64 * j) = v[j];
        const f32x4_t w = *(const f32x4_t*)(nw + cidx), sh = *(const f32x4_t*)(shift + cidx), sc = *(const f32x4_t*)(scale + cidx);
        const f32x4_t h = v[j] * r * w * (1.0f + sc) + sh;
        st_bf4(orow + cidx, h);
    }
}
__device__ __forceinline__ void finalnorm_row(float* xrow, const float* addrow, const float* nw, int lane) {
    f32x4_t* xr = (f32x4_t*)xrow + lane;
    f32x4_t v[4]; float s = 0.f;
#pragma unroll
    for (int j = 0; j < 4; ++j) { v[j] = xr[64 * j]; if (addrow) v[j] += ((const f32x4_t*)addrow + lane)[64 * j]; s += dot4(v[j]); }
    const float r = __builtin_amdgcn_rsqf(wave_sum(s) * (1.0f / DM) + NEPS);
#pragma unroll
    for (int j = 0; j < 4; ++j) { const f32x4_t w = *(const f32x4_t*)(nw + 4 * lane + 256 * j); xr[64 * j] = v[j] * r * w; }
}

template <bool FINAL>
__device__ __forceinline__ void norm_rows4(int m0, int stride, const float* in_ctx, const float* in_lat, float* X, const float* PARTX, bfraw* HB,
                                           const float* nw, const float* modl, int sh_off, int sc_off, int lane) {
    f32x4_t v[4][4];
#pragma unroll
    for (int r = 0; r < 4; ++r) {
        const int m = m0 + r * stride; if (m >= NTOK) break;
        const float* src = in_ctx ? (m < NCTX ? in_ctx + (size_t)m * DM : in_lat + (size_t)(m - NCTX) * DM) : X + (size_t)m * DM;
#pragma unroll
        for (int j = 0; j < 4; ++j) v[r][j] = ((const f32x4_t*)src + lane)[64 * j];
    }
    if (PARTX) {
        u32x2_t pv[4][4], pw[4][4];
#pragma unroll
        for (int r = 0; r < 4; ++r) { const int m = m0 + r * stride; if (m >= NTOK) break;
#pragma unroll
            for (int j = 0; j < 4; ++j) { pv[r][j] = ((const u32x2_t*)((const bfraw*)PARTX + (size_t)m * DM) + lane)[64 * j]; pw[r][j] = ((const u32x2_t*)((const bfraw*)PARTX + (size_t)(NTOK + m) * DM) + lane)[64 * j]; } }
#pragma unroll
        for (int r = 0; r < 4; ++r) { const int m = m0 + r * stride; if (m >= NTOK) break;
#pragma unroll
            for (int j = 0; j < 4; ++j) { const u32x2_t q = pv[r][j], q2 = pw[r][j];
                v[r][j][0] += __builtin_bit_cast(float, q.x << 16) + __builtin_bit_cast(float, q2.x << 16); v[r][j][1] += __builtin_bit_cast(float, q.x & 0xffff0000u) + __builtin_bit_cast(float, q2.x & 0xffff0000u);
                v[r][j][2] += __builtin_bit_cast(float, q.y << 16) + __builtin_bit_cast(float, q2.y << 16); v[r][j][3] += __builtin_bit_cast(float, q.y & 0xffff0000u) + __builtin_bit_cast(float, q2.y & 0xffff0000u); } }
    }
#pragma unroll
    for (int r = 0; r < 4; ++r) {
        const int m = m0 + r * stride; if (m >= NTOK) break;
        float s = 0.f;
#pragma unroll
        for (int j = 0; j < 4; ++j) s += dot4(v[r][j]);
        const float rr = __builtin_amdgcn_rsqf(wave_sum(s) * (1.0f / DM) + NEPS);
        const int cond = m < NCTX ? 0 : 1 + ((m - NCTX) >> 11);
        const float* md = modl + (size_t)cond * 6144;
#pragma unroll
        for (int j = 0; j < 4; ++j) {
            const int cidx = 4 * lane + 256 * j;
            const f32x4_t w = *(const f32x4_t*)(nw + cidx);
            if (FINAL) { ((f32x4_t*)(X + (size_t)m * DM) + lane)[64 * j] = v[r][j] * rr * w; }
            else {
                if (in_ctx || PARTX) ((f32x4_t*)(X + (size_t)m * DM) + lane)[64 * j] = v[r][j];
                const f32x4_t sh = *(const f32x4_t*)(md + sh_off + cidx), sc = *(const f32x4_t*)(md + sc_off + cidx);
                st_bf4(HB + (size_t)m * DM + cidx, v[r][j] * rr * w * (1.0f + sc) + sh);
            }
        }
    }
}

struct AttnArgs {
    const bfraw* Q; int qcol0, qcol1;
    const bfraw* Kown; const bfraw* Kc; int kstride;
    int nOwn, nTot;
    const bfraw* Vown; int vsOwn; const bfraw* Vc; int vsC;
    bfraw* O; int ocol0, ocol1;
    float lam, postscale; const float* subln;
};
constexpr int ATT_VOFF = 17408, ATT_BUF = 36864, ATT_XOFF = 0;
template <int KROWB, bool QLDS>
__device__ __forceinline__ void att_s(const LAS unsigned char* cur, int koff, const s16x8_t (&qf)[4], const LAS s16x8_t* qlds, const f32x16_t& negm, f32x16_t& p0, f32x16_t& p1) {
#pragma unroll
    for (int d0 = 0; d0 < 4; ++d0) {
        const s16x8_t k0 = *(const LAS s16x8_t*)(cur + koff + d0 * 32);
        const s16x8_t k1 = *(const LAS s16x8_t*)(cur + koff + 32 * KROWB + d0 * 32);
        const s16x8_t q = QLDS ? qlds[d0 * 512] : qf[d0];
        if (d0 == 0) { p0 = __builtin_amdgcn_mfma_f32_32x32x16_bf16(k0, q, negm, 0, 0, 0); p1 = __builtin_amdgcn_mfma_f32_32x32x16_bf16(k1, q, negm, 0, 0, 0); }
        else { p0 = __builtin_amdgcn_mfma_f32_32x32x16_bf16(k0, q, p0, 0, 0, 0); p1 = __builtin_amdgcn_mfma_f32_32x32x16_bf16(k1, q, p1, 0, 0, 0); }
    }
}
__device__ __forceinline__ float vmax3(float a, float b, float c) { float r; asm("v_max3_f32 %0, %1, %2, %3" : "=v"(r) : "v"(a), "v"(b), "v"(c)); return r; }
template <bool FIRST>
__device__ __forceinline__ float att_softmax(f32x16_t& p0, f32x16_t& p1, float& m_run, float& l_run, f32x16_t& negm, u32x4_t (&pf)[4]) {
    asm volatile("s_nop 15\n\ts_nop 7" : "+v"(p0), "+v"(p1));
    float mx = vmax3(p0[0], p0[1], p1[0]);
    mx = vmax3(mx, p1[1], p0[2]);
#pragma unroll
    for (int r = 2; r < 16; r += 2) { if (r > 2) mx = vmax3(mx, p0[r], p1[r]); else mx = vmax3(mx, p1[2], p1[2]); mx = vmax3(mx, p0[r + 1], p1[r + 1]); }
    mx = __builtin_fmaxf(mx, __shfl_xor(mx, 32));
    float alpha = 1.0f;
    if (FIRST || __any(mx > 0.f)) {
        const float dl = FIRST ? mx : __builtin_fmaxf(mx, 0.f);
        m_run += dl; alpha = __builtin_amdgcn_exp2f(-dl);
#pragma unroll
        for (int r = 0; r < 16; ++r) { p0[r] -= dl; p1[r] -= dl; negm[r] = -m_run; }
    }
    float rs = 0.f;
#pragma unroll
    for (int r = 0; r < 16; ++r) { p0[r] = __builtin_amdgcn_exp2f(p0[r]); p1[r] = __builtin_amdgcn_exp2f(p1[r]); rs += p0[r] + p1[r]; }
    l_run = FIRST ? rs : l_run * alpha + rs;
#pragma unroll
    for (int s2 = 0; s2 < 2; ++s2) {
        pf[s2].x = pk2(p0[8 * s2 + 0], p0[8 * s2 + 1]); pf[s2].y = pk2(p0[8 * s2 + 2], p0[8 * s2 + 3]); pf[s2].z = pk2(p0[8 * s2 + 4], p0[8 * s2 + 5]); pf[s2].w = pk2(p0[8 * s2 + 6], p0[8 * s2 + 7]);
        pf[2 + s2].x = pk2(p1[8 * s2 + 0], p1[8 * s2 + 1]); pf[2 + s2].y = pk2(p1[8 * s2 + 2], p1[8 * s2 + 3]); pf[2 + s2].z = pk2(p1[8 * s2 + 4], p1[8 * s2 + 5]); pf[2 + s2].w = pk2(p1[8 * s2 + 6], p1[8 * s2 + 7]);
    }
    return alpha;
}
template <int NDB>
__device__ __forceinline__ void att_pv(const LAS unsigned char* vt, int voff, const u32x4_t (&pf)[4], f32x16_t (&o)[NDB]) {
#pragma unroll
    for (int js = 0; js < 4; ++js) {
        const s16x8_t pfr = __builtin_bit_cast(s16x8_t, pf[js]);
#pragma unroll
        for (int db = 0; db < NDB; ++db) {
            const LAS unsigned char* vp = vt + voff + db * (32 * 144) + js * 32;
            const u32x2_t lo = *(const LAS u32x2_t*)vp, hh = *(const LAS u32x2_t*)(vp + 16);
            u32x4_t vw; vw.x = lo.x; vw.y = lo.y; vw.z = hh.x; vw.w = hh.y;
            o[db] = __builtin_amdgcn_mfma_f32_32x32x16_bf16(__builtin_bit_cast(s16x8_t, vw), pfr, o[db], 0, 0, 0);
        }
    }
}
template <int DV, int KROW, bool DIFF>
__device__ __forceinline__ void attn_unit(LAS unsigned char* lds, const AttnArgs& a) {
    constexpr int KROWB = KROW * 2 + 16, NKC = KROW / 64, NVC = DV / 64, NDB = DV / 32, KPR = KROW / 8;
    int tid_ = threadIdx.x; asm volatile("" : "+v"(tid_));
    const int tid = tid_, lane = tid & 63, r32 = lane & 31, hi = lane >> 5;
    const int wid = __builtin_amdgcn_readfirstlane(tid >> 6), g = wid >> 2, wq = wid & 3;
    const int kcol = (KROW == 128) ? g * 64 : 0;
    const int koff = r32 * KROWB + (kcol + hi * 8) * 2;
    const int voff = ATT_VOFF + r32 * 144 + hi * 8;
    constexpr bool QLDS = false;
    s16x8_t qf[4];
    LAS s16x8_t* const qlds = (LAS s16x8_t*)(lds + 3 * ATT_BUF) + tid;
    { const bfraw* qp = a.Q + (size_t)(wq * 32 + r32) * 512 + (g ? a.qcol1 : a.qcol0) + hi * 8;
#pragma unroll
      for (int d0 = 0; d0 < 4; ++d0) { qf[d0] = *(const s16x8_t*)(qp + d0 * 16); if (QLDS) qlds[d0 * 512] = qf[d0]; } }
    f32x16_t o[NDB];
#pragma unroll
    for (int db = 0; db < NDB; ++db)
#pragma unroll
        for (int r = 0; r < 16; ++r) o[db][r] = 0.f;
    float m_run = 0.f, l_run = 0.f;
    f32x16_t negm;
#pragma unroll
    for (int r = 0; r < 16; ++r) negm[r] = 0.f;
    u32x4_t kreg[NKC], vreg[NVC];
#define ATT_GLOAD(tn_) do { const int tn = (tn_); const bool own = tn < a.nOwn; \
            const bfraw* kb = own ? a.Kown + (size_t)tn * 64 * a.kstride : a.Kc + (size_t)(tn - a.nOwn) * 64 * a.kstride; \
            const bfraw* vb = own ? a.Vown + tn * 64 : a.Vc + (tn - a.nOwn) * 64; const int vs = own ? a.vsOwn : a.vsC; \
            _Pragma("unroll") for (int i = 0; i < NKC; ++i) { const int ch = tid + 512 * i, key = ch / KPR, part = ch % KPR; kreg[i] = *(const u32x4_t*)(kb + (size_t)key * a.kstride + part * 8); } \
            _Pragma("unroll") for (int i = 0; i < NVC; ++i) { const int ch = tid + 512 * i, d = ch >> 3, part = ch & 7; vreg[i] = *(const u32x4_t*)(vb + (size_t)d * vs + part * 8); } } while (0)
#define ATT_LSTORE(buf_) do { LAS unsigned char* const nb_ = (buf_); \
            _Pragma("unroll") for (int i = 0; i < NKC; ++i) { const int ch = tid + 512 * i, key = ch / KPR, part = ch % KPR; *(LAS u32x4_t*)(nb_ + key * KROWB + part * 16) = kreg[i]; } \
            _Pragma("unroll") for (int i = 0; i < NVC; ++i) { const int ch = tid + 512 * i, d = ch >> 3, part = ch & 7; *(LAS u32x4_t*)(nb_ + ATT_VOFF + d * 144 + part * 16) = vreg[i]; } } while (0)
    ATT_GLOAD(0);
    ATT_LSTORE(lds);
    __syncthreads();
    ATT_GLOAD(1);
    u32x4_t pf[4];
    {
        f32x16_t p0, p1;
        att_s<KROWB, QLDS>(lds, koff, qf, qlds, negm, p0, p1);
        (void)att_softmax<true>(p0, p1, m_run, l_run, negm, pf);
        ATT_LSTORE(lds + ATT_BUF);
        __syncthreads();
        if (a.nTot > 2) ATT_GLOAD(2);
    }
    int ic = 1, ip = 0, in = 2;
    for (int t = 1; t < a.nTot; ++t) {
        const LAS unsigned char* const cur = lds + ic * ATT_BUF; const LAS unsigned char* const prv = lds + ip * ATT_BUF;
        f32x16_t p0, p1;
        att_s<KROWB, QLDS>(cur, koff, qf, qlds, negm, p0, p1);
        att_pv<NDB>(prv, voff, pf, o);
        u32x4_t pn[4];
        const float alpha = att_softmax<false>(p0, p1, m_run, l_run, negm, pn);
        if (__any(alpha != 1.0f)) {
#pragma unroll
            for (int db = 0; db < NDB; ++db)
#pragma unroll
                for (int r = 0; r < 16; ++r) o[db][r] *= alpha;
        }
#pragma unroll
        for (int i = 0; i < 4; ++i) pf[i] = pn[i];
        if (t + 1 < a.nTot) ATT_LSTORE(lds + in * ATT_BUF);
        __syncthreads();
        if (t + 2 < a.nTot) ATT_GLOAD(t + 2);
        const int tmp = ip; ip = ic; ic = in; in = tmp;
    }
    att_pv<NDB>(lds + ip * ATT_BUF, voff, pf, o);
    __syncthreads();
#undef ATT_GLOAD
#undef ATT_LSTORE
    const float ltot = l_run + __shfl_xor(l_run, 32);
    const float inv = 1.0f / ltot;
    const int qrow = wq * 32 + r32;
    if (DIFF) {
        LAS float* xch = (LAS float*)(lds + ATT_XOFF) + wq * 64 * 64 + lane;
        if (g == 1) {
            const float sc = inv * a.lam;
#pragma unroll
            for (int db = 0; db < NDB; ++db)
#pragma unroll
                for (int r = 0; r < 16; ++r) xch[(db * 16 + r) * 64] = o[db][r] * sc;
        }
        __syncthreads();
        if (g == 0) {
            float ss = 0.f;
#pragma unroll
            for (int db = 0; db < NDB; ++db)
#pragma unroll
                for (int r = 0; r < 16; ++r) { const float v = o[db][r] * inv - xch[(db * 16 + r) * 64]; o[db][r] = v; ss += v * v; }
            ss += __shfl_xor(ss, 32);
            const float rn = __builtin_amdgcn_rsqf(ss * (1.0f / 128.0f) + NEPS) * a.postscale;
            bfraw* op = a.O + (size_t)qrow * 512 + a.ocol0 + 4 * hi;
#pragma unroll
            for (int db = 0; db < NDB; ++db)
#pragma unroll
                for (int rr = 0; rr < 4; ++rr) {
                    const int d = 32 * db + 8 * rr;
                    const f32x4_t w = *(const f32x4_t*)(a.subln + d + 4 * hi);
                    f32x4_t v; v[0] = o[db][4 * rr] * rn * w[0]; v[1] = o[db][4 * rr + 1] * rn * w[1]; v[2] = o[db][4 * rr + 2] * rn * w[2]; v[3] = o[db][4 * rr + 3] * rn * w[3];
                    st_bf4(op + d, v);
                }
        }
    } else {
        bfraw* op = a.O + (size_t)qrow * 512 + (g ? a.ocol1 : a.ocol0) + 4 * hi;
#pragma unroll
        for (int db = 0; db < NDB; ++db)
#pragma unroll
            for (int rr = 0; rr < 4; ++rr) {
                f32x4_t v; v[0] = o[db][4 * rr] * inv; v[1] = o[db][4 * rr + 1] * inv; v[2] = o[db][4 * rr + 2] * inv; v[3] = o[db][4 * rr + 3] * inv;
                st_bf4(op + 32 * db + 8 * rr, v);
            }
    }
    __syncthreads();
}

__device__ __forceinline__ void conv_unit(LAS unsigned char* lds, int unit, const bfraw* U, bfraw* UC, const float* cw, const float* cb, const float* lg, const float* lbeta) {
    int tid_ = threadIdx.x; asm volatile("" : "+v"(tid_));
    const int tid = tid_, lane = tid & 63, wid = tid >> 6, c = tid;
    const int m0 = unit * 32;
    int lo, hi_;
    if (m0 < NCTX) { lo = (m0 / CSEQ) * CSEQ; hi_ = lo + CSEQ; } else { lo = NCTX + ((m0 - NCTX) / LSEQ) * LSEQ; hi_ = lo + LSEQ; }
    LAS bfraw* sin_ = (LAS bfraw*)lds;
    LAS float* sm = (LAS float*)(lds + 65536);
    LAS float* st = (LAS float*)(lds + 131072);
#pragma unroll
    for (int k = 0; k < 8; ++k) {
        const int ch = tid + 512 * k, i = ch >> 6, part = ch & 63; int tok = m0 - 15 + i;
        const bool ok = tok >= lo && tok < hi_ && i < 62;
        tok = tok < lo ? lo : (tok >= hi_ ? hi_ - 1 : tok);
        u32x4_t v = *(const u32x4_t*)(U + (size_t)tok * 512 + part * 8);
        if (!ok) v = (u32x4_t){0u, 0u, 0u, 0u};
        if (i < 62) *(LAS u32x4_t*)(sin_ + i * 512 + part * 8) = v;
    }
    float w[31];
#pragma unroll
    for (int j = 0; j < 31; ++j) w[j] = cw[j * 512 + c];
    const float bias = cb[c];
    __syncthreads();
#pragma unroll 1
    for (int g = 0; g < 4; ++g) {
        float acc[8];
#pragma unroll
        for (int o = 0; o < 8; ++o) acc[o] = bias;
        const LAS bfraw* sp = sin_ + (8 * g) * 512 + c;
#pragma unroll
        for (int i = 0; i < 38; ++i) {
            const float v = bf2f(sp[i * 512]);
#pragma unroll
            for (int o = 0; o < 8; ++o) { const int j = i - o; if (j >= 0 && j < 31) acc[o] += v * w[j]; }
        }
#pragma unroll
        for (int o = 0; o < 8; ++o) sm[(8 * g + o) * 512 + c] = acc[o];
    }
    __syncthreads();
#pragma unroll
    for (int tt = 0; tt < 4; ++tt) {
        const int tok = wid * 4 + tt; float s = 0.f, q = 0.f;
#pragma unroll
        for (int k = 0; k < 8; ++k) { const float x = sm[tok * 512 + lane + 64 * k]; s += x; q += x * x; }
        s = wave_sum(s); q = wave_sum(q);
        const float mu = s * (1.0f / 512.0f), var = __builtin_fmaxf(q * (1.0f / 512.0f) - mu * mu, 0.f);
        if (lane == 0) { st[tok * 2] = mu; st[tok * 2 + 1] = __builtin_amdgcn_rsqf(var + NEPS); }
    }
    __syncthreads();
    const float gg = lg[c], bb = lbeta[c];
#pragma unroll 8
    for (int o = 0; o < 32; ++o) {
        const float y = (sm[o * 512 + c] - st[o * 2]) * st[o * 2 + 1] * gg + bb;
        UC[(size_t)(m0 + o) * 512 + c] = f2bf(y * sigmoidf_(y));
    }
    __syncthreads();
}

template <bool PERMIN>
__device__ __forceinline__ void convert_item(const float* W, int K, int N, bfraw* WT, int vrow0, int n0, int k0, LAS float* scr, int tid) {
    const int lane = tid & 63, wave = tid >> 6;
    float v[16][4];
#pragma unroll
    for (int g4 = 0; g4 < 4; ++g4) {
        const int vc = g4 * 64 + lane;
        const int col = PERMIN ? vcol_map((vrow0 + vc) >> 5) + (vc & 31) : n0 + vc;
#pragma unroll
        for (int r = 0; r < 16; ++r) v[r][g4] = W[(size_t)(k0 + wave * 16 + r) * N + col];
    }
#pragma unroll
    for (int r = 0; r < 16; ++r)
#pragma unroll
        for (int g4 = 0; g4 < 4; ++g4) scr[(wave * 16 + r) * 257 + g4 * 64 + lane] = v[r][g4];
    __syncthreads();
#pragma unroll
    for (int it = 0; it < 8; ++it) {
        const int ch = it * 512 + tid, n = ch >> 4, kc = ch & 15;
        const LAS float* s = scr + (8 * kc) * 257 + n;
        u32x4_t o; o.x = pk2(s[0], s[257]); o.y = pk2(s[2 * 257], s[3 * 257]); o.z = pk2(s[4 * 257], s[5 * 257]); o.w = pk2(s[6 * 257], s[7 * 257]);
        *(u32x4_t*)(WT + (size_t)(vrow0 + n) * K + k0 + 8 * kc) = o;
    }
    __syncthreads();
}
#define CONVERT_RANGE(IT0, ITEND, STEP) { \
        LAS float* scr = (LAS float*)lds; \
        constexpr int I_IN = 8 * 25, I_BR = 3 * 16, I_O = 32, I_1 = 128, I_2 = 128, I_L = I_IN + I_BR + I_O + I_1 + I_2; \
        for (int it = (IT0); it < (ITEND); it += (STEP)) { \
            const int l = it / I_L; int r = it % I_L; \
            if (r < I_IN) { const int kb = r / 25, nt = r % 25; convert_item<true>(a.in[12] + (size_t)l * DM * INW, DM, INW, (bfraw*)(ws + WS_WIN + l * WIN_L), nt * 256, 0, kb * 128, scr, tid); continue; } r -= I_IN; \
            if (r < I_BR) { const int br = r >> 4, rr = r & 15, kb = rr >> 2, nt = rr & 3; const float* W = (br == 0 ? a.in[18] : br == 1 ? a.in[21] : a.in[26]) + (size_t)l * 512 * 1024; \
                convert_item<false>(W, 512, 1024, (bfraw*)(ws + WS_WBR + l * WBR_L) + (size_t)br * 1024 * 512, nt * 256, nt * 256, kb * 128, scr, tid); continue; } r -= I_BR; \
            if (r < I_O) { const int kb = r >> 2, nt = r & 3; convert_item<false>(a.in[27] + (size_t)l * 1024 * 1024, 1024, 1024, (bfraw*)(ws + WS_WO + l * WO_L), nt * 256, nt * 256, kb * 128, scr, tid); continue; } r -= I_O; \
            if (r < I_1) { const int kb = r >> 4, nt = r & 15; convert_item<false>(a.in[28] + (size_t)l * 1024 * 4096, 1024, 4096, (bfraw*)(ws + WS_W1 + l * W1_L), nt * 256, nt * 256, kb * 128, scr, tid); continue; } r -= I_1; \
            { const int kb = r >> 2, nt = r & 3; convert_item<false>(a.in[29] + (size_t)l * 4096 * 1024, 4096, 1024, (bfraw*)(ws + WS_W2 + l * W2_L), nt * 256, nt * 256, kb * 128, scr, tid); } \
        } }
#define P0_CONVERT { if (G == 256) CONVERT_RANGE(G - 1 - bid, 200, G) else CONVERT_RANGE(G - 1 - bid, 1072, G) }
#define CONV_PHASE \
            for (int u0 = bid; u0 < NTOK / 32; u0 += G) { const int u = (G == 256) ? 32 * (u0 & 7) + (u0 >> 3) : u0;     \
                conv_unit(lds, u, (const bfraw*)(P_PROJ + P_U), P_ABR + (size_t)2 * NTOK * 512, a.in[22] + l * 31 * 512, a.in[23] + l * 512, a.in[24] + l * 512, a.in[25] + l * 512); }
#define PH_BEGIN const CAS_ KArgs* ap_ = (const CAS_ KArgs*)__builtin_amdgcn_kernarg_segment_ptr(); asm volatile("" : "+s"(ap_)); const CAS_ KArgs& a = *ap_; \
    GAS_ unsigned char* wsg_ = (GAS_ unsigned char*)a.ws; asm volatile("" : "+s"(wsg_)); unsigned char* ws = (unsigned char*)wsg_; int tid = threadIdx.x; asm volatile("" : "+v"(tid)); \
    const int lane = tid & 63, wave = __builtin_amdgcn_readfirstlane(tid >> 6), gw = bid * 8 + wave, NGW = G * 8; (void)lane; (void)gw; (void)NGW; (void)wave;
#define GAS_ __attribute__((address_space(1)))
#define CAS_ __attribute__((address_space(4)))
#ifdef TPROBE
#ifndef TP_BLK
#define TP_BLK 0
#endif
#define STAMP(k) do { if (bid == TP_BLK && threadIdx.x == 0) ((volatile LAS unsigned long long*)(lds + 146880))[(k)] = __builtin_amdgcn_s_memrealtime(); } while (0)
#else
#define STAMP(k) do {} while (0)
#endif
#ifndef SPLITK
#define SPLITK 1
#endif
#ifndef PATAIL
#define PATAIL 1
#endif
#ifndef LOCALBAR
#define LOCALBAR 1
#endif
#ifndef NOCG
#define NOCG 1
#endif
#ifndef C1ALIGN
#define C1ALIGN true
#endif
#ifndef C1SP2
#define C1SP2 true
#endif
#ifndef C2SPLIT
#define C2SPLIT 1
#endif
#ifndef GALIGN
#define GALIGN true
#endif
#ifndef C1HALFN
#define C1HALFN 1
#endif
#ifndef C1PAIR
#define C1PAIR 0
#endif
#ifdef XPROBE
#define XP_OFF(x) 0
#define XPROBE_KL(full) (full)
#else
#define XP_OFF(x) (x)
#define XPROBE_KL(full) kh
#endif
#define NR_XCD (G == 256)
#define NR_M0 (NR_XCD ? 1024 * (bid & 7) + (((bid >> 3) * 8 + wave) * 4) : gw)
#define NR_END (NR_XCD ? NR_M0 + 1 : NTOK)
#define NR_STEP (NR_XCD ? 4 : 4 * NGW)
#define NR_STRIDE (NR_XCD ? 1 : NGW)
#define P_MOD ((float*)(ws + WS_MOD))
#define P_HB ((bfraw*)(ws + WS_HB))
#define P_ABR ((bfraw*)(ws + WS_ABR))
#define P_PROJ (ws + WS_PROJ)
#define P_X (a.out + O_X)
__global__ void __launch_bounds__(512, 2) fwd_kernel(KArgs a_) {
    extern __shared__ __attribute__((aligned(16))) unsigned char lds_raw[];
    LAS unsigned char* lds = (LAS unsigned char*)lds_raw;
    cg::grid_group grid = cg::this_grid();
    int bid = blockIdx.x; const int G = gridDim.x;
    volatile LAS unsigned* bst = (volatile LAS unsigned*)(lds + 147392);
    STAMP(0);
    {
        PH_BEGIN
        unsigned* barw = (unsigned*)(ws + WS_BAR);
        if (tid == 0) { bst[0] = 0u; bst[1] = 0u; bst[2] = 0u; bst[3] = 0u; }
#if !NOCG
        if (bid == 0) for (int i = tid; i < 6656; i += 512) __hip_atomic_store(barw + i, 0u, __ATOMIC_RELAXED, __HIP_MEMORY_SCOPE_AGENT);
#else
        (void)barw;
#endif
        __syncthreads();
    }
#if NOCG
    const XcdBarrier bar = xcd_barrier_post((unsigned*)(a_.ws + WS_BAR), bst);
#endif
#pragma unroll 1
    for (int rep_ = 0; rep_ < REP_P0; ++rep_) {
        PH_BEGIN
        LAS float* sil = (LAS float*)lds;
        for (int i = tid; i < 3072; i += 512) { const int cond = i >> 10, k = i & 1023; const float v = cond == 0 ? a.in[7][k] : a.in[6][(cond - 1) * 1024 + k]; sil[i] = v * sigmoidf_(v); }
        __syncthreads();
        LAS float* part = (LAS float*)(lds + 16384);
        for (int item = bid; item < 192; item += G) {
            const int l = item / 96, nb = (item % 96) * 64;
            const float* W = a.in[8] + (size_t)l * 1024 * 6144 + nb + lane;
            const int k0 = wave * 128;
            float a0 = 0.f, a1 = 0.f, a2 = 0.f;
#pragma unroll 32
            for (int kk = 0; kk < 128; ++kk) { const float wv = W[(size_t)(k0 + kk) * 6144]; a0 += sil[k0 + kk] * wv; a1 += sil[1024 + k0 + kk] * wv; a2 += sil[2048 + k0 + kk] * wv; }
            part[(wave * 3 + 0) * 64 + lane] = a0; part[(wave * 3 + 1) * 64 + lane] = a1; part[(wave * 3 + 2) * 64 + lane] = a2;
            __syncthreads();
            if (tid < 192) { const int cnd = tid >> 6, ln = tid & 63; float s = 0.f;
#pragma unroll
                for (int wv = 0; wv < 8; ++wv) s += part[(wv * 3 + cnd) * 64 + ln];
                P_MOD[(size_t)(l * 3 + cnd) * 6144 + nb + ln] = s + a.in[9][l * 6144 + nb + ln]; }
            __syncthreads();
        }
        if ((bid == G - 3 || G < 3) && tid < 2) {
            float d1 = 0.f, d2 = 0.f;
            for (int i = 0; i < 64; ++i) { d1 += a.in[13][tid * 64 + i] * a.in[14][tid * 64 + i]; d2 += a.in[15][tid * 64 + i] * a.in[16][tid * 64 + i]; }
            ((float*)(ws + WS_LAM))[tid] = __builtin_amdgcn_exp2f(d1 * 1.4426950408889634f) - __builtin_amdgcn_exp2f(d2 * 1.4426950408889634f) + (tid == 0 ? 0.2f : 0.35550907f);
        }
        if (bid == G - 2 || G == 1) { float* QKN = (float*)(ws + WS_QKN); if (tid < 256) { const int l_ = tid >> 7, w_ = (tid >> 6) & 1, d_ = tid & 63; QKN[tid] = (w_ ? a.in[20] : a.in[19])[l_ * 64 + d_]; } }
        if (bid == G - 1) {
            float* ROPEC = (float*)(ws + WS_ROPEC); float* ROPES = (float*)(ws + WS_ROPES);
            for (int i = tid; i < 1024; i += 512) { const int pos = i >> 4, j = i & 15; const float freq = __builtin_amdgcn_exp2f(-(float)j * 0.8304820237218406f);
                float s, c; sincos_small((float)pos * freq, s, c); ROPEC[i] = c; ROPES[i] = s; }
        }
        __syncthreads();
        P0_CONVERT
        const int gt = bid * 512 + tid, GT = G * 512;
        bfraw* CDK = (bfraw*)(ws + WS_CDK); bfraw* CDVT = (bfraw*)(ws + WS_CDVT); bfraw* CGK = (bfraw*)(ws + WS_CGK); bfraw* CGVT = (bfraw*)(ws + WS_CGVT);
        for (int i = gt; i < 2 * 2 * 256 * 512; i += GT) { const int col = i & 511, s = (i >> 9) & 255, l = (i >> 17) & 1, lb = i >> 18;
            CDK[((size_t)(l * 2 + lb) * 256 + s) * 512 + col] = f2bf(a.in[2][i]); CDVT[((size_t)(l * 2 + lb) * 512 + col) * 256 + s] = f2bf(a.in[3][i]); }
        for (int i = gt; i < 2 * 2 * 256 * 128; i += GT) { const int col = i & 127, s = (i >> 7) & 255, l = (i >> 15) & 1, lb = i >> 16;
            CGK[((size_t)(l * 2 + lb) * 256 + s) * 128 + col] = f2bf(a.in[4][i]); CGVT[((size_t)(l * 2 + lb) * 128 + col) * 256 + s] = f2bf(a.in[5][i]); }
    }
#if !NOCG
    grid.sync();
    const XcdBarrier bar = xcd_barrier_post((unsigned*)(a_.ws + WS_BAR), bst);
#else
    if (G == 0x7fffffff) grid.sync();
    xcd_barrier(bar);
#endif
    STAMP(1);
    for (int rep_ = 0; rep_ < REP_SYNC; ++rep_) xcd_barrier(bar);
#if NOCG
    const bool lbar = LOCALBAR && bst[3] != 0u;
    if (lbar) bid = (int)(bst[2] * 8u + bar.x);
#endif
    {
        PH_BEGIN
        for (int mb = NR_M0; mb < NR_END; mb += NR_STEP) norm_rows4<false>(mb, NR_STRIDE, a.in[0], a.in[1], P_X, nullptr, P_HB, a.in[10], P_MOD, M_SH1, M_SC1, lane);
    }
#if NOCG
    if (lbar) xcc_local_barrier(bar); else xcd_barrier(bar);
#else
    xcd_barrier(bar);
#endif
    STAMP(2);
#if !NOCG
    const bool lbar = LOCALBAR && bst[3] != 0u;
    if (lbar) bid = (int)(bst[2] * 8u + bar.x);
#endif
#define SEAM_LOCAL() do { if (lbar) xcc_local_barrier(bar); else xcd_barrier(bar); } while (0)

#pragma unroll 1
    for (int l = 0; l < 2; ++l) {
#pragma unroll 1
        for (int rep_ = 0; rep_ < REP_PA; ++rep_) {
            PH_BEGIN
            EpiCtx ec; ec.l = l; ec.out = a.out; ec.ws = ws;
            pg8::Gemm g{P_HB, (const bfraw*)(ws + WS_WIN + l * WIN_L), NTOK, INW, DM, DM, -1};
            const bool tail = (G == 256) && PATAIL;
            { pg8::EpiIn E{ec, -1}; pg8::StaticOrder S; S.init(NTOK, tail ? 24 * 256 : INW, G, bid); pg8::gemm_phase<pg8::EpiIn, pg8::StaticOrder, GALIGN, true>(lds, g, S, E); }
            if (tail) { pg8::Gemm g2{P_HB, (const bfraw*)(ws + WS_WIN + l * WIN_L), NTOK, INW, DM, DM, (bid >> 3) & 1}; pg8::EpiIn E2{ec, (bid >> 3) & 1}; pg8::QuarterOrder S{bid}; pg8::gemm_phase<pg8::EpiIn, pg8::QuarterOrder, true, true>(lds, g2, S, E2); }
            if (rep_ == 0 && G == 256 && bid >= 64) { __syncthreads(); if (l == 0) { CONVERT_RANGE(200 + (bid - 64), 536, 192) } else { CONVERT_RANGE(736 + (bid - 64), 1072, 192) } }
        }
        xcd_barrier(bar);
        STAMP(3 + l * 8 + 0);
#pragma unroll 1
        for (int rep_ = 0; rep_ < REP_ATT; ++rep_) {
            PH_BEGIN
            const float lam_init = l == 0 ? 0.2f : 0.35550907f;
            const float lam = ((const float*)(ws + WS_LAM))[l];
            const bfraw* CDK = (const bfraw*)(ws + WS_CDK); const bfraw* CDVT = (const bfraw*)(ws + WS_CDVT); const bfraw* CGK = (const bfraw*)(ws + WS_CGK); const bfraw* CGVT = (const bfraw*)(ws + WS_CGVT);
            bfraw* const DQ = (bfraw*)(P_PROJ + P_DQ); bfraw* const DK = (bfraw*)(P_PROJ + P_DK); bfraw* const DVtC = (bfraw*)(P_PROJ + P_DVTC); bfraw* const DVtL = (bfraw*)(P_PROJ + P_DVTL);
            bfraw* const GQ = (bfraw*)(P_PROJ + P_GQ); bfraw* const GK = (bfraw*)(P_PROJ + P_GK); bfraw* const GVtC = (bfraw*)(P_PROJ + P_GVTC); bfraw* const GVtL = (bfraw*)(P_PROJ + P_GVTL);
            bfraw* const ABR = P_ABR;
            for (int k = 0; ; ++k) {
                int u;
                if (G == 256) { if (bid < 128) { if (k > 0) break; u = bid; } else { if (k > 2) break; u = 128 * (k + 1) + (bid - 128); } }
                else { u = bid + k * G; if (u >= 512) break; }
                const int cls = u >> 7, j_ = u & 127, i = (G == 256) ? (j_ & 7) * 16 + (j_ >> 3) : j_;
                AttnArgs t;
                t.lam = lam; t.postscale = 1.0f - lam_init; t.subln = a.in[17] + l * 128;
                if (cls == 0) {
                    const int lb = i >> 6, h = (i >> 4) & 3, qb = i & 15; const int row0 = NCTX + lb * LSEQ;
                    t.Q = DQ + (size_t)(row0 + qb * 128) * 512; t.qcol0 = h * 128; t.qcol1 = h * 128 + 64;
                    t.Kown = DK + (size_t)row0 * 512 + h * 128; t.Kc = CDK + (size_t)(l * 2 + lb) * 256 * 512 + h * 128; t.kstride = 512; t.nOwn = 32; t.nTot = 36;
                    t.Vown = DVtL + ((size_t)lb * 512 + h * 128) * 2048; t.vsOwn = 2048; t.Vc = CDVT + ((size_t)(l * 2 + lb) * 512 + h * 128) * 256; t.vsC = 256;
                    t.O = ABR + (size_t)(row0 + qb * 128) * 512; t.ocol0 = h * 128; t.ocol1 = 0;
                    attn_unit<128, 128, true>(lds, t);
                } else if (cls == 2) {
                    const int cb = i >> 3, h = (i >> 1) & 3, qb = i & 1; const int row0 = cb * CSEQ;
                    t.Q = DQ + (size_t)(row0 + qb * 128) * 512; t.qcol0 = h * 128; t.qcol1 = h * 128 + 64;
                    t.Kown = DK + (size_t)row0 * 512 + h * 128; t.Kc = t.Kown; t.kstride = 512; t.nOwn = 4; t.nTot = 4;
                    t.Vown = DVtC + ((size_t)cb * 512 + h * 128) * 256; t.vsOwn = 256; t.Vc = t.Vown; t.vsC = 256;
                    t.O = ABR + (size_t)(row0 + qb * 128) * 512; t.ocol0 = h * 128; t.ocol1 = 0;
                    attn_unit<128, 128, true>(lds, t);
                } else if (cls == 1) {
                    const int lb = i >> 6, pr = (i >> 4) & 3, qb = i & 15, kvh = pr >> 1, h0 = kvh * 4 + (pr & 1) * 2; const int row0 = NCTX + lb * LSEQ;
                    t.Q = GQ + (size_t)(row0 + qb * 128) * 512; t.qcol0 = h0 * 64; t.qcol1 = h0 * 64 + 64;
                    t.Kown = GK + (size_t)row0 * 128 + kvh * 64; t.Kc = CGK + (size_t)(l * 2 + lb) * 256 * 128 + kvh * 64; t.kstride = 128; t.nOwn = 32; t.nTot = 36;
                    t.Vown = GVtL + ((size_t)lb * 128 + kvh * 64) * 2048; t.vsOwn = 2048; t.Vc = CGVT + ((size_t)(l * 2 + lb) * 128 + kvh * 64) * 256; t.vsC = 256;
                    t.O = ABR + (size_t)NTOK * 512 + (size_t)(row0 + qb * 128) * 512; t.ocol0 = h0 * 64; t.ocol1 = h0 * 64 + 64;
                    attn_unit<64, 64, false>(lds, t);
                } else {
                    const int cb = i >> 3, pr = (i >> 1) & 3, qb = i & 1, kvh = pr >> 1, h0 = kvh * 4 + (pr & 1) * 2; const int row0 = cb * CSEQ;
                    t.Q = GQ + (size_t)(row0 + qb * 128) * 512; t.qcol0 = h0 * 64; t.qcol1 = h0 * 64 + 64;
                    t.Kown = GK + (size_t)row0 * 128 + kvh * 64; t.Kc = t.Kown; t.kstride = 128; t.nOwn = 4; t.nTot = 4;
                    t.Vown = GVtC + ((size_t)cb * 128 + kvh * 64) * 256; t.vsOwn = 256; t.Vc = t.Vown; t.vsC = 256;
                    t.O = ABR + (size_t)NTOK * 512 + (size_t)(row0 + qb * 128) * 512; t.ocol0 = h0 * 64; t.ocol1 = h0 * 64 + 64;
                    attn_unit<64, 64, false>(lds, t);
                }
            }
        }
        STAMP(20 + l * 2);
#pragma unroll 1
        for (int rep_ = 0; rep_ < REP_CONV; ++rep_) {
            PH_BEGIN
            CONV_PHASE
        }
        STAMP(21 + l * 2);
        xcd_barrier(bar);
        STAMP(3 + l * 8 + 1);
#pragma unroll 1
        for (int rep_ = 0; rep_ < REP_C1; ++rep_) {
            PH_BEGIN
            EpiCtx ec; ec.l = l; ec.out = a.out; ec.ws = ws;
            const bool sp = (G == 256) && SPLITK && C1HALFN; const int pairm = (lbar && C1PAIR) ? 1 : 0; const int bjs = pairm ? -1 : (sp ? (bid >> 7) : -1);
            pg8::Gemm g{P_ABR, (const bfraw*)(ws + WS_WBR + l * WBR_L), 3 * NTOK, 3 * 1024, 512, 512, bjs}; pg8::BranchOrder S{(sp || pairm) ? (bid & 127) : bid, bid >> 7, pairm};
            pg8::EpiBranch E{ec, bjs, pairm, (unsigned)(l + 1)};
            pg8::gemm_phase<pg8::EpiBranch, pg8::BranchOrder, C1ALIGN, C1SP2>(lds, g, S, E);
            if (l == 0 && rep_ == 0 && G == 256) { __syncthreads(); if (C1HALFN) { CONVERT_RANGE(536 + bid, 736, 256) } else if (bid >= 128) { CONVERT_RANGE(536 + (bid - 128), 736, 128) }     }
        }
        SEAM_LOCAL();
        STAMP(3 + l * 8 + 2);
#pragma unroll 1
        for (int rep_ = 0; rep_ < REP_C2; ++rep_) {
            PH_BEGIN
            EpiCtx ec; ec.l = l; ec.out = a.out; ec.ws = ws;
            const bool sp = (G == 256) && SPLITK && C2SPLIT; const int half = sp ? (bid >> 7) : 0, kh = sp ? DM / 2 : DM;
            pg8::Gemm g{P_HB + half * kh, (const bfraw*)(ws + WS_WO + l * WO_L) + half * kh, NTOK, DM, DM, kh, -1}; pg8::StaticOrder S; S.init(NTOK, DM, sp ? 128 : G, sp ? (bid & 127) : bid);
            pg8::EpiRes E{ec, M_G1, sp ? (half ? 1 : 2) : 0};
            pg8::gemm_phase<pg8::EpiRes, pg8::StaticOrder, false, true>(lds, g, S, E);
        }
        SEAM_LOCAL();
        STAMP(3 + l * 8 + 3);
        {
            PH_BEGIN
            for (int mb = NR_M0; mb < NR_END; mb += NR_STEP) norm_rows4<false>(mb, NR_STRIDE, nullptr, nullptr, P_X, ((G == 256) && SPLITK && C2SPLIT) ? (const float*)(ws + WS_PART) : nullptr, P_HB, a.in[11] + l * DM, P_MOD + (size_t)(l * 3) * 6144, M_SH2, M_SC2, lane);
        }
        SEAM_LOCAL();
        STAMP(3 + l * 8 + 4);
#pragma unroll 1
        for (int rep_ = 0; rep_ < REP_M1; ++rep_) {
            PH_BEGIN
            EpiCtx ec; ec.l = l; ec.out = a.out; ec.ws = ws;
            pg8::Gemm g{P_HB, (const bfraw*)(ws + WS_W1 + l * W1_L), NTOK, FF, DM, DM, -1}; pg8::StaticOrder S; S.init(NTOK, FF, G, bid);
            pg8::EpiRelu2 E{ec};
            pg8::gemm_phase<pg8::EpiRelu2, pg8::StaticOrder, GALIGN, true>(lds, g, S, E);
        }
        SEAM_LOCAL();
        STAMP(3 + l * 8 + 5);
#pragma unroll 1
        for (int rep_ = 0; rep_ < REP_M2; ++rep_) {
            PH_BEGIN
            EpiCtx ec; ec.l = l; ec.out = a.out; ec.ws = ws;
            const bool sp = (G == 256) && SPLITK; const int half = sp ? (bid >> 7) : 0, kh = sp ? FF / 2 : FF;
            pg8::Gemm g{(const bfraw*)P_PROJ + half * kh, (const bfraw*)(ws + WS_W2 + l * W2_L) + half * kh, NTOK, DM, FF, kh, -1}; pg8::StaticOrder S; S.init(NTOK, DM, sp ? 128 : G, sp ? (bid & 127) : bid);
            pg8::EpiRes E{ec, M_G2, sp ? (half ? 1 : 2) : 0};
            pg8::gemm_phase<pg8::EpiRes, pg8::StaticOrder, false, true>(lds, g, S, E);
        }
        SEAM_LOCAL();
        STAMP(3 + l * 8 + 6);
        {
            PH_BEGIN
            const float* px = ((G == 256) && SPLITK) ? (const float*)(ws + WS_PART) : nullptr;
            if (l == 0) { for (int mb = NR_M0; mb < NR_END; mb += NR_STEP) norm_rows4<false>(mb, NR_STRIDE, nullptr, nullptr, P_X, px, P_HB, a.in[10] + DM, P_MOD + (size_t)3 * 6144, M_SH1, M_SC1, lane); }
            else { for (int mb = NR_M0; mb < NR_END; mb += NR_STEP) norm_rows4<true>(mb, NR_STRIDE, nullptr, nullptr, P_X, px, nullptr, a.in[30], nullptr, 0, 0, lane); }
        }
        if (l == 0) xcd_barrier(bar);
        STAMP(3 + l * 8 + 7);
    }
#ifdef TPROBE
    if (bid == TP_BLK && threadIdx.x == 0) {
        volatile LAS unsigned long long* ts_ = (volatile LAS unsigned long long*)(lds + 146880);
        const unsigned long long T_ = ts_[TP_B] - ts_[TP_A], end_ = __builtin_amdgcn_s_memrealtime() + TP_MULT * T_;
        while (__builtin_amdgcn_s_memrealtime() < end_) __builtin_amdgcn_s_sleep(8);
    }
#endif
}

extern "C" void kernel_launch(void* const* d_in, const int* in_sizes, int n_in, void* d_out, int out_size, void* d_ws, size_t ws_size, hipStream_t stream) {
    static int grid_blocks = 0;
    if (grid_blocks == 0) {
        if (n_in != 31 || ws_size < WS_END) { fprintf(stderr, "kernel_launch: unexpected n_in %d / ws_size %zu\n", n_in, ws_size); grid_blocks = -1; return; }
        int dev = 0, cus = 0, per_cu = 0;
        hipGetDevice(&dev);
        hipDeviceGetAttribute(&cus, hipDeviceAttributeMultiprocessorCount, dev);
        if (hipFuncSetAttribute((const void*)fwd_kernel, hipFuncAttributeMaxDynamicSharedMemorySize, LDS_BYTES) != hipSuccess) { fprintf(stderr, "kernel_launch: hipFuncSetAttribute failed\n"); grid_blocks = -1; return; }
        if (hipOccupancyMaxActiveBlocksPerMultiprocessor(&per_cu, (const void*)fwd_kernel, 512, LDS_BYTES) != hipSuccess || per_cu < 1) { fprintf(stderr, "kernel_launch: occupancy query gave %d\n", per_cu); (void)hipGetLastError(); per_cu = 1; }
        grid_blocks = cus * 1;
    }
    if (grid_blocks < 0) return;
#if NOCG
    if (hipMemsetAsync((char*)d_ws + WS_BAR, 0, 6656 * 4, stream) != hipSuccess) { fprintf(stderr, "kernel_launch: hipMemsetAsync of the barrier words failed\n"); return; }
#endif
    KArgs a{};
    for (int i = 0; i < 31; ++i) a.in[i] = (const float*)d_in[i];
    a.out = (float*)d_out; a.ws = (unsigned char*)d_ws;
    void* args[] = {&a};
    hipError_t e = hipLaunchCooperativeKernel((const void*)fwd_kernel, dim3(grid_blocks), dim3(512), args, LDS_BYTES, stream);
    if (e != hipSuccess) fprintf(stderr, "cooperative launch failed: %s (grid %d)\n", hipGetErrorString(e), grid_blocks);
}
```

```cpp
#include <hip/hip_runtime.h>
#include <hip/hip_cooperative_groups.h>
#include <cstdio>
#include <cstdint>
namespace cg = cooperative_groups;

typedef float f32x4_t __attribute__((ext_vector_type(4)));
typedef float f32x2_t __attribute__((ext_vector_type(2)));
typedef float f32x16_t __attribute__((ext_vector_type(16)));
typedef unsigned u32x4_t __attribute__((ext_vector_type(4)));
typedef unsigned u32x2_t __attribute__((ext_vector_type(2)));
typedef short s16x8_t __attribute__((ext_vector_type(8)));
typedef __bf16 bf16x2_t __attribute__((ext_vector_type(2)));
typedef unsigned short bfraw;

__device__ __forceinline__ unsigned pk2(float lo, float hi) { f32x2_t v = {lo, hi}; bf16x2_t b = __builtin_convertvector(v, bf16x2_t); return __builtin_bit_cast(unsigned, b); }
__device__ __forceinline__ bfraw f2bf(float x) { return (bfraw)(pk2(x, 0.f) & 0xffffu); }
__device__ __forceinline__ float bf2f(bfraw x) { return __builtin_bit_cast(float, (unsigned)x << 16); }
__device__ __forceinline__ float sigmoidf_(float x) { return __builtin_amdgcn_rcpf(1.0f + __builtin_amdgcn_exp2f(-1.4426950408889634f * x)); }

constexpr int DM = 1024, NTOK = 8192, NCTX = 4096, CSEQ = 256, LSEQ = 2048, PAST = 256, INW = 6400, FF = 4096;
constexpr float NEPS = 1e-6f;
constexpr float QSCALE = 0.125f * 1.4426950408889634f;
constexpr size_t O_X = 0, O_NDK = 8388608, O_NDV = 12582912, O_NGK = 16777216, O_NGV = 17825792;
constexpr int M_SH1 = 0, M_SC1 = 1024, M_G1 = 2048, M_SH2 = 3072, M_SC2 = 4096, M_G2 = 5120;

struct EpiCtx { int l; float* out; unsigned char* ws; };
#define LAS __attribute__((address_space(3)))
constexpr size_t MiB = 1u << 20;
constexpr size_t WS_MOD = 0, WS_ROPEC = 160 * 1024, WS_ROPES = 164 * 1024, WS_BAR = 192 * 1024, WS_FLAG = WS_BAR + 16384, WS_FLAG2 = WS_BAR + 5632 * 4, WS_QKN = 176 * 1024, WS_LAM = 180 * 1024;
constexpr size_t WS_CDK = 1 * MiB, WS_CDVT = 2 * MiB, WS_CGK = 3 * MiB, WS_CGVT = 3 * MiB + 256 * 1024;
constexpr size_t WS_WIN = 4 * MiB, WIN_L = (size_t)INW * DM * 2;
constexpr size_t WS_WBR = 29 * MiB, WBR_L = 3 * MiB;
constexpr size_t WS_WO = 35 * MiB, WO_L = 2 * MiB;
constexpr size_t WS_W1 = 39 * MiB, W1_L = 8 * MiB;
constexpr size_t WS_W2 = 55 * MiB, W2_L = 8 * MiB;
constexpr size_t WS_HB = 72 * MiB;
constexpr size_t WS_ABR = 88 * MiB;
constexpr size_t WS_PROJ = 112 * MiB;
constexpr size_t P_DQ = 0, P_DK = 8 * MiB, P_DVTC = 16 * MiB, P_DVTL = 20 * MiB, P_GQ = 24 * MiB, P_GK = 32 * MiB, P_GVTC = 34 * MiB, P_GVTL = 35 * MiB, P_U = 36 * MiB, P_G = 44 * MiB;
constexpr size_t WS_PART = 204 * MiB;
constexpr size_t WS_END = 236 * MiB;
constexpr int LDS_BYTES = 147456;

__device__ __forceinline__ void st_bf4(bfraw* p, f32x4_t v) { u32x2_t w; w.x = pk2(v[0], v[1]); w.y = pk2(v[2], v[3]); *(u32x2_t*)p = w; }
__device__ __forceinline__ float dot4(f32x4_t v) { return (v[0] * v[0] + v[1] * v[1]) + (v[2] * v[2] + v[3] * v[3]); }
namespace pg8 {
#define PG8_LAS __attribute__((address_space(3)))
typedef unsigned short bf16_t;
typedef short bf16x8 __attribute__((ext_vector_type(8)));
typedef float f32x4 __attribute__((ext_vector_type(4)));
typedef unsigned u32x4 __attribute__((ext_vector_type(4)));
constexpr int BM = 256, BK = 64, HALF = 128, HTB = HALF * BK * 2  , STAGE_BYTES = 8 * HTB, NXCD = 8, WGM = 4;

__host__ __device__ __forceinline__ int lds_byte(int r, int c) { const int st = (r >> 4) * 2 + (c >> 5), rr = r & 15, cc = c & 31, ob = rr * 64 + cc * 2; return st * 1024 + (ob ^ (((ob >> 9) & 1) << 5)); }
__host__ __device__ __forceinline__ void stage_rc(int b, int& R, int& C) { const int st = b / 1024, sb = b % 1024, swz = sb ^ (((sb >> 9) & 1) << 5); R = (st >> 1) * 16 + swz / 64; C = (st & 1) * 32 + (swz % 64) / 2; }
__host__ __device__ __forceinline__ int perm32(int rho) { const int n = rho >> 4, i = rho & 15; return 8 * (i >> 2) + 4 * n + (i & 3); }

struct Unit { int pm, pn; };
struct Gemm { const bf16_t* A; const bf16_t* Bt; int M, N, K, Kloop, bjsel; };

struct StaticOrder {
    int nM, nN, nwg, G, c;
    __host__ __device__ void init(int M, int N, int G_, int c_) { nM = M / BM; nN = N / BM; nwg = nM * nN; G = G_; c = c_; }
    __host__ __device__ bool next(int i, Unit& u) const {
        const long L = (long)i * G + c; if (L >= nwg) return false;
        int wgid = (int)L; { const int q = nwg / NXCD, r = nwg % NXCD, xcd = wgid % NXCD, off = wgid / NXCD; wgid = (xcd < r ? xcd * (q + 1) : r * (q + 1) + (xcd - r) * q) + off; }
        const int nig = WGM * nN, gid = wgid / nig, fm = gid * WGM, gsz = (nM - fm) < WGM ? (nM - fm) : WGM;
        u.pm = fm + ((wgid % nig) % gsz); u.pn = (wgid % nig) / gsz; return true;
    }
    __device__ __forceinline__ void a_ready(const Unit&) const {}
    __device__ __forceinline__ void done(const Unit&) const {}
};

__device__ __forceinline__ unsigned cvt_pk_bf16(float lo, float hi) { unsigned r; asm volatile("v_cvt_pk_bf16_f32 %0, %1, %2" : "=v"(r) : "v"(lo), "v"(hi)); return r; }
typedef float f32x2 __attribute__((ext_vector_type(2)));
#define EC_DQ ((bfraw*)(c.ws + WS_PROJ + P_DQ))
#define EC_DK ((bfraw*)(c.ws + WS_PROJ + P_DK))
#define EC_DVtC ((bfraw*)(c.ws + WS_PROJ + P_DVTC))
#define EC_DVtL ((bfraw*)(c.ws + WS_PROJ + P_DVTL))
#define EC_GQ ((bfraw*)(c.ws + WS_PROJ + P_GQ))
#define EC_GK ((bfraw*)(c.ws + WS_PROJ + P_GK))
#define EC_GVtC ((bfraw*)(c.ws + WS_PROJ + P_GVTC))
#define EC_GVtL ((bfraw*)(c.ws + WS_PROJ + P_GVTL))
#define EC_U ((bfraw*)(c.ws + WS_PROJ + P_U))
#define EC_G ((bfraw*)(c.ws + WS_PROJ + P_G))
#define EC_TMP ((float*)(c.ws + WS_PROJ))
#define EC_HB ((bfraw*)(c.ws + WS_HB))
#define EC_HID ((bfraw*)(c.ws + WS_PROJ))
#define EC_mod ((const float*)(c.ws + WS_MOD))
#define EC_ropec ((const float*)(c.ws + WS_ROPEC))
#define EC_ropes ((const float*)(c.ws + WS_ROPES))

struct EpiIn {
    static constexpr bool PERM = false, AFTER_DRAIN = false;
    EpiCtx c; int q;
    __device__ __forceinline__ void operator()(const f32x4 (&acc)[2][2][4][2], const Unit& u, int wr, int wc, int fr_, int fq_) const {
        int fr = fr_, fq = fq_; asm volatile("" : "+v"(fr), "+v"(fq));
        const int pn = u.pn, pm = u.pm, l = c.l;
        const bool ctx = pm < 16;
        const int rbase = pm * 256 + wr * 64 + fr;
        const int lb = (pm - 16) >> 3;
        if (pn < 2) {
#pragma unroll
            for (int ai = 0; ai < 2; ++ai)
#pragma unroll
                for (int m = 0; m < 4; ++m) {
                    const int row = rbase + ai * 128 + m * 16; const int t = (row - NCTX) & (LSEQ - 1);
                    f32x4 cs = {1.f, 1.f, 1.f, 1.f}, sn = {0.f, 0.f, 0.f, 0.f};
                    if (!ctx) { const int pos = (wc & 1) ? (t & 63) : (t >> 6); cs = *(const f32x4*)(EC_ropec + pos * 16 + 4 * fq); sn = *(const f32x4*)(EC_ropes + pos * 16 + 4 * fq); }
#pragma unroll
                    for (int bj = 0; bj < 2; ++bj) {
                        const f32x4 x1 = acc[ai][bj][m][0], x2 = acc[ai][bj][m][1];
                        const f32x4 o1 = (x1 * cs - x2 * sn) * QSCALE, o2 = (x2 * cs + x1 * sn) * QSCALE;
                        bfraw* p = EC_DQ + (size_t)row * 512 + pn * 256 + bj * 128 + wc * 32 + 4 * fq;
                        st_bf4(p, o1); st_bf4(p + 16, o2);
                    }
                }
        } else if (pn < 4) {
#pragma unroll
            for (int ai = 0; ai < 2; ++ai)
#pragma unroll
                for (int m = 0; m < 4; ++m) {
                    const int row = rbase + ai * 128 + m * 16; const int t = (row - NCTX) & (LSEQ - 1);
                    f32x4 cs = {1.f, 1.f, 1.f, 1.f}, sn = {0.f, 0.f, 0.f, 0.f};
                    if (!ctx) { const int pos = (wc & 1) ? (t & 63) : (t >> 6); cs = *(const f32x4*)(EC_ropec + pos * 16 + 4 * fq); sn = *(const f32x4*)(EC_ropes + pos * 16 + 4 * fq); }
#pragma unroll
                    for (int bj = 0; bj < 2; ++bj) {
                        const f32x4 x1 = acc[ai][bj][m][0], x2 = acc[ai][bj][m][1];
                        const f32x4 o1 = x1 * cs - x2 * sn, o2 = x2 * cs + x1 * sn;
                        const int colb = (pn - 2) * 256 + bj * 128 + wc * 32 + 4 * fq;
                        if (ctx) { float* op = c.out + O_NDK + ((size_t)(pm * 2 + l) * 256 + (row & 255)) * 512 + colb; *(f32x4*)op = x1; *(f32x4*)(op + 16) = x2; }
                        bfraw* p = EC_DK + (size_t)row * 512 + colb;
                        st_bf4(p, o1); st_bf4(p + 16, o2);
                    }
                }
        } else if (pn < 6) {
#pragma unroll
            for (int ai = 0; ai < 2; ++ai)
#pragma unroll
                for (int m = 0; m < 4; ++m) {
                    const int row = rbase + ai * 128 + m * 16; const int t = (row - NCTX) & (LSEQ - 1); const int s = row & 255;
#pragma unroll
                    for (int bj = 0; bj < 2; ++bj)
#pragma unroll
                        for (int n = 0; n < 2; ++n) {
                            const f32x4 x = acc[ai][bj][m][n];
                            const int colb = (pn - 4) * 256 + bj * 128 + wc * 32 + 16 * n + 4 * fq;
                            if (ctx) { *(f32x4*)(c.out + O_NDV + ((size_t)(pm * 2 + l) * 256 + s) * 512 + colb) = x;
#pragma unroll
                                for (int j = 0; j < 4; ++j) EC_DVtC[((size_t)pm * 512 + colb + j) * 256 + s] = f2bf(x[j]); }
                            else {
#pragma unroll
                                for (int j = 0; j < 4; ++j) EC_DVtL[((size_t)lb * 512 + colb + j) * 2048 + t] = f2bf(x[j]);
#ifdef DUPV
                                asm volatile("" ::: "memory");
#pragma unroll
                                for (int j = 0; j < 4; ++j) EC_DVtL[((size_t)lb * 512 + colb + j) * 2048 + t] = f2bf(x[j]);
#endif
                            }
                        }
                }
        } else if (pn < 8 || (pn == 8 && wc < 2)) {
            const bool isq = pn < 8;
            const float* nw = (const float*)(c.ws + WS_QKN) + l * 128 + (isq ? 0 : 64);
            const int head = isq ? 4 * (pn - 6) + wc : wc;
            const float osc = isq ? QSCALE : 1.0f;
#pragma unroll
            for (int ai = 0; ai < 2; ++ai)
#pragma unroll
                for (int m = 0; m < 4; ++m) {
                    const int row = rbase + ai * 128 + m * 16; const int t = (row - NCTX) & (LSEQ - 1);
                    float ss = (dot4(acc[ai][0][m][0]) + dot4(acc[ai][0][m][1])) + (dot4(acc[ai][1][m][0]) + dot4(acc[ai][1][m][1]));
                    ss += __shfl_xor(ss, 16); ss += __shfl_xor(ss, 32);
                    const float r = __builtin_amdgcn_rsqf(ss * (1.0f / 64.0f) + NEPS);
#pragma unroll
                    for (int bj = 0; bj < 2; ++bj) {
                        const f32x4 wa = *(const f32x4*)(nw + 32 * bj + 4 * fq), wb = *(const f32x4*)(nw + 32 * bj + 16 + 4 * fq);
                        const f32x4 x1 = acc[ai][bj][m][0] * r * wa, x2 = acc[ai][bj][m][1] * r * wb;
                        f32x4 cs = {1.f, 1.f, 1.f, 1.f}, sn = {0.f, 0.f, 0.f, 0.f};
                        if (!ctx) { const int pos = bj ? (t & 63) : (t >> 6); cs = *(const f32x4*)(EC_ropec + pos * 16 + 4 * fq); sn = *(const f32x4*)(EC_ropes + pos * 16 + 4 * fq); }
                        const f32x4 o1 = (x1 * cs - x2 * sn) * osc, o2 = (x2 * cs + x1 * sn) * osc;
                        const int d0 = head * 64 + 32 * bj + 4 * fq;
                        if (isq) { bfraw* p = EC_GQ + (size_t)row * 512 + d0; st_bf4(p, o1); st_bf4(p + 16, o2); }
                        else {
                            if (ctx) { float* op = c.out + O_NGK + ((size_t)(pm * 2 + l) * 256 + (row & 255)) * 128 + d0; *(f32x4*)op = x1; *(f32x4*)(op + 16) = x2; }
                            bfraw* p = EC_GK + (size_t)row * 128 + d0; st_bf4(p, o1); st_bf4(p + 16, o2);
                        }
                    }
                    asm volatile("" ::: "memory");
                }
        } else if (pn == 8) {
            const int kvh = wc - 2;
#pragma unroll
            for (int ai = 0; ai < 2; ++ai)
#pragma unroll
                for (int m = 0; m < 4; ++m) {
                    const int row = rbase + ai * 128 + m * 16; const int t = (row - NCTX) & (LSEQ - 1); const int s = row & 255;
#pragma unroll
                    for (int bj = 0; bj < 2; ++bj)
#pragma unroll
                        for (int n = 0; n < 2; ++n) {
                            const f32x4 x = acc[ai][bj][m][n];
                            const int d0 = kvh * 64 + 32 * bj + 16 * n + 4 * fq;
                            if (ctx) { *(f32x4*)(c.out + O_NGV + ((size_t)(pm * 2 + l) * 256 + s) * 128 + d0) = x;
#pragma unroll
                                for (int j = 0; j < 4; ++j) EC_GVtC[((size_t)pm * 128 + d0 + j) * 256 + s] = f2bf(x[j]); }
                            else {
#pragma unroll
                                for (int j = 0; j < 4; ++j) EC_GVtL[((size_t)lb * 128 + d0 + j) * 2048 + t] = f2bf(x[j]); }
                        }
                }
        } else if (pn < 13) {
            const int q = pn - 9;
#pragma unroll
            for (int ai = 0; ai < 2; ++ai)
#pragma unroll
                for (int m = 0; m < 4; ++m) {
                    const int row = rbase + ai * 128 + m * 16;
#pragma unroll
                    for (int n = 0; n < 2; ++n) {
                        const f32x4 a = acc[ai][0][m][n], g = acc[ai][1][m][n];
                        f32x4 o; o[0] = a[0] * sigmoidf_(g[0]); o[1] = a[1] * sigmoidf_(g[1]); o[2] = a[2] * sigmoidf_(g[2]); o[3] = a[3] * sigmoidf_(g[3]);
                        st_bf4(EC_U + (size_t)row * 512 + q * 128 + wc * 32 + 16 * n + 4 * fq, o);
                    }
                }
        } else {
#pragma unroll
            for (int ai = 0; ai < 2; ++ai) {
#pragma unroll
                for (int m = 0; m < 4; ++m) {
                    const int row = rbase + ai * 128 + m * 16;
#pragma unroll
                    for (int bj = 0; bj < 2; ++bj) {
                        if (q >= 0 && bj != q) continue;
#pragma unroll
                        for (int n = 0; n < 2; ++n) {
                            const f32x4 g = acc[ai][bj][m][n];
                            f32x4 o; o[0] = sigmoidf_(g[0]); o[1] = sigmoidf_(g[1]); o[2] = sigmoidf_(g[2]); o[3] = sigmoidf_(g[3]);
                            st_bf4(EC_G + (size_t)row * 3072 + (pn - 13) * 256 + bj * 128 + wc * 32 + 16 * n + 4 * fq, o);
                        }
                    }
                }
            }
        }
    }
};

struct EpiBranch {
    static constexpr bool PERM = true, AFTER_DRAIN = false;
    EpiCtx c; int bjsel; int pair; unsigned epoch;
    __device__ __forceinline__ void operator()(const f32x4 (&acc)[2][2][4][2], const Unit& u, int wr, int wc, int fr_, int fq_) const {
        int fr = fr_, fq = fq_; asm volatile("" : "+v"(fr), "+v"(fq));
        const int br = u.pm >> 5, pm = u.pm & 31, pn = u.pn & 3;
        unsigned* const flag = (unsigned*)(c.ws + WS_FLAG2) + (pm * 4 + pn) * 8 + wr * 4 + wc;
        const bool last = pair ? (br == 1) : (br == 2);
        if (pair && br == 1) {
            unsigned spins = 0;
            while (__hip_atomic_load(flag, __ATOMIC_RELAXED, __HIP_MEMORY_SCOPE_AGENT) != epoch) { __builtin_amdgcn_s_sleep(1); if (++spins > (1u << 22)) break; }
            __builtin_amdgcn_fence(__ATOMIC_ACQUIRE, "agent");
        }
#pragma unroll
        for (int ai = 0; ai < 2; ++ai)
#pragma unroll
            for (int m = 0; m < 4; ++m) {
                const int row = pm * 256 + ai * 128 + wr * 64 + m * 16 + fr;
#pragma unroll
                for (int bj = 0; bj < 2; ++bj) {
                    if (bjsel >= 0 && bj != bjsel) continue;
                    const int col8 = pn * 256 + bj * 128 + wc * 32 + 8 * fq;
                    const u32x4 gw = *(const u32x4*)(EC_G + (size_t)row * 3072 + br * 1024 + col8);
                    f32x4 g0, g1;
                    g0[0] = __builtin_bit_cast(float, gw.x << 16); g0[1] = __builtin_bit_cast(float, gw.x & 0xffff0000u);
                    g0[2] = __builtin_bit_cast(float, gw.y << 16); g0[3] = __builtin_bit_cast(float, gw.y & 0xffff0000u);
                    g1[0] = __builtin_bit_cast(float, gw.z << 16); g1[1] = __builtin_bit_cast(float, gw.z & 0xffff0000u);
                    g1[2] = __builtin_bit_cast(float, gw.w << 16); g1[3] = __builtin_bit_cast(float, gw.w & 0xffff0000u);
                    f32x4 v0 = acc[ai][bj][m][0] * g0, v1 = acc[ai][bj][m][1] * g1;
                    bfraw* tp = (bfraw*)EC_TMP + (size_t)row * 1024 + col8;
                    float* t2 = (float*)(c.ws + WS_PART) + (size_t)row * 1024 + col8;
                    if (pair && br == 2) { *(f32x4*)t2 = v0; *(f32x4*)(t2 + 4) = v1; }
                    else {
                        if (br != 0) { const u32x4 tw = *(const u32x4*)tp;
                            v0[0] += __builtin_bit_cast(float, tw.x << 16); v0[1] += __builtin_bit_cast(float, tw.x & 0xffff0000u); v0[2] += __builtin_bit_cast(float, tw.y << 16); v0[3] += __builtin_bit_cast(float, tw.y & 0xffff0000u);
                            v1[0] += __builtin_bit_cast(float, tw.z << 16); v1[1] += __builtin_bit_cast(float, tw.z & 0xffff0000u); v1[2] += __builtin_bit_cast(float, tw.w << 16); v1[3] += __builtin_bit_cast(float, tw.w & 0xffff0000u); }
                        if (last && pair) { v0 += *(const f32x4*)t2; v1 += *(const f32x4*)(t2 + 4); }
                        u32x4 w; w.x = pk2(v0[0], v0[1]); w.y = pk2(v0[2], v0[3]); w.z = pk2(v1[0], v1[1]); w.w = pk2(v1[2], v1[3]);
                        if (last) *(u32x4*)(EC_HB + (size_t)row * 1024 + col8) = w; else *(u32x4*)tp = w;
                    }
                }
            }
        if (pair && br == 2) {
            asm volatile("s_waitcnt vmcnt(0)" ::: "memory");
            if (fr + 16 * fq == 0) __hip_atomic_store(flag, epoch, __ATOMIC_RELAXED, __HIP_MEMORY_SCOPE_AGENT);
        }
    }
};
struct QuarterOrder {
    int c;
    __device__ bool next(int i, Unit& u) const { if (i > 0 || c >= 64) return false; u.pm = 4 * (c & 7) + (c >> 4); u.pn = 24; return true; }
    __device__ __forceinline__ void a_ready(const Unit&) const {}
    __device__ __forceinline__ void done(const Unit&) const {}
};
struct BranchOrder {
    int c, role, pair;
    __device__ bool next(int i, Unit& u) const {
        if (c >= 128) return false;
        int br = i;
        if (pair) { if (role == 0) { if (i >= 2) return false; } else { if (i >= 1) return false; br = 2; } }
        else if (i >= 3) return false;
        const int x = c & 7, j = c >> 3; u.pm = br * 32 + 4 * x + (j >> 2); u.pn = br * 4 + (j & 3); return true;
    }
    __device__ __forceinline__ void a_ready(const Unit&) const {}
    __device__ __forceinline__ void done(const Unit&) const {}
};

struct EpiRes {
    static constexpr bool PERM = false, AFTER_DRAIN = true;
    EpiCtx c; int goff; int part;
    __device__ __forceinline__ void fused(f32x4 (&acc)[2][2][4][2], const Unit& u, int wr, int wc, int fr_, int fq_, PG8_LAS unsigned char* lds, int wid, int lane_) const {
        int fr = fr_, fq = fq_, lane = lane_; asm volatile("" : "+v"(fr), "+v"(fq), "+v"(lane));
        const int pm = u.pm, pn = u.pn;
        const int cond = pm < 16 ? 0 : 1 + ((pm - 16) >> 3);
        const float* gp = EC_mod + (size_t)(c.l * 3 + cond) * 6144 + goff + pn * 256;
        float* const dst = c.out + O_X + (size_t)(pm * 256) * 1024 + pn * 256 + 4 * lane;
        bfraw* const dstp = (bfraw*)(c.ws + WS_PART) + (part == 2 ? (size_t)NTOK * 1024 : 0) + (size_t)(pm * 256) * 1024 + pn * 256 + 4 * lane;
        PG8_LAS float* const lf = (PG8_LAS float*)lds;
#pragma unroll
        for (int ai = 0; ai < 2; ++ai) {
#pragma unroll
            for (int bj = 0; bj < 2; ++bj)
#pragma unroll
                for (int n = 0; n < 2; ++n) {
                    const int col = bj * 128 + wc * 32 + 16 * n + 4 * fq;
                    const f32x4 gv = *(const f32x4*)(gp + col);
#pragma unroll
                    for (int m = 0; m < 4; ++m) *(PG8_LAS f32x4*)(lf + (wr * 64 + m * 16 + fr) * 260 + col) = gv * acc[ai][bj][m][n];
                }
            asm volatile("s_waitcnt lgkmcnt(0)" ::: "memory"); __builtin_amdgcn_s_barrier(); asm volatile("" ::: "memory");
#pragma unroll 4
            for (int r = 0; r < 16; ++r) {
                const int rl = wid * 16 + r;
                const f32x4 v = *(const PG8_LAS f32x4*)(lf + rl * 260 + 4 * lane);
                float* xp = dst + (size_t)(ai * 128 + rl) * 1024;
                if (part) st_bf4(dstp + (size_t)(ai * 128 + rl) * 1024, v); else *(f32x4*)xp = *(const f32x4*)xp + v;
            }
            asm volatile("s_waitcnt lgkmcnt(0)" ::: "memory"); __builtin_amdgcn_s_barrier(); asm volatile("" ::: "memory");
        }
    }
};

struct EpiRelu2 {
    static constexpr bool PERM = true, AFTER_DRAIN = false;
    EpiCtx c;
    __device__ __forceinline__ void operator()(const f32x4 (&acc)[2][2][4][2], const Unit& u, int wr, int wc, int fr_, int fq_) const {
        int fr = fr_, fq = fq_; asm volatile("" : "+v"(fr), "+v"(fq));
#pragma unroll
        for (int ai = 0; ai < 2; ++ai)
#pragma unroll
            for (int m = 0; m < 4; ++m) {
                const int row = u.pm * 256 + ai * 128 + wr * 64 + m * 16 + fr;
#pragma unroll
                for (int bj = 0; bj < 2; ++bj) {
                    f32x4 v0 = acc[ai][bj][m][0], v1 = acc[ai][bj][m][1];
#pragma unroll
                    for (int j = 0; j < 4; ++j) { v0[j] = __builtin_fmaxf(v0[j], 0.f); v1[j] = __builtin_fmaxf(v1[j], 0.f); }
                    v0 = v0 * v0; v1 = v1 * v1;
                    u32x4 w; w.x = pk2(v0[0], v0[1]); w.y = pk2(v0[2], v0[3]); w.z = pk2(v1[0], v1[1]); w.w = pk2(v1[2], v1[3]);
                    *(u32x4*)(EC_HID + (size_t)row * 4096 + u.pn * 256 + bj * 128 + wc * 32 + 8 * fq) = w;
                }
            }
    }
};
template <class Epi, class Sched, bool ALIGN_EPI = false, bool SP2 = false>
__device__ __forceinline__ void gemm_phase(PG8_LAS unsigned char* lds, const Gemm g, const Sched& S, const Epi& E) {
    int tid_ = threadIdx.x; asm volatile("" : "+v"(tid_));
    const int tid = tid_, wid = __builtin_amdgcn_readfirstlane(tid >> 6), lane = tid & 63, wr = wid >> 2, wc = wid & 3, fr = lane & 15, fq = lane >> 4;
    const int K = g.K, nt = g.Kloop / BK, bjs = g.bjsel;
    unsigned voffA[2], voffB[2];
#pragma unroll
    for (int i = 0; i < 2; ++i) { int R, C; stage_rc(tid * 16 + i * 8192, R, C); const int Rb = Epi::PERM ? ((R & ~31) + perm32(R & 31)) : R;
        voffA[i] = (unsigned)(R * K + C) * 2u; voffB[i] = (unsigned)(Rb * K + C) * 2u; }
    const size_t kstep = (size_t)(BK * 2);
    const size_t hstep = (size_t)HALF * K * 2;
    const size_t tstep = 2 * hstep;
    const unsigned ldsw = (unsigned)wid * 1024u;
    const int aoff = lds_byte(wr * 64 + fr, fq * 8), boff = lds_byte(wc * 32 + fr, fq * 8);
#define PG8_SA(b, h) (((b) * 2 + (h)) * HTB)
#define PG8_SB(b, h) ((4 + (b) * 2 + (h)) * HTB)
#define PG8_STAGE(bufoff, gbase, voff) do { _Pragma("unroll") for (int _i = 0; _i < 2; ++_i) \
        __builtin_amdgcn_global_load_lds((const unsigned*)((const char*)(gbase) + (voff)[_i]), (PG8_LAS unsigned*)(lds + (bufoff) + ldsw + _i * 8192), 16, 0, 0); } while (0)
#define PG8_LDA(dst, b, h) do { _Pragma("unroll") for (int m = 0; m < 4; ++m) _Pragma("unroll") for (int k = 0; k < 2; ++k) dst[m][k] = *(const PG8_LAS bf16x8*)(lds + PG8_SA(b, h) + aoff + m * 2048 + k * 1024); } while (0)
#define PG8_LDB(dst, b, h) do { _Pragma("unroll") for (int n = 0; n < 2; ++n) _Pragma("unroll") for (int k = 0; k < 2; ++k) dst[n][k] = *(const PG8_LAS bf16x8*)(lds + PG8_SB(b, h) + boff + n * 2048 + k * 1024); } while (0)
#define PG8_MMA(ai, bj, At, Bt) do { __builtin_amdgcn_s_setprio(1); _Pragma("unroll") for (int m = 0; m < 4; ++m) _Pragma("unroll") for (int n = 0; n < 2; ++n) _Pragma("unroll") for (int k = 0; k < 2; ++k) \
        acc[ai][bj][m][n] = __builtin_amdgcn_mfma_f32_16x16x32_bf16(Bt[n][k], At[m][k], acc[ai][bj][m][n], 0, 0, 0); __builtin_amdgcn_s_setprio(0); } while (0)
#define PG8_WAIT_V(n) asm volatile("s_waitcnt vmcnt(" #n ")" ::: "memory")
#define PG8_WAIT_L(n) asm volatile("s_waitcnt lgkmcnt(" #n ")" ::: "memory")
#define PG8_BAR __builtin_amdgcn_s_barrier()
#define PG8_SCHED __builtin_amdgcn_sched_barrier(0)
    Unit cur, nxt; int ui = 0;
    if (!S.next(0, cur)) return;
    f32x4 acc[2][2][4][2];
#pragma unroll
    for (int a = 0; a < 2; ++a)
#pragma unroll
        for (int b = 0; b < 2; ++b)
#pragma unroll
            for (int m = 0; m < 4; ++m)
#pragma unroll
                for (int n = 0; n < 2; ++n) acc[a][b][m][n] = (f32x4){0.f, 0.f, 0.f, 0.f};
    bf16x8 At[4][2], B0[2][2], B1[2][2];
    const char* cA = (const char*)g.A + (size_t)cur.pm * tstep; const char* cB = (const char*)g.Bt + (size_t)cur.pn * tstep;
    S.a_ready(cur);
    if constexpr (SP2) {
        PG8_STAGE(PG8_SB(0, 0), cB, voffB); PG8_STAGE(PG8_SB(0, 1), cB + hstep, voffB); PG8_STAGE(PG8_SA(0, 0), cA, voffA); PG8_STAGE(PG8_SA(0, 1), cA + hstep, voffA);
        if (wr == 1) PG8_BAR;
        PG8_WAIT_V(2); PG8_BAR;
        PG8_STAGE(PG8_SB(1, 0), cB + kstep, voffB); PG8_STAGE(PG8_SA(1, 0), cA + kstep, voffA); PG8_STAGE(PG8_SB(1, 1), cB + hstep + kstep, voffB);
        PG8_WAIT_V(6); PG8_BAR;
    } else {
        PG8_STAGE(PG8_SB(0, 0), cB, voffB); PG8_STAGE(PG8_SA(0, 0), cA, voffA); PG8_STAGE(PG8_SB(0, 1), cB + hstep, voffB); PG8_STAGE(PG8_SA(0, 1), cA + hstep, voffA);
        if (wr == 1) PG8_BAR;
        PG8_WAIT_V(4); PG8_BAR;
        PG8_STAGE(PG8_SB(1, 0), cB + kstep, voffB); PG8_STAGE(PG8_SA(1, 0), cA + kstep, voffA); PG8_STAGE(PG8_SB(1, 1), cB + hstep + kstep, voffB);
        PG8_WAIT_V(6); PG8_BAR;
    }
    for (;;) {
        const bool has_next = S.next(ui + 1, nxt);
        const char* nA = has_next ? (const char*)g.A + (size_t)nxt.pm * tstep : cA; const char* nB = has_next ? (const char*)g.Bt + (size_t)nxt.pn * tstep : cB;
        for (int t = 0; t < nt; t += 2) {
            const bool last = (t == nt - 2);
            const char* a1 = cA + (size_t)(t + 1) * kstep;
            const char* a2 = last ? nA : cA + (size_t)(t + 2) * kstep; const char* b2 = last ? nB : cB + (size_t)(t + 2) * kstep;
            const char* a3 = a2 + kstep; const char* b3 = b2 + kstep;
            if (last && has_next) S.a_ready(nxt);
            if constexpr (SP2) {
            PG8_LDB(B0, 0, 0); PG8_LDB(B1, 0, 1); PG8_SCHED; PG8_LDA(At, 0, 0); PG8_STAGE(PG8_SA(1, 1), a1 + hstep, voffA);
            PG8_WAIT_V(8); PG8_WAIT_L(0); PG8_BAR; if (bjs != 1) PG8_MMA(0, 0, At, B0); if (bjs != 0) PG8_MMA(0, 1, At, B1); PG8_BAR; PG8_SCHED;
            PG8_LDA(At, 0, 1); PG8_STAGE(PG8_SB(0, 0), b2, voffB); PG8_STAGE(PG8_SB(0, 1), b2 + hstep, voffB); PG8_STAGE(PG8_SA(0, 0), a2, voffA);
            PG8_WAIT_V(8); PG8_WAIT_L(0); PG8_BAR; if (bjs != 1) PG8_MMA(1, 0, At, B0); if (bjs != 0) PG8_MMA(1, 1, At, B1); PG8_BAR; PG8_SCHED;
            PG8_LDB(B0, 1, 0); PG8_LDB(B1, 1, 1); PG8_SCHED; PG8_LDA(At, 1, 0); PG8_STAGE(PG8_SA(0, 1), a2 + hstep, voffA);
            PG8_WAIT_V(8); PG8_WAIT_L(0); PG8_BAR; if (bjs != 1) PG8_MMA(0, 0, At, B0); if (bjs != 0) PG8_MMA(0, 1, At, B1); PG8_BAR; PG8_SCHED;
            PG8_LDA(At, 1, 1); PG8_STAGE(PG8_SB(1, 0), b3, voffB); PG8_STAGE(PG8_SB(1, 1), b3 + hstep, voffB); PG8_STAGE(PG8_SA(1, 0), a3, voffA);
            PG8_WAIT_V(8); PG8_WAIT_L(0); PG8_BAR; if (bjs != 1) PG8_MMA(1, 0, At, B0); if (bjs != 0) PG8_MMA(1, 1, At, B1); PG8_BAR; PG8_SCHED;
            } else {
            PG8_LDB(B0, 0, 0); PG8_SCHED; PG8_LDA(At, 0, 0); PG8_STAGE(PG8_SA(1, 1), a1 + hstep, voffA);
            PG8_WAIT_L(8); PG8_BAR; PG8_WAIT_L(0); PG8_MMA(0, 0, At, B0); PG8_BAR; PG8_SCHED;
            PG8_LDB(B1, 0, 1); PG8_STAGE(PG8_SB(0, 0), b2, voffB);
            PG8_BAR; PG8_WAIT_L(0); PG8_MMA(0, 1, At, B1); PG8_BAR;
            PG8_LDA(At, 0, 1); PG8_STAGE(PG8_SA(0, 0), a2, voffA);
            PG8_BAR; PG8_WAIT_L(0); PG8_MMA(1, 0, At, B0); PG8_BAR; PG8_SCHED;
            PG8_STAGE(PG8_SB(0, 1), b2 + hstep, voffB);
            PG8_WAIT_V(6); PG8_BAR; PG8_MMA(1, 1, At, B1); PG8_BAR;
            PG8_LDB(B0, 1, 0); PG8_SCHED; PG8_LDA(At, 1, 0); PG8_STAGE(PG8_SA(0, 1), a2 + hstep, voffA);
            PG8_WAIT_L(8); PG8_BAR; PG8_WAIT_L(0); PG8_MMA(0, 0, At, B0); PG8_BAR; PG8_SCHED;
            PG8_LDB(B1, 1, 1); PG8_STAGE(PG8_SB(1, 0), b3, voffB);
            PG8_BAR; PG8_WAIT_L(0); PG8_MMA(0, 1, At, B1); PG8_BAR;
            PG8_LDA(At, 1, 1); PG8_STAGE(PG8_SA(1, 0), a3, voffA);
            PG8_BAR; PG8_WAIT_L(0); PG8_MMA(1, 0, At, B0); PG8_BAR; PG8_SCHED;
            PG8_STAGE(PG8_SB(1, 1), b3 + hstep, voffB);
            PG8_WAIT_V(6); PG8_BAR; PG8_MMA(1, 1, At, B1); PG8_BAR;
            }
        }
        if constexpr (ALIGN_EPI) { if (wr == 0) PG8_BAR; }
        if constexpr (!Epi::AFTER_DRAIN) { E(acc, cur, wr, wc, fr, fq); S.done(cur); }
        if (!has_next) break;
#pragma unroll
        for (int a = 0; a < 2; ++a)
#pragma unroll
            for (int b = 0; b < 2; ++b)
#pragma unroll
                for (int m = 0; m < 4; ++m)
#pragma unroll
                    for (int n = 0; n < 2; ++n) acc[a][b][m][n] = (f32x4){0.f, 0.f, 0.f, 0.f};
        cur = nxt; cA = nA; cB = nB; ++ui;
        if constexpr (ALIGN_EPI) { if (wr == 1) PG8_BAR; }
    }
    PG8_WAIT_V(0);
    if constexpr (!ALIGN_EPI) { if (wr == 0) PG8_BAR; }
    PG8_BAR;
    if constexpr (Epi::AFTER_DRAIN) { E.fused(acc, cur, wr, wc, fr, fq, lds, wid, lane); S.done(cur); }
#undef PG8_SA
#undef PG8_SB
#undef PG8_STAGE
#undef PG8_LDA
#undef PG8_LDB
#undef PG8_MMA
#undef PG8_WAIT_V
#undef PG8_WAIT_L
#undef PG8_BAR
#undef PG8_SCHED
}
}
#ifndef REP_P0
#define REP_P0 1
#endif
#ifndef REP_PA
#define REP_PA 1
#endif
#ifndef REP_ATT
#define REP_ATT 1
#endif
#ifndef REP_CONV
#define REP_CONV 1
#endif
#ifndef REP_C1
#define REP_C1 1
#endif
#ifndef REP_C2
#define REP_C2 1
#endif
#ifndef REP_M1
#define REP_M1 1
#endif
#ifndef REP_M2
#define REP_M2 1
#endif
#ifndef REP_SYNC
#define REP_SYNC 0
#endif

struct KArgs { const float* in[31]; float* out; unsigned char* ws; };
#define XB_TMO      128
#define XB_XCNT(j)  (256  + 64 * (j))
#define XB_XSUB(j)  (1280 + 64 * (j))
#define XB_XGEN(j)  (2304 + 64 * (j))
#define XB_TOP      3328
#define XB_TOPGEN   3392
#define XCD_BAR_WORDS 3456
#define XB_SPIN_CAP (1u << 18)

__device__ __forceinline__ unsigned xb_ld(unsigned* p)              { return __hip_atomic_load(p, __ATOMIC_RELAXED, __HIP_MEMORY_SCOPE_AGENT); }
__device__ __forceinline__ unsigned xb_add(unsigned* p, unsigned v) { return __hip_atomic_fetch_add(p, v, __ATOMIC_RELAXED, __HIP_MEMORY_SCOPE_AGENT); }
__device__ __forceinline__ unsigned xb_xcc_id() { return (unsigned)__builtin_amdgcn_s_getreg((3 << 11) | 20) & 0xFu; }
#define XB_SPIN(cond, bar) do { unsigned _sp = 0; while (cond) { __builtin_amdgcn_s_sleep(1); \
    if ((++_sp & 255u) == 0u) { if (xb_ld(&(bar)[XB_TMO])) break; if (_sp > XB_SPIN_CAP) { atomicAdd(&(bar)[XB_TMO], 1u); break; } } } } while (0)

struct XcdBarrier {
    unsigned* bar; unsigned x;
    volatile LAS unsigned* st;
};

__device__ __forceinline__ XcdBarrier xcd_barrier_post(unsigned* bar, volatile LAS unsigned* st) {
    XcdBarrier b; b.bar = bar; b.x = xb_xcc_id(); b.st = st;
    if (threadIdx.x == 0) st[2] = xb_add(&bar[XB_XCNT(b.x)], 1u);
    return b;
}
__device__ __forceinline__ void xcd_barrier_complete(unsigned* bar, unsigned x, unsigned& nloc, unsigned& nx) {
    const unsigned G = gridDim.x * gridDim.y * gridDim.z;
    unsigned sum, cnt, mine, sp = 0u;
    for (;;) {
        sum = 0u; cnt = 0u; mine = 0u;
#pragma unroll
        for (unsigned j = 0; j < 16; ++j) { const unsigned c = xb_ld(&bar[XB_XCNT(j)]); sum += c; cnt += (c > 0u) ? 1u : 0u; mine = (j == x) ? c : mine; }
        if (sum == G) break;
        __builtin_amdgcn_s_sleep(1);
        if ((++sp & 255u) == 0u) { if (xb_ld(&bar[XB_TMO])) break; if (sp > XB_SPIN_CAP) { atomicAdd(&bar[XB_TMO], 1u); break; } }
    }
    nloc = mine > 0u ? mine : 1u; nx = cnt > 0u ? cnt : 1u;
}

__device__ __forceinline__ void xcd_barrier(const XcdBarrier& b) {
    asm volatile("s_waitcnt vmcnt(0)" ::: "memory");
    __syncthreads();
    if (threadIdx.x == 0) {
        unsigned* bar = b.bar;
        __builtin_amdgcn_s_waitcnt(0);
        unsigned nloc = b.st[0], nx = b.st[1];
        if (nloc == 0u) { xcd_barrier_complete(bar, b.x, nloc, nx); b.st[0] = nloc; b.st[1] = nx;
            unsigned uni = (nx == 8u && gridDim.x == 256u) ? 1u : 0u;
#pragma unroll
            for (unsigned j = 0; j < 16; ++j) { const unsigned cj = xb_ld(&bar[XB_XCNT(j)]); if (cj != (j < 8u ? 32u : 0u)) uni = 0u; }
            b.st[3] = uni; }
        const unsigned old = xb_add(&bar[XB_XSUB(b.x)], 1u);
        const unsigned gen = old / nloc;
        if (old + 1u == (gen + 1u) * nloc) {
            __builtin_amdgcn_fence(__ATOMIC_RELEASE, "agent");
            asm volatile("s_waitcnt vmcnt(0)" ::: "memory");
            const unsigned og = xb_add(&bar[XB_TOP], 1u);
            const unsigned tg = og / nx;
            if (og + 1u == (tg + 1u) * nx) xb_add(&bar[XB_TOPGEN], 1u);
            else XB_SPIN(xb_ld(&bar[XB_TOPGEN]) == tg, bar);
            __builtin_amdgcn_fence(__ATOMIC_ACQUIRE, "agent");
            xb_add(&bar[XB_XGEN(b.x)], 1u);
            asm volatile("s_waitcnt vmcnt(0)" ::: "memory");
        } else {
            XB_SPIN(xb_ld(&bar[XB_XGEN(b.x)]) == gen, bar);
            __builtin_amdgcn_fence(__ATOMIC_ACQUIRE, "agent");
            asm volatile("s_waitcnt vmcnt(0)" ::: "memory");
        }
    }
    __syncthreads();
}


__device__ __forceinline__ float wave_sum(float v) {
#pragma unroll
    for (int o = 1; o < 64; o <<= 1) v += __shfl_xor(v, o);
    return v;
}

#define XB_LSUB(j)  (3456 + 64 * (j))
#define XB_LGEN(j)  (4480 + 64 * (j))
__device__ __forceinline__ void xcc_local_barrier(const XcdBarrier& b) {
    asm volatile("s_waitcnt vmcnt(0)" ::: "memory");
    __syncthreads();
    if (threadIdx.x == 0) {
        unsigned* bar = b.bar;
        const unsigned old = xb_add(&bar[XB_LSUB(b.x)], 1u), gen = old / 32u;
        if (old + 1u == (gen + 1u) * 32u) xb_add(&bar[XB_LGEN(b.x)], 1u);
        else XB_SPIN(xb_ld(&bar[XB_LGEN(b.x)]) == gen, bar);
        __builtin_amdgcn_fence(__ATOMIC_ACQUIRE, "agent");
        asm volatile("s_waitcnt vmcnt(0)" ::: "memory");
    }
    __syncthreads();
}

__device__ __forceinline__ void transpose_item(const float* W, int K, int N, bfraw* WT, int vrow0, int n0, int k0, LAS float* scr, int lane) {
#pragma unroll 8
    for (int i = 0; i < 32; ++i) { const int kk = 2 * i + (lane >> 5); scr[kk * 33 + (lane & 31)] = W[(size_t)(k0 + kk) * N + n0 + (lane & 31)]; }
    asm volatile("s_waitcnt lgkmcnt(0)" ::: "memory");
    const int cch = lane & 7;
#pragma unroll
    for (int j = 0; j < 4; ++j) { const int n = (lane >> 3) + 8 * j; const LAS float* s = scr + (8 * cch) * 33 + n;
        u32x4_t o; o.x = pk2(s[0 * 33], s[1 * 33]); o.y = pk2(s[2 * 33], s[3 * 33]); o.z = pk2(s[4 * 33], s[5 * 33]); o.w = pk2(s[6 * 33], s[7 * 33]);
        *(u32x4_t*)(WT + (size_t)(vrow0 + n) * K + k0 + 8 * cch) = o; }
    asm volatile("s_waitcnt lgkmcnt(0)" ::: "memory");
}
__device__ __forceinline__ int vcol_map(int vb) {
    const int tile = vb >> 3, sub = vb & 7, bj = sub >> 2, wc = sub & 3;
    if (tile < 6 || tile >= 13) return vb * 32;
    if (tile < 8) return 1536 + (4 * (tile - 6) + wc) * 64 + 32 * bj;
    if (tile == 8) return 2048 + wc * 64 + 32 * bj;
    return (bj ? 2816 : 2304) + 128 * (tile - 9) + 32 * wc;
}
__device__ __forceinline__ void sincos_small(float x, float& s, float& c) {
    const float k = __builtin_rintf(x * 0.15915494309189535f);
    float r = __builtin_fmaf(-k, 6.2831854820251465f, x); r = __builtin_fmaf(-k, -1.7484555e-07f, r);
    const float y = r * 0.25f, y2 = y * y;
    float sp = __builtin_fmaf(y2, 2.7557319e-06f, -1.9841270e-04f); sp = __builtin_fmaf(sp, y2, 8.3333333e-03f); sp = __builtin_fmaf(sp, y2, -1.6666667e-01f); sp = __builtin_fmaf(sp * y2, y, y);
    float cp = __builtin_fmaf(y2, -2.7557319e-07f, 2.4801587e-05f); cp = __builtin_fmaf(cp, y2, -1.3888889e-03f); cp = __builtin_fmaf(cp, y2, 4.1666667e-02f); cp = __builtin_fmaf(cp, y2, -0.5f); cp = __builtin_fmaf(cp, y2, 1.0f);
    const float s2 = 2.f * sp * cp, c2 = cp * cp - sp * sp;
    s = 2.f * s2 * c2; c = c2 * c2 - s2 * s2;
}
__device__ __forceinline__ void modnorm_row(const float* xrow, const float* addrow, float* xcopy, bfraw* orow, const float* nw, const float* shift, const float* scale, int lane) {
    const f32x4_t* xr = (const f32x4_t*)xrow + lane;
    f32x4_t v[4]; float s = 0.f;
#pragma unroll
    for (int j = 0; j < 4; ++j) { v[j] = xr[64 * j]; if (addrow) v[j] += ((const f32x4_t*)addrow + lane)[64 * j]; s += dot4(v[j]); }
    const float r = __builtin_amdgcn_rsqf(wave_sum(s) * (1.0f / DM) + NEPS);
#pragma unroll
    for (int j = 0; j < 4; ++j) {
        const int cidx = 4 * lane + 256 * j;
        if (xcopy) *((f32x4_t*)xcopy + lane + 64 * j) = v[j];
        const f32x4_t w = *(const f32x4_t*)(nw + cidx), sh = *(const f32x4_t*)(shift + cidx), sc = *(const f32x4_t*)(scale + cidx);
        const f32x4_t h = v[j] * r * w * (1.0f + sc) + sh;
        st_bf4(orow + cidx, h);
    }
}
__device__ __forceinline__ void finalnorm_row(float* xrow, const float* addrow, const float* nw, int lane) {
    f32x4_t* xr = (f32x4_t*)xrow + lane;
    f32x4_t v[4]; float s = 0.f;
#pragma unroll
    for (int j = 0; j < 4; ++j) { v[j] = xr[64 * j]; if (addrow) v[j] += ((const f32x4_t*)addrow + lane)[64 * j]; s += dot4(v[j]); }
    const float r = __builtin_amdgcn_rsqf(wave_sum(s) * (1.0f / DM) + NEPS);
#pragma unroll
    for (int j = 0; j < 4; ++j) { const f32x4_t w = *(const f32x4_t*)(nw + 4 * lane + 256 * j); xr[64 * j] = v[j] * r * w; }
}

template <bool FINAL>
__device__ __forceinline__ void norm_rows4(int m0, int stride, const float* in_ctx, const float* in_lat, float* X, const float* PARTX, bfraw* HB,
                                           const float* nw, const float* modl, int sh_off, int sc_off, int lane) {
    f32x4_t v[4][4];
#pragma unroll
    for (int r = 0; r < 4; ++r) {
        const int m = m0 + r * stride; if (m >= NTOK) break;
        const float* src = in_ctx ? (m < NCTX ? in_ctx + (size_t)m * DM : in_lat + (size_t)(m - NCTX) * DM) : X + (size_t)m * DM;
#pragma unroll
        for (int j = 0; j < 4; ++j) v[r][j] = ((const f32x4_t*)src + lane)[64 * j];
    }
    if (PARTX) {
        u32x2_t pv[4][4], pw[4][4];
#pragma unroll
        for (int r = 0; r < 4; ++r) { const int m = m0 + r * stride; if (m >= NTOK) break;
#pragma unroll
            for (int j = 0; j < 4; ++j) { pv[r][j] = ((const u32x2_t*)((const bfraw*)PARTX + (size_t)m * DM) + lane)[64 * j]; pw[r][j] = ((const u32x2_t*)((const bfraw*)PARTX + (size_t)(NTOK + m) * DM) + lane)[64 * j]; } }
#pragma unroll
        for (int r = 0; r < 4; ++r) { const int m = m0 + r * stride; if (m >= NTOK) break;
#pragma unroll
            for (int j = 0; j < 4; ++j) { const u32x2_t q = pv[r][j], q2 = pw[r][j];
                v[r][j][0] += __builtin_bit_cast(float, q.x << 16) + __builtin_bit_cast(float, q2.x << 16); v[r][j][1] += __builtin_bit_cast(float, q.x & 0xffff0000u) + __builtin_bit_cast(float, q2.x & 0xffff0000u);
                v[r][j][2] += __builtin_bit_cast(float, q.y << 16) + __builtin_bit_cast(float, q2.y << 16); v[r][j][3] += __builtin_bit_cast(float, q.y & 0xffff0000u) + __builtin_bit_cast(float, q2.y & 0xffff0000u); } }
    }
#pragma unroll
    for (int r = 0; r < 4; ++r) {
        const int m = m0 + r * stride; if (m >= NTOK) break;
        float s = 0.f;
#pragma unroll
        for (int j = 0; j < 4; ++j) s += dot4(v[r][j]);
        const float rr = __builtin_amdgcn_rsqf(wave_sum(s) * (1.0f / DM) + NEPS);
        const int cond = m < NCTX ? 0 : 1 + ((m - NCTX) >> 11);
        const float* md = modl + (size_t)cond * 6144;
#pragma unroll
        for (int j = 0; j < 4; ++j) {
            const int cidx = 4 * lane + 256 * j;
            const f32x4_t w = *(const f32x4_t*)(nw + cidx);
            if (FINAL) { ((f32x4_t*)(X + (size_t)m * DM) + lane)[64 * j] = v[r][j] * rr * w; }
            else {
                if (in_ctx || PARTX) ((f32x4_t*)(X + (size_t)m * DM) + lane)[64 * j] = v[r][j];
                const f32x4_t sh = *(const f32x4_t*)(md + sh_off + cidx), sc = *(const f32x4_t*)(md + sc_off + cidx);
                st_bf4(HB + (size_t)m * DM + cidx, v[r][j] * rr * w * (1.0f + sc) + sh);
            }
        }
    }
}

struct AttnArgs {
    const bfraw* Q; int qcol0, qcol1;
    const bfraw* Kown; const bfraw* Kc; int kstride;
    int nOwn, nTot;
    const bfraw* Vown; int vsOwn; const bfraw* Vc; int vsC;
    bfraw* O; int ocol0, ocol1;
    float lam, postscale; const float* subln;
};
constexpr int ATT_VOFF = 17408, ATT_BUF = 36864, ATT_XOFF = 0;
template <int KROWB, bool QLDS>
__device__ __forceinline__ void att_s(const LAS unsigned char* cur, int koff, const s16x8_t (&qf)[4], const LAS s16x8_t* qlds, const f32x16_t& negm, f32x16_t& p0, f32x16_t& p1) {
#pragma unroll
    for (int d0 = 0; d0 < 4; ++d0) {
        const s16x8_t k0 = *(const LAS s16x8_t*)(cur + koff + d0 * 32);
        const s16x8_t k1 = *(const LAS s16x8_t*)(cur + koff + 32 * KROWB + d0 * 32);
        const s16x8_t q = QLDS ? qlds[d0 * 512] : qf[d0];
        if (d0 == 0) { p0 = __builtin_amdgcn_mfma_f32_32x32x16_bf16(k0, q, negm, 0, 0, 0); p1 = __builtin_amdgcn_mfma_f32_32x32x16_bf16(k1, q, negm, 0, 0, 0); }
        else { p0 = __builtin_amdgcn_mfma_f32_32x32x16_bf16(k0, q, p0, 0, 0, 0); p1 = __builtin_amdgcn_mfma_f32_32x32x16_bf16(k1, q, p1, 0, 0, 0); }
    }
}
__device__ __forceinline__ float vmax3(float a, float b, float c) { float r; asm("v_max3_f32 %0, %1, %2, %3" : "=v"(r) : "v"(a), "v"(b), "v"(c)); return r; }
template <bool FIRST>
__device__ __forceinline__ float att_softmax(f32x16_t& p0, f32x16_t& p1, float& m_run, float& l_run, f32x16_t& negm, u32x4_t (&pf)[4]) {
    asm volatile("s_nop 15\n\ts_nop 7" : "+v"(p0), "+v"(p1));
    float mx = vmax3(p0[0], p0[1], p1[0]);
    mx = vmax3(mx, p1[1], p0[2]);
#pragma unroll
    for (int r = 2; r < 16; r += 2) { if (r > 2) mx = vmax3(mx, p0[r], p1[r]); else mx = vmax3(mx, p1[2], p1[2]); mx = vmax3(mx, p0[r + 1], p1[r + 1]); }
    mx = __builtin_fmaxf(mx, __shfl_xor(mx, 32));
    float alpha = 1.0f;
    if (FIRST || __any(mx > 0.f)) {
        const float dl = FIRST ? mx : __builtin_fmaxf(mx, 0.f);
        m_run += dl; alpha = __builtin_amdgcn_exp2f(-dl);
#pragma unroll
        for (int r = 0; r < 16; ++r) { p0[r] -= dl; p1[r] -= dl; negm[r] = -m_run; }
    }
    float rs = 0.f;
#pragma unroll
    for (int r = 0; r < 16; ++r) { p0[r] = __builtin_amdgcn_exp2f(p0[r]); p1[r] = __builtin_amdgcn_exp2f(p1[r]); rs += p0[r] + p1[r]; }
    l_run = FIRST ? rs : l_run * alpha + rs;
#pragma unroll
    for (int s2 = 0; s2 < 2; ++s2) {
        pf[s2].x = pk2(p0[8 * s2 + 0], p0[8 * s2 + 1]); pf[s2].y = pk2(p0[8 * s2 + 2], p0[8 * s2 + 3]); pf[s2].z = pk2(p0[8 * s2 + 4], p0[8 * s2 + 5]); pf[s2].w = pk2(p0[8 * s2 + 6], p0[8 * s2 + 7]);
        pf[2 + s2].x = pk2(p1[8 * s2 + 0], p1[8 * s2 + 1]); pf[2 + s2].y = pk2(p1[8 * s2 + 2], p1[8 * s2 + 3]); pf[2 + s2].z = pk2(p1[8 * s2 + 4], p1[8 * s2 + 5]); pf[2 + s2].w = pk2(p1[8 * s2 + 6], p1[8 * s2 + 7]);
    }
    return alpha;
}
template <int NDB>
__device__ __forceinline__ void att_pv(const LAS unsigned char* vt, int voff, const u32x4_t (&pf)[4], f32x16_t (&o)[NDB]) {
#pragma unroll
    for (int js = 0; js < 4; ++js) {
        const s16x8_t pfr = __builtin_bit_cast(s16x8_t, pf[js]);
#pragma unroll
        for (int db = 0; db < NDB; ++db) {
            const LAS unsigned char* vp = vt + voff + db * (32 * 144) + js * 32;
            const u32x2_t lo = *(const LAS u32x2_t*)vp, hh = *(const LAS u32x2_t*)(vp + 16);
            u32x4_t vw; vw.x = lo.x; vw.y = lo.y; vw.z = hh.x; vw.w = hh.y;
            o[db] = __builtin_amdgcn_mfma_f32_32x32x16_bf16(__builtin_bit_cast(s16x8_t, vw), pfr, o[db], 0, 0, 0);
        }
    }
}
template <int DV, int KROW, bool DIFF>
__device__ __forceinline__ void attn_unit(LAS unsigned char* lds, const AttnArgs& a) {
    constexpr int KROWB = KROW * 2 + 16, NKC = KROW / 64, NVC = DV / 64, NDB = DV / 32, KPR = KROW / 8;
    int tid_ = threadIdx.x; asm volatile("" : "+v"(tid_));
    const int tid = tid_, lane = tid & 63, r32 = lane & 31, hi = lane >> 5;
    const int wid = __builtin_amdgcn_readfirstlane(tid >> 6), g = wid >> 2, wq = wid & 3;
    const int kcol = (KROW == 128) ? g * 64 : 0;
    const int koff = r32 * KROWB + (kcol + hi * 8) * 2;
    const int voff = ATT_VOFF + r32 * 144 + hi * 8;
    constexpr bool QLDS = false;
    s16x8_t qf[4];
    LAS s16x8_t* const qlds = (LAS s16x8_t*)(lds + 3 * ATT_BUF) + tid;
    { const bfraw* qp = a.Q + (size_t)(wq * 32 + r32) * 512 + (g ? a.qcol1 : a.qcol0) + hi * 8;
#pragma unroll
      for (int d0 = 0; d0 < 4; ++d0) { qf[d0] = *(const s16x8_t*)(qp + d0 * 16); if (QLDS) qlds[d0 * 512] = qf[d0]; } }
    f32x16_t o[NDB];
#pragma unroll
    for (int db = 0; db < NDB; ++db)
#pragma unroll
        for (int r = 0; r < 16; ++r) o[db][r] = 0.f;
    float m_run = 0.f, l_run = 0.f;
    f32x16_t negm;
#pragma unroll
    for (int r = 0; r < 16; ++r) negm[r] = 0.f;
    u32x4_t kreg[NKC], vreg[NVC];
#define ATT_GLOAD(tn_) do { const int tn = (tn_); const bool own = tn < a.nOwn; \
            const bfraw* kb = own ? a.Kown + (size_t)tn * 64 * a.kstride : a.Kc + (size_t)(tn - a.nOwn) * 64 * a.kstride; \
            const bfraw* vb = own ? a.Vown + tn * 64 : a.Vc + (tn - a.nOwn) * 64; const int vs = own ? a.vsOwn : a.vsC; \
            _Pragma("unroll") for (int i = 0; i < NKC; ++i) { const int ch = tid + 512 * i, key = ch / KPR, part = ch % KPR; kreg[i] = *(const u32x4_t*)(kb + (size_t)key * a.kstride + part * 8); } \
            _Pragma("unroll") for (int i = 0; i < NVC; ++i) { const int ch = tid + 512 * i, d = ch >> 3, part = ch & 7; vreg[i] = *(const u32x4_t*)(vb + (size_t)d * vs + part * 8); } } while (0)
#define ATT_LSTORE(buf_) do { LAS unsigned char* const nb_ = (buf_); \
            _Pragma("unroll") for (int i = 0; i < NKC; ++i) { const int ch = tid + 512 * i, key = ch / KPR, part = ch % KPR; *(LAS u32x4_t*)(nb_ + key * KROWB + part * 16) = kreg[i]; } \
            _Pragma("unroll") for (int i = 0; i < NVC; ++i) { const int ch = tid + 512 * i, d = ch >> 3, part = ch & 7; *(LAS u32x4_t*)(nb_ + ATT_VOFF + d * 144 + part * 16) = vreg[i]; } } while (0)
    ATT_GLOAD(0);
    ATT_LSTORE(lds);
    __syncthreads();
    ATT_GLOAD(1);
    u32x4_t pf[4];
    {
        f32x16_t p0, p1;
        att_s<KROWB, QLDS>(lds, koff, qf, qlds, negm, p0, p1);
        (void)att_softmax<true>(p0, p1, m_run, l_run, negm, pf);
        ATT_LSTORE(lds + ATT_BUF);
        __syncthreads();
        if (a.nTot > 2) ATT_GLOAD(2);
    }
    int ic = 1, ip = 0, in = 2;
    for (int t = 1; t < a.nTot; ++t) {
        const LAS unsigned char* const cur = lds + ic * ATT_BUF; const LAS unsigned char* const prv = lds + ip * ATT_BUF;
        f32x16_t p0, p1;
        att_s<KROWB, QLDS>(cur, koff, qf, qlds, negm, p0, p1);
        att_pv<NDB>(prv, voff, pf, o);
        u32x4_t pn[4];
        const float alpha = att_softmax<false>(p0, p1, m_run, l_run, negm, pn);
        if (__any(alpha != 1.0f)) {
#pragma unroll
            for (int db = 0; db < NDB; ++db)
#pragma unroll
                for (int r = 0; r < 16; ++r) o[db][r] *= alpha;
        }
#pragma unroll
        for (int i = 0; i < 4; ++i) pf[i] = pn[i];
        if (t + 1 < a.nTot) ATT_LSTORE(lds + in * ATT_BUF);
        __syncthreads();
        if (t + 2 < a.nTot) ATT_GLOAD(t + 2);
        const int tmp = ip; ip = ic; ic = in; in = tmp;
    }
    att_pv<NDB>(lds + ip * ATT_BUF, voff, pf, o);
    __syncthreads();
#undef ATT_GLOAD
#undef ATT_LSTORE
    const float ltot = l_run + __shfl_xor(l_run, 32);
    const float inv = 1.0f / ltot;
    const int qrow = wq * 32 + r32;
    if (DIFF) {
        LAS float* xch = (LAS float*)(lds + ATT_XOFF) + wq * 64 * 64 + lane;
        if (g == 1) {
            const float sc = inv * a.lam;
#pragma unroll
            for (int db = 0; db < NDB; ++db)
#pragma unroll
                for (int r = 0; r < 16; ++r) xch[(db * 16 + r) * 64] = o[db][r] * sc;
        }
        __syncthreads();
        if (g == 0) {
            float ss = 0.f;
#pragma unroll
            for (int db = 0; db < NDB; ++db)
#pragma unroll
                for (int r = 0; r < 16; ++r) { const float v = o[db][r] * inv - xch[(db * 16 + r) * 64]; o[db][r] = v; ss += v * v; }
            ss += __shfl_xor(ss, 32);
            const float rn = __builtin_amdgcn_rsqf(ss * (1.0f / 128.0f) + NEPS) * a.postscale;
            bfraw* op = a.O + (size_t)qrow * 512 + a.ocol0 + 4 * hi;
#pragma unroll
            for (int db = 0; db < NDB; ++db)
#pragma unroll
                for (int rr = 0; rr < 4; ++rr) {
                    const int d = 32 * db + 8 * rr;
                    const f32x4_t w = *(const f32x4_t*)(a.subln + d + 4 * hi);
                    f32x4_t v; v[0] = o[db][4 * rr] * rn * w[0]; v[1] = o[db][4 * rr + 1] * rn * w[1]; v[2] = o[db][4 * rr + 2] * rn * w[2]; v[3] = o[db][4 * rr + 3] * rn * w[3];
                    st_bf4(op + d, v);
                }
        }
    } else {
        bfraw* op = a.O + (size_t)qrow * 512 + (g ? a.ocol1 : a.ocol0) + 4 * hi;
#pragma unroll
        for (int db = 0; db < NDB; ++db)
#pragma unroll
            for (int rr = 0; rr < 4; ++rr) {
                f32x4_t v; v[0] = o[db][4 * rr] * inv; v[1] = o[db][4 * rr + 1] * inv; v[2] = o[db][4 * rr + 2] * inv; v[3] = o[db][4 * rr + 3] * inv;
                st_bf4(op + 32 * db + 8 * rr, v);
            }
    }
    __syncthreads();
}

__device__ __forceinline__ void conv_unit(LAS unsigned char* lds, int unit, const bfraw* U, bfraw* UC, const float* cw, const float* cb, const float* lg, const float* lbeta) {
    int tid_ = threadIdx.x; asm volatile("" : "+v"(tid_));
    const int tid = tid_, lane = tid & 63, wid = tid >> 6, c = tid;
    const int m0 = unit * 32;
    int lo, hi_;
    if (m0 < NCTX) { lo = (m0 / CSEQ) * CSEQ; hi_ = lo + CSEQ; } else { lo = NCTX + ((m0 - NCTX) / LSEQ) * LSEQ; hi_ = lo + LSEQ; }
    LAS bfraw* sin_ = (LAS bfraw*)lds;
    LAS float* sm = (LAS float*)(lds + 65536);
    LAS float* st = (LAS float*)(lds + 131072);
#pragma unroll
    for (int k = 0; k < 8; ++k) {
        const int ch = tid + 512 * k, i = ch >> 6, part = ch & 63; int tok = m0 - 15 + i;
        const bool ok = tok >= lo && tok < hi_ && i < 62;
        tok = tok < lo ? lo : (tok >= hi_ ? hi_ - 1 : tok);
        u32x4_t v = *(const u32x4_t*)(U + (size_t)tok * 512 + part * 8);
        if (!ok) v = (u32x4_t){0u, 0u, 0u, 0u};
        if (i < 62) *(LAS u32x4_t*)(sin_ + i * 512 + part * 8) = v;
    }
    float w[31];
#pragma unroll
    for (int j = 0; j < 31; ++j) w[j] = cw[j * 512 + c];
    const float bias = cb[c];
    __syncthreads();
#pragma unroll 1
    for (int g = 0; g < 4; ++g) {
        float acc[8];
#pragma unroll
        for (int o = 0; o < 8; ++o) acc[o] = bias;
        const LAS bfraw* sp = sin_ + (8 * g) * 512 + c;
#pragma unroll
        for (int i = 0; i < 38; ++i) {
            const float v = bf2f(sp[i * 512]);
#pragma unroll
            for (int o = 0; o < 8; ++o) { const int j = i - o; if (j >= 0 && j < 31) acc[o] += v * w[j]; }
        }
#pragma unroll
        for (int o = 0; o < 8; ++o) sm[(8 * g + o) * 512 + c] = acc[o];
    }
    __syncthreads();
#pragma unroll
    for (int tt = 0; tt < 4; ++tt) {
        const int tok = wid * 4 + tt; float s = 0.f, q = 0.f;
#pragma unroll
        for (int k = 0; k < 8; ++k) { const float x = sm[tok * 512 + lane + 64 * k]; s += x; q += x * x; }
        s = wave_sum(s); q = wave_sum(q);
        const float mu = s * (1.0f / 512.0f), var = __builtin_fmaxf(q * (1.0f / 512.0f) - mu * mu, 0.f);
        if (lane == 0) { st[tok * 2] = mu; st[tok * 2 + 1] = __builtin_amdgcn_rsqf(var + NEPS); }
    }
    __syncthreads();
    const float gg = lg[c], bb = lbeta[c];
#pragma unroll 8
    for (int o = 0; o < 32; ++o) {
        const float y = (sm[o * 512 + c] - st[o * 2]) * st[o * 2 + 1] * gg + bb;
        UC[(size_t)(m0 + o) * 512 + c] = f2bf(y * sigmoidf_(y));
    }
    __syncthreads();
}

template <bool PERMIN>
__device__ __forceinline__ void convert_item(const float* W, int K, int N, bfraw* WT, int vrow0, int n0, int k0, LAS float* scr, int tid) {
    const int lane = tid & 63, wave = tid >> 6;
    float v[16][4];
#pragma unroll
    for (int g4 = 0; g4 < 4; ++g4) {
        const int vc = g4 * 64 + lane;
        const int col = PERMIN ? vcol_map((vrow0 + vc) >> 5) + (vc & 31) : n0 + vc;
#pragma unroll
        for (int r = 0; r < 16; ++r) v[r][g4] = W[(size_t)(k0 + wave * 16 + r) * N + col];
    }
#pragma unroll
    for (int r = 0; r < 16; ++r)
#pragma unroll
        for (int g4 = 0; g4 < 4; ++g4) scr[(wave * 16 + r) * 257 + g4 * 64 + lane] = v[r][g4];
    __syncthreads();
#pragma unroll
    for (int it = 0; it < 8; ++it) {
        const int ch = it * 512 + tid, n = ch >> 4, kc = ch & 15;
        const LAS float* s = scr + (8 * kc) * 257 + n;
        u32x4_t o; o.x = pk2(s[0], s[257]); o.y = pk2(s[2 * 257], s[3 * 257]); o.z = pk2(s[4 * 257], s[5 * 257]); o.w = pk2(s[6 * 257], s[7 * 257]);
        *(u32x4_t*)(WT + (size_t)(vrow0 + n) * K + k0 + 8 * kc) = o;
    }
    __syncthreads();
}
#define CONVERT_RANGE(IT0, ITEND, STEP) { \
        LAS float* scr = (LAS float*)lds; \
        constexpr int I_IN = 8 * 25, I_BR = 3 * 16, I_O = 32, I_1 = 128, I_2 = 128, I_L = I_IN + I_BR + I_O + I_1 + I_2; \
        for (int it = (IT0); it < (ITEND); it += (STEP)) { \
            const int l = it / I_L; int r = it % I_L; \
            if (r < I_IN) { const int kb = r / 25, nt = r % 25; convert_item<true>(a.in[12] + (size_t)l * DM * INW, DM, INW, (bfraw*)(ws + WS_WIN + l * WIN_L), nt * 256, 0, kb * 128, scr, tid); continue; } r -= I_IN; \
            if (r < I_BR) { const int br = r >> 4, rr = r & 15, kb = rr >> 2, nt = rr & 3; const float* W = (br == 0 ? a.in[18] : br == 1 ? a.in[21] : a.in[26]) + (size_t)l * 512 * 1024; \
                convert_item<false>(W, 512, 1024, (bfraw*)(ws + WS_WBR + l * WBR_L) + (size_t)br * 1024 * 512, nt * 256, nt * 256, kb * 128, scr, tid); continue; } r -= I_BR; \
            if (r < I_O) { const int kb = r >> 2, nt = r & 3; convert_item<false>(a.in[27] + (size_t)l * 1024 * 1024, 1024, 1024, (bfraw*)(ws + WS_WO + l * WO_L), nt * 256, nt * 256, kb * 128, scr, tid); continue; } r -= I_O; \
            if (r < I_1) { const int kb = r >> 4, nt = r & 15; convert_item<false>(a.in[28] + (size_t)l * 1024 * 4096, 1024, 4096, (bfraw*)(ws + WS_W1 + l * W1_L), nt * 256, nt * 256, kb * 128, scr, tid); continue; } r -= I_1; \
            { const int kb = r >> 2, nt = r & 3; convert_item<false>(a.in[29] + (size_t)l * 4096 * 1024, 4096, 1024, (bfraw*)(ws + WS_W2 + l * W2_L), nt * 256, nt * 256, kb * 128, scr, tid); } \
        } }
#define P0_CONVERT { if (G == 256) CONVERT_RANGE(G - 1 - bid, 200, G) else CONVERT_RANGE(G - 1 - bid, 1072, G) }
#define CONV_PHASE \
            for (int u0 = bid; u0 < NTOK / 32; u0 += G) { const int u = (G == 256) ? 32 * (u0 & 7) + (u0 >> 3) : u0;     \
                conv_unit(lds, u, (const bfraw*)(P_PROJ + P_U), P_ABR + (size_t)2 * NTOK * 512, a.in[22] + l * 31 * 512, a.in[23] + l * 512, a.in[24] + l * 512, a.in[25] + l * 512); }
#define PH_BEGIN const CAS_ KArgs* ap_ = (const CAS_ KArgs*)__builtin_amdgcn_kernarg_segment_ptr(); asm volatile("" : "+s"(ap_)); const CAS_ KArgs& a = *ap_; \
    GAS_ unsigned char* wsg_ = (GAS_ unsigned char*)a.ws; asm volatile("" : "+s"(wsg_)); unsigned char* ws = (unsigned char*)wsg_; int tid = threadIdx.x; asm volatile("" : "+v"(tid)); \
    const int lane = tid & 63, wave = __builtin_amdgcn_readfirstlane(tid >> 6), gw = bid * 8 + wave, NGW = G * 8; (void)lane; (void)gw; (void)NGW; (void)wave;
#define GAS_ __attribute__((address_space(1)))
#define CAS_ __attribute__((address_space(4)))
#ifdef TPROBE
#ifndef TP_BLK
#define TP_BLK 0
#endif
#define STAMP(k) do { if (bid == TP_BLK && threadIdx.x == 0) ((volatile LAS unsigned long long*)(lds + 146880))[(k)] = __builtin_amdgcn_s_memrealtime(); } while (0)
#else
#define STAMP(k) do {} while (0)
#endif
#ifndef SPLITK
#define SPLITK 1
#endif
#ifndef PATAIL
#define PATAIL 1
#endif
#ifndef LOCALBAR
#define LOCALBAR 1
#endif
#ifndef NOCG
#define NOCG 1
#endif
#ifndef C1CONV
#define C1CONV 2
#endif
#ifndef C1ALIGN
#define C1ALIGN true
#endif
#ifndef C1SP2
#define C1SP2 true
#endif
#ifndef C2SPLIT
#define C2SPLIT 1
#endif
#ifndef GALIGN
#define GALIGN true
#endif
#ifndef C1HALFN
#define C1HALFN 1
#endif
#ifndef C1PAIR
#define C1PAIR 0
#endif
#ifdef XPROBE
#define XP_OFF(x) 0
#define XPROBE_KL(full) (full)
#else
#define XP_OFF(x) (x)
#define XPROBE_KL(full) kh
#endif
#define NR_XCD (G == 256)
#define NR_M0 (NR_XCD ? 1024 * (bid & 7) + (((bid >> 3) * 8 + wave) * 4) : gw)
#define NR_END (NR_XCD ? NR_M0 + 1 : NTOK)
#define NR_STEP (NR_XCD ? 4 : 4 * NGW)
#define NR_STRIDE (NR_XCD ? 1 : NGW)
#define P_MOD ((float*)(ws + WS_MOD))
#define P_HB ((bfraw*)(ws + WS_HB))
#define P_ABR ((bfraw*)(ws + WS_ABR))
#define P_PROJ (ws + WS_PROJ)
#define P_X (a.out + O_X)
__global__ void __launch_bounds__(512, 2) fwd_kernel(KArgs a_) {
    extern __shared__ __attribute__((aligned(16))) unsigned char lds_raw[];
    LAS unsigned char* lds = (LAS unsigned char*)lds_raw;
    cg::grid_group grid = cg::this_grid();
    int bid = blockIdx.x; const int G = gridDim.x;
    volatile LAS unsigned* bst = (volatile LAS unsigned*)(lds + 147392);
    STAMP(0);
    {
        PH_BEGIN
        unsigned* barw = (unsigned*)(ws + WS_BAR);
        if (tid == 0) { bst[0] = 0u; bst[1] = 0u; bst[2] = 0u; bst[3] = 0u; }
#if !NOCG
        if (bid == 0) for (int i = tid; i < 6656; i += 512) __hip_atomic_store(barw + i, 0u, __ATOMIC_RELAXED, __HIP_MEMORY_SCOPE_AGENT);
#else
        (void)barw;
#endif
        __syncthreads();
    }
#if NOCG
    const XcdBarrier bar = xcd_barrier_post((unsigned*)(a_.ws + WS_BAR), bst);
#endif
#pragma unroll 1
    for (int rep_ = 0; rep_ < REP_P0; ++rep_) {
        PH_BEGIN
        LAS float* sil = (LAS float*)lds;
        for (int i = tid; i < 3072; i += 512) { const int cond = i >> 10, k = i & 1023; const float v = cond == 0 ? a.in[7][k] : a.in[6][(cond - 1) * 1024 + k]; sil[i] = v * sigmoidf_(v); }
        __syncthreads();
        LAS float* part = (LAS float*)(lds + 16384);
        for (int item = bid; item < 192; item += G) {
            const int l = item / 96, nb = (item % 96) * 64;
            const float* W = a.in[8] + (size_t)l * 1024 * 6144 + nb + lane;
            const int k0 = wave * 128;
            float a0 = 0.f, a1 = 0.f, a2 = 0.f;
#pragma unroll 32
            for (int kk = 0; kk < 128; ++kk) { const float wv = W[(size_t)(k0 + kk) * 6144]; a0 += sil[k0 + kk] * wv; a1 += sil[1024 + k0 + kk] * wv; a2 += sil[2048 + k0 + kk] * wv; }
            part[(wave * 3 + 0) * 64 + lane] = a0; part[(wave * 3 + 1) * 64 + lane] = a1; part[(wave * 3 + 2) * 64 + lane] = a2;
            __syncthreads();
            if (tid < 192) { const int cnd = tid >> 6, ln = tid & 63; float s = 0.f;
#pragma unroll
                for (int wv = 0; wv < 8; ++wv) s += part[(wv * 3 + cnd) * 64 + ln];
                P_MOD[(size_t)(l * 3 + cnd) * 6144 + nb + ln] = s + a.in[9][l * 6144 + nb + ln]; }
            __syncthreads();
        }
        if ((bid == G - 3 || G < 3) && tid < 2) {
            float d1 = 0.f, d2 = 0.f;
            for (int i = 0; i < 64; ++i) { d1 += a.in[13][tid * 64 + i] * a.in[14][tid * 64 + i]; d2 += a.in[15][tid * 64 + i] * a.in[16][tid * 64 + i]; }
            ((float*)(ws + WS_LAM))[tid] = __builtin_amdgcn_exp2f(d1 * 1.4426950408889634f) - __builtin_amdgcn_exp2f(d2 * 1.4426950408889634f) + (tid == 0 ? 0.2f : 0.35550907f);
        }
        if (bid == G - 2 || G == 1) { float* QKN = (float*)(ws + WS_QKN); if (tid < 256) { const int l_ = tid >> 7, w_ = (tid >> 6) & 1, d_ = tid & 63; QKN[tid] = (w_ ? a.in[20] : a.in[19])[l_ * 64 + d_]; } }
        if (bid == G - 1) {
            float* ROPEC = (float*)(ws + WS_ROPEC); float* ROPES = (float*)(ws + WS_ROPES);
            for (int i = tid; i < 1024; i += 512) { const int pos = i >> 4, j = i & 15; const float freq = __builtin_amdgcn_exp2f(-(float)j * 0.8304820237218406f);
                float s, c; sincos_small((float)pos * freq, s, c); ROPEC[i] = c; ROPES[i] = s; }
        }
        __syncthreads();
        P0_CONVERT
        const int gt = bid * 512 + tid, GT = G * 512;
        bfraw* CDK = (bfraw*)(ws + WS_CDK); bfraw* CDVT = (bfraw*)(ws + WS_CDVT); bfraw* CGK = (bfraw*)(ws + WS_CGK); bfraw* CGVT = (bfraw*)(ws + WS_CGVT);
        for (int i = gt; i < 2 * 2 * 256 * 512; i += GT) { const int col = i & 511, s = (i >> 9) & 255, l = (i >> 17) & 1, lb = i >> 18;
            CDK[((size_t)(l * 2 + lb) * 256 + s) * 512 + col] = f2bf(a.in[2][i]); CDVT[((size_t)(l * 2 + lb) * 512 + col) * 256 + s] = f2bf(a.in[3][i]); }
        for (int i = gt; i < 2 * 2 * 256 * 128; i += GT) { const int col = i & 127, s = (i >> 7) & 255, l = (i >> 15) & 1, lb = i >> 16;
            CGK[((size_t)(l * 2 + lb) * 256 + s) * 128 + col] = f2bf(a.in[4][i]); CGVT[((size_t)(l * 2 + lb) * 128 + col) * 256 + s] = f2bf(a.in[5][i]); }
    }
#if !NOCG
    grid.sync();
    const XcdBarrier bar = xcd_barrier_post((unsigned*)(a_.ws + WS_BAR), bst);
#else
    if (G == 0x7fffffff) grid.sync();
    xcd_barrier(bar);
#endif
    STAMP(1);
    for (int rep_ = 0; rep_ < REP_SYNC; ++rep_) xcd_barrier(bar);
#if NOCG
    const bool lbar = LOCALBAR && bst[3] != 0u;
    if (lbar) bid = (int)(bst[2] * 8u + bar.x);
#endif
    {
        PH_BEGIN
        for (int mb = NR_M0; mb < NR_END; mb += NR_STEP) norm_rows4<false>(mb, NR_STRIDE, a.in[0], a.in[1], P_X, nullptr, P_HB, a.in[10], P_MOD, M_SH1, M_SC1, lane);
    }
#if NOCG
    if (lbar) xcc_local_barrier(bar); else xcd_barrier(bar);
#else
    xcd_barrier(bar);
#endif
    STAMP(2);
#if !NOCG
    const bool lbar = LOCALBAR && bst[3] != 0u;
    if (lbar) bid = (int)(bst[2] * 8u + bar.x);
#endif
#define SEAM_LOCAL() do { if (lbar) xcc_local_barrier(bar); else xcd_barrier(bar); } while (0)

#pragma unroll 1
    for (int l = 0; l < 2; ++l) {
#pragma unroll 1
        for (int rep_ = 0; rep_ < REP_PA; ++rep_) {
            PH_BEGIN
            EpiCtx ec; ec.l = l; ec.out = a.out; ec.ws = ws;
            pg8::Gemm g{P_HB, (const bfraw*)(ws + WS_WIN + l * WIN_L), NTOK, INW, DM, DM, -1};
            const bool tail = (G == 256) && PATAIL;
            { pg8::EpiIn E{ec, -1}; pg8::StaticOrder S; S.init(NTOK, tail ? 24 * 256 : INW, G, bid); pg8::gemm_phase<pg8::EpiIn, pg8::StaticOrder, GALIGN, true>(lds, g, S, E); }
            if (tail) { pg8::Gemm g2{P_HB, (const bfraw*)(ws + WS_WIN + l * WIN_L), NTOK, INW, DM, DM, (bid >> 3) & 1}; pg8::EpiIn E2{ec, (bid >> 3) & 1}; pg8::QuarterOrder S{bid}; pg8::gemm_phase<pg8::EpiIn, pg8::QuarterOrder, true, true>(lds, g2, S, E2); }
            if (rep_ == 0 && G == 256 && bid >= 64) { __syncthreads(); if (l == 0) { CONVERT_RANGE(200 + (bid - 64), C1CONV ? 536 : 736, 192) } else { CONVERT_RANGE(736 + (bid - 64), 1072, 192) } }
        }
        xcd_barrier(bar);
        STAMP(3 + l * 8 + 0);
#pragma unroll 1
        for (int rep_ = 0; rep_ < REP_ATT; ++rep_) {
            PH_BEGIN
            const float lam_init = l == 0 ? 0.2f : 0.35550907f;
            const float lam = ((const float*)(ws + WS_LAM))[l];
            const bfraw* CDK = (const bfraw*)(ws + WS_CDK); const bfraw* CDVT = (const bfraw*)(ws + WS_CDVT); const bfraw* CGK = (const bfraw*)(ws + WS_CGK); const bfraw* CGVT = (const bfraw*)(ws + WS_CGVT);
            bfraw* const DQ = (bfraw*)(P_PROJ + P_DQ); bfraw* const DK = (bfraw*)(P_PROJ + P_DK); bfraw* const DVtC = (bfraw*)(P_PROJ + P_DVTC); bfraw* const DVtL = (bfraw*)(P_PROJ + P_DVTL);
            bfraw* const GQ = (bfraw*)(P_PROJ + P_GQ); bfraw* const GK = (bfraw*)(P_PROJ + P_GK); bfraw* const GVtC = (bfraw*)(P_PROJ + P_GVTC); bfraw* const GVtL = (bfraw*)(P_PROJ + P_GVTL);
            bfraw* const ABR = P_ABR;
            for (int k = 0; ; ++k) {
                int u;
                if (G == 256) { if (bid < 128) { if (k > 0) break; u = bid; } else { if (k > 2) break; u = 128 * (k + 1) + (bid - 128); } }
                else { u = bid + k * G; if (u >= 512) break; }
                const int cls = u >> 7, j_ = u & 127, i = (G == 256) ? (j_ & 7) * 16 + (j_ >> 3) : j_;
                AttnArgs t;
                t.lam = lam; t.postscale = 1.0f - lam_init; t.subln = a.in[17] + l * 128;
                if (cls == 0) {
                    const int lb = i >> 6, h = (i >> 4) & 3, qb = i & 15; const int row0 = NCTX + lb * LSEQ;
                    t.Q = DQ + (size_t)(row0 + qb * 128) * 512; t.qcol0 = h * 128; t.qcol1 = h * 128 + 64;
                    t.Kown = DK + (size_t)row0 * 512 + h * 128; t.Kc = CDK + (size_t)(l * 2 + lb) * 256 * 512 + h * 128; t.kstride = 512; t.nOwn = 32; t.nTot = 36;
                    t.Vown = DVtL + ((size_t)lb * 512 + h * 128) * 2048; t.vsOwn = 2048; t.Vc = CDVT + ((size_t)(l * 2 + lb) * 512 + h * 128) * 256; t.vsC = 256;
                    t.O = ABR + (size_t)(row0 + qb * 128) * 512; t.ocol0 = h * 128; t.ocol1 = 0;
                    attn_unit<128, 128, true>(lds, t);
                } else if (cls == 2) {
                    const int cb = i >> 3, h = (i >> 1) & 3, qb = i & 1; const int row0 = cb * CSEQ;
                    t.Q = DQ + (size_t)(row0 + qb * 128) * 512; t.qcol0 = h * 128; t.qcol1 = h * 128 + 64;
                    t.Kown = DK + (size_t)row0 * 512 + h * 128; t.Kc = t.Kown; t.kstride = 512; t.nOwn = 4; t.nTot = 4;
                    t.Vown = DVtC + ((size_t)cb * 512 + h * 128) * 256; t.vsOwn = 256; t.Vc = t.Vown; t.vsC = 256;
                    t.O = ABR + (size_t)(row0 + qb * 128) * 512; t.ocol0 = h * 128; t.ocol1 = 0;
                    attn_unit<128, 128, true>(lds, t);
                } else if (cls == 1) {
                    const int lb = i >> 6, pr = (i >> 4) & 3, qb = i & 15, kvh = pr >> 1, h0 = kvh * 4 + (pr & 1) * 2; const int row0 = NCTX + lb * LSEQ;
                    t.Q = GQ + (size_t)(row0 + qb * 128) * 512; t.qcol0 = h0 * 64; t.qcol1 = h0 * 64 + 64;
                    t.Kown = GK + (size_t)row0 * 128 + kvh * 64; t.Kc = CGK + (size_t)(l * 2 + lb) * 256 * 128 + kvh * 64; t.kstride = 128; t.nOwn = 32; t.nTot = 36;
                    t.Vown = GVtL + ((size_t)lb * 128 + kvh * 64) * 2048; t.vsOwn = 2048; t.Vc = CGVT + ((size_t)(l * 2 + lb) * 128 + kvh * 64) * 256; t.vsC = 256;
                    t.O = ABR + (size_t)NTOK * 512 + (size_t)(row0 + qb * 128) * 512; t.ocol0 = h0 * 64; t.ocol1 = h0 * 64 + 64;
                    attn_unit<64, 64, false>(lds, t);
                } else {
                    const int cb = i >> 3, pr = (i >> 1) & 3, qb = i & 1, kvh = pr >> 1, h0 = kvh * 4 + (pr & 1) * 2; const int row0 = cb * CSEQ;
                    t.Q = GQ + (size_t)(row0 + qb * 128) * 512; t.qcol0 = h0 * 64; t.qcol1 = h0 * 64 + 64;
                    t.Kown = GK + (size_t)row0 * 128 + kvh * 64; t.Kc = t.Kown; t.kstride = 128; t.nOwn = 4; t.nTot = 4;
                    t.Vown = GVtC + ((size_t)cb * 128 + kvh * 64) * 256; t.vsOwn = 256; t.Vc = t.Vown; t.vsC = 256;
                    t.O = ABR + (size_t)NTOK * 512 + (size_t)(row0 + qb * 128) * 512; t.ocol0 = h0 * 64; t.ocol1 = h0 * 64 + 64;
                    attn_unit<64, 64, false>(lds, t);
                }
            }
        }
        STAMP(20 + l * 2);
#pragma unroll 1
        for (int rep_ = 0; rep_ < REP_CONV; ++rep_) {
            PH_BEGIN
            CONV_PHASE
        }
        STAMP(21 + l * 2);
        xcd_barrier(bar);
        STAMP(3 + l * 8 + 1);
#pragma unroll 1
        for (int rep_ = 0; rep_ < REP_C1; ++rep_) {
            PH_BEGIN
            EpiCtx ec; ec.l = l; ec.out = a.out; ec.ws = ws;
            const bool sp = (G == 256) && SPLITK && C1HALFN; const int pairm = (lbar && C1PAIR) ? 1 : 0; const int bjs = pairm ? -1 : (sp ? (bid >> 7) : -1);
            pg8::Gemm g{P_ABR, (const bfraw*)(ws + WS_WBR + l * WBR_L), 3 * NTOK, 3 * 1024, 512, 512, bjs}; pg8::BranchOrder S{(sp || pairm) ? (bid & 127) : bid, bid >> 7, pairm};
            pg8::EpiBranch E{ec, bjs, pairm, (unsigned)(l + 1)};
            pg8::gemm_phase<pg8::EpiBranch, pg8::BranchOrder, C1ALIGN, C1SP2>(lds, g, S, E);
            if (l == 0 && rep_ == 0 && G == 256 && C1CONV == 1) { __syncthreads(); if (C1HALFN) { CONVERT_RANGE(536 + bid, 736, 256) } else if (bid >= 128) { CONVERT_RANGE(536 + (bid - 128), 736, 128) }     }
        }
        SEAM_LOCAL();
        STAMP(3 + l * 8 + 2);
#pragma unroll 1
        for (int rep_ = 0; rep_ < REP_C2; ++rep_) {
            PH_BEGIN
            EpiCtx ec; ec.l = l; ec.out = a.out; ec.ws = ws;
            const bool sp = (G == 256) && SPLITK && C2SPLIT; const int half = sp ? (bid >> 7) : 0, kh = sp ? DM / 2 : DM;
            pg8::Gemm g{P_HB + half * kh, (const bfraw*)(ws + WS_WO + l * WO_L) + half * kh, NTOK, DM, DM, kh, -1}; pg8::StaticOrder S; S.init(NTOK, DM, sp ? 128 : G, sp ? (bid & 127) : bid);
            pg8::EpiRes E{ec, M_G1, sp ? (half ? 1 : 2) : 0};
            pg8::gemm_phase<pg8::EpiRes, pg8::StaticOrder, false, true>(lds, g, S, E);
        }
        SEAM_LOCAL();
        STAMP(3 + l * 8 + 3);
        {
            PH_BEGIN
            for (int mb = NR_M0; mb < NR_END; mb += NR_STEP) norm_rows4<false>(mb, NR_STRIDE, nullptr, nullptr, P_X, ((G == 256) && SPLITK && C2SPLIT) ? (const float*)(ws + WS_PART) : nullptr, P_HB, a.in[11] + l * DM, P_MOD + (size_t)(l * 3) * 6144, M_SH2, M_SC2, lane);
        }
        SEAM_LOCAL();
        STAMP(3 + l * 8 + 4);
#pragma unroll 1
        for (int rep_ = 0; rep_ < REP_M1; ++rep_) {
            PH_BEGIN
            EpiCtx ec; ec.l = l; ec.out = a.out; ec.ws = ws;
            pg8::Gemm g{P_HB, (const bfraw*)(ws + WS_W1 + l * W1_L), NTOK, FF, DM, DM, -1}; pg8::StaticOrder S; S.init(NTOK, FF, G, bid);
            pg8::EpiRelu2 E{ec};
            pg8::gemm_phase<pg8::EpiRelu2, pg8::StaticOrder, GALIGN, true>(lds, g, S, E);
        }
        SEAM_LOCAL();
        STAMP(3 + l * 8 + 5);
#pragma unroll 1
        for (int rep_ = 0; rep_ < REP_M2; ++rep_) {
            PH_BEGIN
            EpiCtx ec; ec.l = l; ec.out = a.out; ec.ws = ws;
            const bool sp = (G == 256) && SPLITK; const int half = sp ? (bid >> 7) : 0, kh = sp ? FF / 2 : FF;
            pg8::Gemm g{(const bfraw*)P_PROJ + half * kh, (const bfraw*)(ws + WS_W2 + l * W2_L) + half * kh, NTOK, DM, FF, kh, -1}; pg8::StaticOrder S; S.init(NTOK, DM, sp ? 128 : G, sp ? (bid & 127) : bid);
            pg8::EpiRes E{ec, M_G2, sp ? (half ? 1 : 2) : 0};
            pg8::gemm_phase<pg8::EpiRes, pg8::StaticOrder, false, true>(lds, g, S, E);
        }
        SEAM_LOCAL();
        STAMP(3 + l * 8 + 6);
        {
            PH_BEGIN
            const float* px = ((G == 256) && SPLITK) ? (const float*)(ws + WS_PART) : nullptr;
            if (l == 0) { for (int mb = NR_M0; mb < NR_END; mb += NR_STEP) norm_rows4<false>(mb, NR_STRIDE, nullptr, nullptr, P_X, px, P_HB, a.in[10] + DM, P_MOD + (size_t)3 * 6144, M_SH1, M_SC1, lane); }
            if (l == 0 && G == 256 && C1CONV == 2) { __syncthreads(); CONVERT_RANGE(536 + bid, 736, 256) }
            else { for (int mb = NR_M0; mb < NR_END; mb += NR_STEP) norm_rows4<true>(mb, NR_STRIDE, nullptr, nullptr, P_X, px, nullptr, a.in[30], nullptr, 0, 0, lane); }
        }
        if (l == 0) xcd_barrier(bar);
        STAMP(3 + l * 8 + 7);
    }
#ifdef TPROBE
    if (bid == TP_BLK && threadIdx.x == 0) {
        volatile LAS unsigned long long* ts_ = (volatile LAS unsigned long long*)(lds + 146880);
        const unsigned long long T_ = ts_[TP_B] - ts_[TP_A], end_ = __builtin_amdgcn_s_memrealtime() + TP_MULT * T_;
        while (__builtin_amdgcn_s_memrealtime() < end_) __builtin_amdgcn_s_sleep(8);
    }
#endif
}

extern "C" void kernel_launch(void* const* d_in, const int* in_sizes, int n_in, void* d_out, int out_size, void* d_ws, size_t ws_size, hipStream_t stream) {
    static int grid_blocks = 0;
    if (grid_blocks == 0) {
        if (n_in != 31 || ws_size < WS_END) { fprintf(stderr, "kernel_launch: unexpected n_in %d / ws_size %zu\n", n_in, ws_size); grid_blocks = -1; return; }
        int dev = 0, cus = 0, per_cu = 0;
        hipGetDevice(&dev);
        hipDeviceGetAttribute(&cus, hipDeviceAttributeMultiprocessorCount, dev);
        if (hipFuncSetAttribute((const void*)fwd_kernel, hipFuncAttributeMaxDynamicSharedMemorySize, LDS_BYTES) != hipSuccess) { fprintf(stderr, "kernel_launch: hipFuncSetAttribute failed\n"); grid_blocks = -1; return; }
        if (hipOccupancyMaxActiveBlocksPerMultiprocessor(&per_cu, (const void*)fwd_kernel, 512, LDS_BYTES) != hipSuccess || per_cu < 1) { fprintf(stderr, "kernel_launch: occupancy query gave %d\n", per_cu); (void)hipGetLastError(); per_cu = 1; }
        grid_blocks = cus * 1;
    }
    if (grid_blocks < 0) return;
#if NOCG
    if (hipMemsetAsync((char*)d_ws + WS_BAR, 0, 6656 * 4, stream) != hipSuccess) { fprintf(stderr, "kernel_launch: hipMemsetAsync of the barrier words failed\n"); return; }
#endif
    KArgs a{};
    for (int i = 0; i < 31; ++i) a.in[i] = (const float*)d_in[i];
    a.out = (float*)d_out; a.ws = (unsigned char*)d_ws;
    void* args[] = {&a};
    hipError_t e = hipLaunchCooperativeKernel((const void*)fwd_kernel, dim3(grid_blocks), dim3(512), args, LDS_BYTES, stream);
    if (e != hipSuccess) fprintf(stderr, "cooperative launch failed: %s (grid %d)\n", hipGetErrorString(e), grid_blocks);
}
```
